# Optimizing an MI355X kernel written in HIP

```python
import jax, jax.numpy as jnp
from jax import lax
import numpy as np

D_MODEL = 1024
BATCH = 4
SEQ = 4096
DEPTH = 2

HEAD_DIM = 64
ROPE_DIM = HEAD_DIM // 4
ROPE_THETA = 500000.0
EPS = 1e-6
NEG = -1e30
BIG = 1e9

GLA_HEADS = 4
GLA_DK = 64
GLA_DV = 128
GLA_GATE_RANK = 16
GLA_GATE_NORM = 16.0
GLA_CHUNK = 64

SWA_Q_HEADS = 8
SWA_KV_HEADS = 2
SWA_WINDOW = 128
BAND_BLOCK = 128

RET_HEADS = 4
RET_DK = 64
RET_DV = 128
RET_CHUNK = 64
RET_THETA = 10000.0

NSA_Q_HEADS = 8
NSA_KV_HEADS = 2
CMP_BLOCK = 32
CMP_STRIDE = 16
CMP_HIDDEN = 256
SEL_BLOCK = 64
SEL_TOP_N = 16
SEL_QUERY_BLOCK = 64
NSA_WINDOW = 512

D_FF = 2816
N_EXPERTS = 8
TOP_K = 2
D_FF_EXPERT = 3584

L0_SPLITS = (GLA_HEADS * GLA_DK, GLA_HEADS * GLA_DK, GLA_HEADS * GLA_DV, GLA_GATE_RANK, GLA_HEADS * GLA_DV,
             SWA_Q_HEADS * HEAD_DIM, SWA_KV_HEADS * HEAD_DIM, SWA_KV_HEADS * HEAD_DIM)
L0_IN = sum(L0_SPLITS)
L0_MIX = GLA_HEADS * GLA_DV + SWA_Q_HEADS * HEAD_DIM
L1_SPLITS = (RET_HEADS * RET_DK, RET_HEADS * RET_DK, RET_HEADS * RET_DV, RET_HEADS * RET_DV,
             NSA_Q_HEADS * HEAD_DIM) + (NSA_KV_HEADS * HEAD_DIM,) * 6 + (NSA_Q_HEADS * 3,)
L1_IN = sum(L1_SPLITS)
L1_MIX = RET_HEADS * RET_DV + NSA_Q_HEADS * HEAD_DIM
N_EVEN = (DEPTH + 1) // 2
N_ODD = DEPTH // 2

kernel_name = 'hybrid_gla_swa_retention_nsa_moe'


def rmsnorm(x, g):
    x32 = x.astype(jnp.float32)
    y = x32 * lax.rsqrt(jnp.mean(x32 * x32, axis=-1, keepdims=True) + EPS)
    return (y * g.astype(jnp.float32)).astype(x.dtype)


def head_layernorm(x, g):
    mu = jnp.mean(x, axis=-1, keepdims=True)
    xc = x - mu
    y = xc * lax.rsqrt(jnp.mean(xc * xc, axis=-1, keepdims=True) + EPS)
    return y * g.astype(jnp.float32).reshape(x.shape[2], x.shape[3])


def rope(x, pos, rot_dim, theta):
    half = rot_dim // 2
    inv = jnp.float32(theta) ** (-jnp.arange(half, dtype=jnp.float32) * 2.0 / rot_dim)
    ang = pos.astype(jnp.float32)[..., None] * inv
    cos = jnp.cos(ang)[:, :, None, :]
    sin = jnp.sin(ang)[:, :, None, :]
    x1 = x[..., :half]
    x2 = x[..., half:rot_dim]
    return jnp.concatenate([x1 * cos - x2 * sin, x2 * cos + x1 * sin, x[..., rot_dim:]], axis=-1)


def _split(h, sizes):
    return jnp.split(h, np.cumsum(sizes)[:-1].tolist(), axis=-1)


def _to_chunks(x, c):
    b, t, h, d = x.shape
    return x.reshape(b, t // c, c, h, d).transpose(1, 0, 3, 2, 4)


def _from_chunks(o):
    n, b, h, c, d = o.shape
    return o.transpose(1, 0, 3, 2, 4).reshape(b, n * c, h, d)


def swiglu(x, w_gate, w_up, w_down):
    return (jax.nn.silu(x @ w_gate) * (x @ w_up)) @ w_down


def gla_chunked(q, k, v, log_alpha):
    B, T, H, dk = q.shape
    dv = v.shape[-1]
    C = GLA_CHUNK
    qc, kc, vc, gc = [_to_chunks(t, C) for t in (q, k, v, log_alpha)]
    b = jnp.cumsum(gc, axis=3)
    b_last = b[:, :, :, -1:, :]
    q_in = qc * jnp.exp(b)
    k_in = kc * jnp.exp(-b)
    k_state = kc * jnp.exp(b_last - b)
    causal = jnp.tril(jnp.ones((C, C), dtype=bool))
    scores = jnp.where(causal, jnp.einsum('nbhtd,nbhsd->nbhts', q_in, k_in), 0.0)
    o_intra = jnp.einsum('nbhts,nbhsv->nbhtv', scores, vc)
    chunk_decay = jnp.exp(b_last[:, :, :, 0, :])

    def step(state, inp):
        qi, ks, vv, dec = inp
        out = jnp.einsum('bhtd,bhdv->bhtv', qi, state)
        state = dec[..., None] * state + jnp.einsum('bhsd,bhsv->bhdv', ks, vv)
        return state, out

    state0 = jnp.zeros((B, H, dk, dv), jnp.float32)
    _, o_inter = lax.scan(step, state0, (q_in, k_state, vc, chunk_decay))
    return _from_chunks(o_intra + o_inter)


def retention_chunked(q, k, v):
    B, T, H, dk = q.shape
    dv = v.shape[-1]
    C = RET_CHUNK
    log_gamma = jnp.log(1.0 - jnp.exp2(-5.0 - jnp.arange(H, dtype=jnp.float32)))
    qc, kc, vc = _to_chunks(q, C), _to_chunks(k, C), _to_chunks(v, C)
    i = jnp.arange(C, dtype=jnp.float32)
    diff = i[:, None] - i[None, :]
    decay_in = jnp.where(diff >= 0, jnp.exp(log_gamma[:, None, None] * jnp.maximum(diff, 0.0)), 0.0)
    scores = jnp.einsum('nbhtd,nbhsd->nbhts', qc, kc) * decay_in
    o_intra = jnp.einsum('nbhts,nbhsv->nbhtv', scores, vc)
    q_dec = qc * jnp.exp(log_gamma[:, None] * (i + 1.0))[:, :, None]
    k_dec = kc * jnp.exp(log_gamma[:, None] * (C - 1.0 - i))[:, :, None]
    chunk_decay = jnp.exp(log_gamma * C)[:, None, None]

    def step(state, inp):
        qd, kd, vv = inp
        out = jnp.einsum('bhtd,bhdv->bhtv', qd, state)
        state = chunk_decay * state + jnp.einsum('bhsd,bhsv->bhdv', kd, vv)
        return state, out

    state0 = jnp.zeros((B, H, dk, dv), jnp.float32)
    _, o_inter = lax.scan(step, state0, (q_dec, k_dec, vc))
    return _from_chunks(o_intra + o_inter)


def banded_window_attention(q, k, v, window, sinks=None):
    B, T, Hq, Dh = q.shape
    Hkv = k.shape[2]
    G = Hq // Hkv
    Bq = BAND_BLOCK
    NB = T // Bq
    P = -(-window // Bq)
    L = (P + 1) * Bq
    pad = ((0, 0), (P * Bq, 0), (0, 0), (0, 0))
    kp = jnp.pad(k, pad)
    vp = jnp.pad(v, pad)
    band = jnp.arange(NB)[:, None] * Bq + jnp.arange(L)[None, :]
    kb = jnp.moveaxis(kp[:, band], 1, 0)
    vb = jnp.moveaxis(vp[:, band], 1, 0)
    qb = jnp.moveaxis(q.reshape(B, NB, Bq, Hkv, G, Dh), 1, 0)
    r = jnp.arange(Bq)[:, None]
    c = jnp.arange(L)[None, :]
    rel = r + P * Bq - c
    scale = Dh ** -0.5

    def block(args):
        qi, ki, vi, bi = args
        s = jnp.einsum('bqhgd,bkhd->bhgqk', qi, ki) * scale
        key_pos = bi * Bq + c - P * Bq
        mask = (rel >= 0) & (rel < window) & (key_pos >= 0)
        s = jnp.where(mask, s, NEG)
        if sinks is None:
            p = jax.nn.softmax(s, axis=-1)
        else:
            sk = sinks.astype(jnp.float32).reshape(Hkv, G)[None, :, :, None, None]
            m = jnp.maximum(jnp.max(s, axis=-1, keepdims=True), sk)
            e = jnp.exp(s - m)
            p = e / (jnp.sum(e, axis=-1, keepdims=True) + jnp.exp(sk - m))
        return jnp.einsum('bhgqk,bkhd->bqhgd', p, vi)

    o = lax.map(block, (qb, kb, vb, jnp.arange(NB)))
    return jnp.moveaxis(o, 0, 1).reshape(B, T, Hq, Dh)


def compress_tokens(t, pos_emb, w1, b1, w2, b2):
    B, T, H, Dh = t.shape
    nc = (T - CMP_BLOCK) // CMP_STRIDE + 1
    idx = jnp.arange(nc)[:, None] * CMP_STRIDE + jnp.arange(CMP_BLOCK)[None, :]
    blk = t[:, idx] + pos_emb[:, None, :]
    blk = jnp.transpose(blk, (0, 1, 3, 2, 4)).reshape(B, nc, H, CMP_BLOCK * Dh)
    hid = jax.nn.gelu(blk @ w1 + b1)
    return hid @ w2 + b2


def nsa_compressed_branch(q, kc, vc):
    T = q.shape[1]
    nc = kc.shape[1]
    s = jnp.einsum('bthgd,bnhd->bhgtn', q, kc) * HEAD_DIM ** -0.5
    blk_end = jnp.arange(nc)[None, :] * CMP_STRIDE + CMP_BLOCK - 1
    mask = blk_end <= jnp.arange(T)[:, None]
    p = jnp.where(mask, jax.nn.softmax(jnp.where(mask, s, NEG), axis=-1), 0.0)
    o = jnp.einsum('bhgtn,bnhd->bthgd', p, vc)
    return o, p


def _selection_weights():
    n_prev = CMP_BLOCK // CMP_STRIDE - 1
    offs = np.arange(-n_prev, SEL_BLOCK // CMP_STRIDE)
    start = offs * CMP_STRIDE
    shared = np.minimum(start + CMP_BLOCK, SEL_BLOCK) - np.maximum(start, 0)
    return offs, (shared / CMP_STRIDE).astype(np.float32)


def nsa_select_blocks(p_cmp):
    p = jnp.sum(p_cmp, axis=2)
    T = p.shape[2]
    nc = p.shape[3]
    ns = T // SEL_BLOCK
    offs, wts = _selection_weights()
    cidx = (SEL_BLOCK // CMP_STRIDE) * np.arange(ns)[:, None] + offs[None, :]
    valid = (cidx >= 0) & (cidx < nc)
    gathered = p[..., np.clip(cidx, 0, nc - 1)]
    importance = jnp.sum(gathered * np.where(valid, wts[None, :], 0.0).astype(np.float32), axis=-1)
    t_blk = jnp.arange(T)[:, None] // SEL_BLOCK
    j = jnp.arange(ns)[None, :]
    forced = (j == 0) | (j == t_blk) | (j == t_blk - 1)
    allowed = j <= t_blk
    score = jnp.where(forced, BIG, jnp.where(allowed, importance, -BIG))
    _, idx = lax.top_k(score, min(SEL_TOP_N, ns))
    return idx


def nsa_selected_branch(q, k, v, idx):
    B, T, Hkv, G, Dh = q.shape
    ns = T // SEL_BLOCK
    n = idx.shape[-1]
    kb = k.reshape(B, ns, SEL_BLOCK, Hkv, Dh).transpose(0, 3, 1, 2, 4)
    vb = v.reshape(B, ns, SEL_BLOCK, Hkv, Dh).transpose(0, 3, 1, 2, 4)
    Qb = SEL_QUERY_BLOCK
    nq = T // Qb
    qs = jnp.moveaxis(q.reshape(B, nq, Qb, Hkv, G, Dh), 1, 0)
    ids = jnp.moveaxis(idx.reshape(B, Hkv, nq, Qb, n), 2, 0)
    b_i = jnp.arange(B)[:, None, None, None]
    h_i = jnp.arange(Hkv)[None, :, None, None]
    within = jnp.arange(SEL_BLOCK)
    scale = Dh ** -0.5

    def block(args):
        qi, ii, qblk = args
        ks = kb[b_i, h_i, ii]
        vs = vb[b_i, h_i, ii]
        s = jnp.einsum('bqhgd,bhqnkd->bhgqnk', qi, ks) * scale
        tq = qblk * Qb + jnp.arange(Qb)
        key_pos = ii[..., None] * SEL_BLOCK + within
        mask = key_pos <= tq[None, None, :, None, None]
        s = jnp.where(mask[:, :, None], s, NEG).reshape(B, Hkv, G, Qb, n * SEL_BLOCK)
        p = jax.nn.softmax(s, axis=-1).reshape(B, Hkv, G, Qb, n, SEL_BLOCK)
        return jnp.einsum('bhgqnk,bhqnkd->bqhgd', p, vs)

    o = lax.map(block, (qs, ids, jnp.arange(nq)))
    return jnp.moveaxis(o, 0, 1).reshape(B, T, Hkv, G, Dh)


def even_mixer(xn, positions, w_in, gla_gate_up, gla_gate_bias, gla_out_norm,
               swa_q_norm, swa_k_norm, swa_sinks, w_out):
    B, T, _ = xn.shape
    proj = (xn @ w_in).astype(jnp.float32)
    gq, gk, gv, g_low, g_out, sq, sk, sv = _split(proj, L0_SPLITS)
    gq = gq.reshape(B, T, GLA_HEADS, GLA_DK) * GLA_DK ** -0.5
    gk = gk.reshape(B, T, GLA_HEADS, GLA_DK)
    gv = gv.reshape(B, T, GLA_HEADS, GLA_DV)
    log_alpha = jax.nn.log_sigmoid(g_low @ gla_gate_up + gla_gate_bias).reshape(B, T, GLA_HEADS, GLA_DK) / GLA_GATE_NORM
    o_gla = gla_chunked(gq, gk, gv, log_alpha)
    o_gla = rmsnorm(o_gla, gla_out_norm).reshape(B, T, GLA_HEADS * GLA_DV) * jax.nn.silu(g_out)
    sq = rope(rmsnorm(sq.reshape(B, T, SWA_Q_HEADS, HEAD_DIM), swa_q_norm), positions, ROPE_DIM, ROPE_THETA)
    sk = rope(rmsnorm(sk.reshape(B, T, SWA_KV_HEADS, HEAD_DIM), swa_k_norm), positions, ROPE_DIM, ROPE_THETA)
    sv = sv.reshape(B, T, SWA_KV_HEADS, HEAD_DIM)
    o_swa = banded_window_attention(sq, sk, sv, SWA_WINDOW, swa_sinks).reshape(B, T, SWA_Q_HEADS * HEAD_DIM)
    mixed = jnp.concatenate([o_gla, o_swa], axis=-1)
    return mixed.astype(xn.dtype) @ w_out


def odd_mixer(xn, positions, w_in, ret_out_norm, nsa_q_norm, nsa_kc_norm, nsa_ks_norm, nsa_kw_norm,
              cmp_k, cmp_v, w_out):
    B, T, _ = xn.shape
    G = NSA_Q_HEADS // NSA_KV_HEADS
    proj = (xn @ w_in).astype(jnp.float32)
    rq, rk, rv, rg, nq, kc, vc, ksl, vsl, kwn, vwn, ng = _split(proj, L1_SPLITS)
    rq = rope(rq.reshape(B, T, RET_HEADS, RET_DK), positions, RET_DK, RET_THETA)
    rk = rope(rk.reshape(B, T, RET_HEADS, RET_DK), positions, RET_DK, RET_THETA) * RET_DK ** -0.5
    o_ret = retention_chunked(rq, rk, rv.reshape(B, T, RET_HEADS, RET_DV))
    o_ret = head_layernorm(o_ret, ret_out_norm).reshape(B, T, RET_HEADS * RET_DV) * jax.nn.silu(rg)
    q = rope(rmsnorm(nq.reshape(B, T, NSA_Q_HEADS, HEAD_DIM), nsa_q_norm), positions, ROPE_DIM, ROPE_THETA)
    qg = q.reshape(B, T, NSA_KV_HEADS, G, HEAD_DIM)
    kc_blk = compress_tokens(kc.reshape(B, T, NSA_KV_HEADS, HEAD_DIM), *cmp_k)
    vc_blk = compress_tokens(vc.reshape(B, T, NSA_KV_HEADS, HEAD_DIM), *cmp_v)
    n_cmp = kc_blk.shape[1]
    end_pos = positions[:, np.arange(n_cmp) * CMP_STRIDE + CMP_BLOCK - 1]
    kc_blk = rope(rmsnorm(kc_blk, nsa_kc_norm), end_pos, ROPE_DIM, ROPE_THETA)
    o_cmp, p_cmp = nsa_compressed_branch(qg, kc_blk, vc_blk)
    sel_idx = nsa_select_blocks(p_cmp)
    ks = rope(rmsnorm(ksl.reshape(B, T, NSA_KV_HEADS, HEAD_DIM), nsa_ks_norm), positions, ROPE_DIM, ROPE_THETA)
    o_slc = nsa_selected_branch(qg, ks, vsl.reshape(B, T, NSA_KV_HEADS, HEAD_DIM), sel_idx)
    kw = rope(rmsnorm(kwn.reshape(B, T, NSA_KV_HEADS, HEAD_DIM), nsa_kw_norm), positions, ROPE_DIM, ROPE_THETA)
    o_win = banded_window_attention(q, kw, vwn.reshape(B, T, NSA_KV_HEADS, HEAD_DIM), NSA_WINDOW)
    o_win = o_win.reshape(B, T, NSA_KV_HEADS, G, HEAD_DIM)
    gate = jax.nn.sigmoid(ng).reshape(B, T, NSA_KV_HEADS, G, 3)
    o_nsa = gate[..., 0:1] * o_cmp + gate[..., 1:2] * o_slc + gate[..., 2:3] * o_win
    mixed = jnp.concatenate([o_ret, o_nsa.reshape(B, T, NSA_Q_HEADS * HEAD_DIM)], axis=-1)
    return mixed.astype(xn.dtype) @ w_out


def moe_swiglu(x, router_w, router_b, w_gate, w_up, w_down):
    logits = (x @ router_w).astype(jnp.float32) + router_b.astype(jnp.float32)
    top_val, top_idx = lax.top_k(logits, TOP_K)
    top_w = jax.nn.softmax(top_val, axis=-1)
    combine = jnp.sum(jax.nn.one_hot(top_idx, N_EXPERTS, dtype=jnp.float32) * top_w[..., None], axis=-2)
    out = jnp.zeros(x.shape, jnp.float32)
    for e in range(N_EXPERTS):
        out = out + combine[..., e:e + 1] * swiglu(x, w_gate[e], w_up[e], w_down[e])
    return out.astype(x.dtype)


def setup_inputs(seed: int = 0) -> dict:
    key = jax.random.key(seed)
    ks = iter(jax.random.split(key, 64))
    f32 = jnp.float32
    NE, NO = N_EVEN, N_ODD

    def dense(shape, fan_in):
        return jax.random.normal(next(ks), shape, f32) * fan_in ** -0.5

    def gain(shape):
        return 1.0 + 0.05 * jax.random.normal(next(ks), shape, f32)

    def small(shape, s):
        return s * jax.random.normal(next(ks), shape, f32)

    x = jax.random.normal(next(ks), (BATCH, SEQ, D_MODEL), f32)
    start = jax.random.randint(next(ks), (BATCH, 1), 0, 1024, dtype=jnp.int32)
    positions = start + jnp.arange(SEQ, dtype=jnp.int32)[None, :]
    return {
        'x': x,
        'positions': positions,
        'ln_mix_e': gain((NE, D_MODEL)),
        'w_in_e': dense((NE, D_MODEL, L0_IN), D_MODEL),
        'gla_gate_up': dense((NE, GLA_GATE_RANK, GLA_HEADS * GLA_DK), GLA_GATE_RANK),
        'gla_gate_bias': small((NE, GLA_HEADS * GLA_DK), 0.1),
        'gla_out_norm': gain((NE, GLA_DV)),
        'swa_q_norm': gain((NE, HEAD_DIM)),
        'swa_k_norm': gain((NE, HEAD_DIM)),
        'swa_sinks': small((NE, SWA_Q_HEADS), 0.5),
        'w_out_e': dense((NE, L0_MIX, D_MODEL), L0_MIX),
        'ln_ffn_e': gain((NE, D_MODEL)),
        'ffn_w_gate': dense((NE, D_MODEL, D_FF), D_MODEL),
        'ffn_w_up': dense((NE, D_MODEL, D_FF), D_MODEL),
        'ffn_w_down': dense((NE, D_FF, D_MODEL), D_FF),
        'ln_mix_o': gain((NO, D_MODEL)),
        'w_in_o': dense((NO, D_MODEL, L1_IN), D_MODEL),
        'ret_out_norm': gain((NO, RET_HEADS * RET_DV)),
        'nsa_q_norm': gain((NO, HEAD_DIM)),
        'nsa_kc_norm': gain((NO, HEAD_DIM)),
        'nsa_ks_norm': gain((NO, HEAD_DIM)),
        'nsa_kw_norm': gain((NO, HEAD_DIM)),
        'cmp_pos_k': small((NO, CMP_BLOCK, HEAD_DIM), 0.1),
        'cmp_w1_k': dense((NO, CMP_BLOCK * HEAD_DIM, CMP_HIDDEN), CMP_BLOCK * HEAD_DIM),
        'cmp_b1_k': small((NO, CMP_HIDDEN), 0.02),
        'cmp_w2_k': dense((NO, CMP_HIDDEN, HEAD_DIM), CMP_HIDDEN),
        'cmp_b2_k': small((NO, HEAD_DIM), 0.02),
        'cmp_pos_v': small((NO, CMP_BLOCK, HEAD_DIM), 0.1),
        'cmp_w1_v': dense((NO, CMP_BLOCK * HEAD_DIM, CMP_HIDDEN), CMP_BLOCK * HEAD_DIM),
        'cmp_b1_v': small((NO, CMP_HIDDEN), 0.02),
        'cmp_w2_v': dense((NO, CMP_HIDDEN, HEAD_DIM), CMP_HIDDEN),
        'cmp_b2_v': small((NO, HEAD_DIM), 0.02),
        'w_out_o': dense((NO, L1_MIX, D_MODEL), L1_MIX),
        'ln_ffn_o': gain((NO, D_MODEL)),
        'router_w': dense((NO, D_MODEL, N_EXPERTS), D_MODEL),
        'router_b': small((NO, N_EXPERTS), 0.01),
        'exp_w_gate': dense((NO, N_EXPERTS, D_MODEL, D_FF_EXPERT), D_MODEL),
        'exp_w_up': dense((NO, N_EXPERTS, D_MODEL, D_FF_EXPERT), D_MODEL),
        'exp_w_down': dense((NO, N_EXPERTS, D_FF_EXPERT, D_MODEL), D_FF_EXPERT),
    }


def reference(x, positions,
              ln_mix_e, w_in_e, gla_gate_up, gla_gate_bias, gla_out_norm, swa_q_norm, swa_k_norm, swa_sinks,
              w_out_e, ln_ffn_e, ffn_w_gate, ffn_w_up, ffn_w_down,
              ln_mix_o, w_in_o, ret_out_norm, nsa_q_norm, nsa_kc_norm, nsa_ks_norm, nsa_kw_norm,
              cmp_pos_k, cmp_w1_k, cmp_b1_k, cmp_w2_k, cmp_b2_k,
              cmp_pos_v, cmp_w1_v, cmp_b1_v, cmp_w2_v, cmp_b2_v,
              w_out_o, ln_ffn_o, router_w, router_b, exp_w_gate, exp_w_up, exp_w_down):
    h = x
    for layer in range(DEPTH):
        i = layer // 2
        if layer % 2 == 0:
            h = h + even_mixer(rmsnorm(h, ln_mix_e[i]), positions, w_in_e[i], gla_gate_up[i], gla_gate_bias[i],
                               gla_out_norm[i], swa_q_norm[i], swa_k_norm[i], swa_sinks[i], w_out_e[i])
            h = h + swiglu(rmsnorm(h, ln_ffn_e[i]), ffn_w_gate[i], ffn_w_up[i], ffn_w_down[i])
        else:
            cmp_k = (cmp_pos_k[i], cmp_w1_k[i], cmp_b1_k[i], cmp_w2_k[i], cmp_b2_k[i])
            cmp_v = (cmp_pos_v[i], cmp_w1_v[i], cmp_b1_v[i], cmp_w2_v[i], cmp_b2_v[i])
            h = h + odd_mixer(rmsnorm(h, ln_mix_o[i]), positions, w_in_o[i], ret_out_norm[i], nsa_q_norm[i],
                              nsa_kc_norm[i], nsa_ks_norm[i], nsa_kw_norm[i], cmp_k, cmp_v, w_out_o[i])
            h = h + moe_swiglu(rmsnorm(h, ln_ffn_o[i]), router_w[i], router_b[i],
                               exp_w_gate[i], exp_w_up[i], exp_w_down[i])
    return h
```

```cpp
#include <hip/hip_runtime.h>
#include <cstdio>
#include <cstdint>
namespace pg8 {
#define PG8_LAS __attribute__((address_space(3)))
typedef unsigned short bf16_t;
typedef short bf16x8 __attribute__((ext_vector_type(8)));
typedef float f32x4 __attribute__((ext_vector_type(4)));
typedef unsigned u32x4 __attribute__((ext_vector_type(4)));
constexpr int BM = 256, BK = 64, HALF = 128, HTB = HALF * BK * 2  , STAGE_BYTES = 8 * HTB, NXCD = 8, WGM = 8;

__host__ __device__ __forceinline__ int lds_byte(int r, int c) { const int st = (r >> 4) * 2 + (c >> 5), rr = r & 15, cc = c & 31, ob = rr * 64 + cc * 2; return st * 1024 + (ob ^ (((ob >> 9) & 1) << 5)); }
__host__ __device__ __forceinline__ void stage_rc(int b, int& R, int& C) { const int st = b / 1024, sb = b % 1024, swz = sb ^ (((sb >> 9) & 1) << 5); R = (st >> 1) * 16 + swz / 64; C = (st & 1) * 32 + (swz % 64) / 2; }
__host__ __device__ __forceinline__ int perm32(int rho) { const int n = rho >> 4, i = rho & 15; return 8 * (i >> 2) + 4 * n + (i & 3); }

struct Unit { int pm, pn, pb; };
struct Gemm { const bf16_t* A; const bf16_t* Bt; int M, N, K, lda; };

struct StaticOrder {
    int nM, nN, nwg, G, c;
    __host__ __device__ void init(int M, int N, int G_, int c_) { nM = M / BM; nN = N / BM; nwg = nM * nN; G = G_; c = c_; }
    __host__ __device__ bool next(int i, Unit& u) const {
        const long L = (long)i * G + c; if (L >= nwg) return false;
        int wgid = (int)L; { const int q = nwg / NXCD, r = nwg % NXCD, xcd = wgid % NXCD, off = wgid / NXCD; wgid = (xcd < r ? xcd * (q + 1) : r * (q + 1) + (xcd - r) * q) + off; }
        const int nig = WGM * nN, gid = wgid / nig, fm = gid * WGM, gsz = (nM - fm) < WGM ? (nM - fm) : WGM;
        u.pm = fm + ((wgid % nig) % gsz); u.pn = (wgid % nig) / gsz; u.pb = u.pn; return true;
    }
    __device__ __forceinline__ void a_ready(const Unit&) const {}
    __device__ __forceinline__ void done(const Unit&) const {}
};
struct MoeOrder {
    const int* tile_e; int t0, t1, nN, G, c;
    __device__ bool next(int i, Unit& u) const {
        const long L = (long)i * G + c; const long n = (long)(t1 - t0) * nN; if (L >= n) return false;
        u.pm = t0 + (int)(L / nN); u.pn = (int)(L % nN); u.pb = tile_e[u.pm] * nN + u.pn; return true;
    }
    __device__ __forceinline__ void a_ready(const Unit&) const {}
    __device__ __forceinline__ void done(const Unit&) const {}
};

__device__ __forceinline__ unsigned cvt_pk_bf16(float lo, float hi) { unsigned r; asm volatile("v_cvt_pk_bf16_f32 %0, %1, %2" : "=v"(r) : "v"(lo), "v"(hi)); return r; }

struct EpiBf16Plain {
    static constexpr bool PERM = true, AFTER_DRAIN = false;
    bf16_t* O; int ldc;
    __device__ __forceinline__ void operator()(const f32x4 (&acc)[2][2][4][2], const Unit& u, int wr, int wc, int fr, int fq) const {
        const int row0 = u.pm * BM + wr * 64 + fr, col0 = u.pn * BM + wc * 32 + 8 * fq;
#pragma unroll
        for (int ai = 0; ai < 2; ++ai)
#pragma unroll
            for (int m = 0; m < 4; ++m) { bf16_t* rowp = O + (size_t)(row0 + ai * HALF + m * 16) * ldc + col0;
#pragma unroll
                for (int bj = 0; bj < 2; ++bj) { const f32x4 v0 = acc[ai][bj][m][0], v1 = acc[ai][bj][m][1];
                    u32x4 w; w.x = cvt_pk_bf16(v0[0], v0[1]); w.y = cvt_pk_bf16(v0[2], v0[3]); w.z = cvt_pk_bf16(v1[0], v1[1]); w.w = cvt_pk_bf16(v1[2], v1[3]);
                    *(u32x4*)(rowp + bj * HALF) = w; } }
    }
};
struct EpiResF32 {
    static constexpr bool PERM = false, AFTER_DRAIN = false;
    const float* base; float* out; int ldc;
    __device__ __forceinline__ void operator()(const f32x4 (&acc)[2][2][4][2], const Unit& u, int wr, int wc, int fr, int fq) const {
        const int row0 = u.pm * BM + wr * 64 + fr, col0 = u.pn * BM + wc * 32 + 4 * fq;
#pragma unroll
        for (int ai = 0; ai < 2; ++ai)
#pragma unroll
            for (int m = 0; m < 4; ++m) { const size_t ro = (size_t)(row0 + ai * HALF + m * 16) * ldc + col0;
#pragma unroll
                for (int bj = 0; bj < 2; ++bj)
#pragma unroll
                    for (int n = 0; n < 2; ++n) { const size_t o = ro + bj * HALF + n * 16; const f32x4 b = *(const f32x4*)(base + o); *(f32x4*)(out + o) = b + acc[ai][bj][m][n]; } }
    }
};
struct EpiSwiglu {
    static constexpr bool PERM = true, AFTER_DRAIN = false;
    bf16_t* O; int ldc;
    __device__ __forceinline__ void operator()(const f32x4 (&acc)[2][2][4][2], const Unit& u, int wr, int wc, int fr, int fq) const {
        const int row0 = u.pm * BM + wr * 64 + fr, col0 = u.pn * HALF + wc * 32 + 8 * fq;
#pragma unroll
        for (int ai = 0; ai < 2; ++ai)
#pragma unroll
            for (int m = 0; m < 4; ++m) { bf16_t* rowp = O + (size_t)(row0 + ai * HALF + m * 16) * ldc + col0;
                float r[8];
#pragma unroll
                for (int n = 0; n < 2; ++n)
#pragma unroll
                    for (int i = 0; i < 4; ++i) { const float g = acc[ai][0][m][n][i], up = acc[ai][1][m][n][i]; r[n * 4 + i] = g * __builtin_amdgcn_rcpf(1.0f + __expf(-g)) * up; }
                u32x4 w; w.x = cvt_pk_bf16(r[0], r[1]); w.y = cvt_pk_bf16(r[2], r[3]); w.z = cvt_pk_bf16(r[4], r[5]); w.w = cvt_pk_bf16(r[6], r[7]);
                *(u32x4*)rowp = w; }
    }
};
template <class Epi, class Sched, bool ALIGN_EPI = false, bool SP2 = false>
__device__ __forceinline__ void gemm_phase(PG8_LAS unsigned char* lds, const Gemm g, const Sched& S, const Epi& E) {
    const int tid = threadIdx.x, wid = __builtin_amdgcn_readfirstlane(tid >> 6), lane = tid & 63, wr = wid >> 2, wc = wid & 3, fr = lane & 15, fq = lane >> 4;
    const int K = g.K, nt = K / BK;
    unsigned voffA[2], voffB[2];
#pragma unroll
    for (int i = 0; i < 2; ++i) { int R, C; stage_rc(tid * 16 + i * 8192, R, C); const int Rb = Epi::PERM ? ((R & ~31) + perm32(R & 31)) : R;
        voffA[i] = (unsigned)(R * g.lda + C) * 2u; voffB[i] = (unsigned)(Rb * K + C) * 2u; }
    const size_t kstep = (size_t)(BK * 2);
    const size_t hstep = (size_t)HALF * K * 2;
    const size_t tstep = 2 * hstep; const size_t hstepA = (size_t)HALF * g.lda * 2, tstepA = 2 * hstepA;
    const unsigned ldsw = (unsigned)wid * 1024u;
    const int aoff = lds_byte(wr * 64 + fr, fq * 8), boff = lds_byte(wc * 32 + fr, fq * 8);
#define PG8_SA(b, h) (((b) * 2 + (h)) * HTB)
#define PG8_SB(b, h) ((4 + (b) * 2 + (h)) * HTB)
#define PG8_STAGE(bufoff, gbase, voff) do { _Pragma("unroll") for (int _i = 0; _i < 2; ++_i) \
        __builtin_amdgcn_global_load_lds((const unsigned*)((const char*)(gbase) + (voff)[_i]), (PG8_LAS unsigned*)(lds + (bufoff) + ldsw + _i * 8192), 16, 0, 0); } while (0)
#define PG8_LDA(dst, b, h) do { _Pragma("unroll") for (int m = 0; m < 4; ++m) _Pragma("unroll") for (int k = 0; k < 2; ++k) dst[m][k] = *(const PG8_LAS bf16x8*)(lds + PG8_SA(b, h) + aoff + m * 2048 + k * 1024); } while (0)
#define PG8_LDB(dst, b, h) do { _Pragma("unroll") for (int n = 0; n < 2; ++n) _Pragma("unroll") for (int k = 0; k < 2; ++k) dst[n][k] = *(const PG8_LAS bf16x8*)(lds + PG8_SB(b, h) + boff + n * 2048 + k * 1024); } while (0)
#define PG8_MMA(ai, bj, At, Bt) do { __builtin_amdgcn_s_setprio(1); _Pragma("unroll") for (int m = 0; m < 4; ++m) _Pragma("unroll") for (int n = 0; n < 2; ++n) _Pragma("unroll") for (int k = 0; k < 2; ++k) \
        acc[ai][bj][m][n] = __builtin_amdgcn_mfma_f32_16x16x32_bf16(Bt[n][k], At[m][k], acc[ai][bj][m][n], 0, 0, 0); __builtin_amdgcn_s_setprio(0); } while (0)
#define PG8_WAIT_V(n) asm volatile("s_waitcnt vmcnt(" #n ")" ::: "memory")
#define PG8_WAIT_L(n) asm volatile("s_waitcnt lgkmcnt(" #n ")" ::: "memory")
#define PG8_BAR __builtin_amdgcn_s_barrier()
#define PG8_SCHED __builtin_amdgcn_sched_barrier(0)
    Unit cur, nxt; int ui = 0;
    if (!S.next(0, cur)) return;
    f32x4 acc[2][2][4][2];
#pragma unroll
    for (int a = 0; a < 2; ++a)
#pragma unroll
        for (int b = 0; b < 2; ++b)
#pragma unroll
            for (int m = 0; m < 4; ++m)
#pragma unroll
                for (int n = 0; n < 2; ++n) acc[a][b][m][n] = (f32x4){0.f, 0.f, 0.f, 0.f};
    bf16x8 At[4][2], B0[2][2], B1[2][2];
    const char* cA = (const char*)g.A + (size_t)cur.pm * tstepA; const char* cB = (const char*)g.Bt + (size_t)cur.pb * tstep;
    S.a_ready(cur);
    if constexpr (SP2) {
        PG8_STAGE(PG8_SB(0, 0), cB, voffB); PG8_STAGE(PG8_SB(0, 1), cB + hstep, voffB); PG8_STAGE(PG8_SA(0, 0), cA, voffA); PG8_STAGE(PG8_SA(0, 1), cA + hstepA, voffA);
        if (wr == 1) PG8_BAR;
        PG8_WAIT_V(2); PG8_BAR;
        PG8_STAGE(PG8_SB(1, 0), cB + kstep, voffB); PG8_STAGE(PG8_SA(1, 0), cA + kstep, voffA); PG8_STAGE(PG8_SB(1, 1), cB + hstep + kstep, voffB);
        PG8_WAIT_V(6); PG8_BAR;
    } else {
        PG8_STAGE(PG8_SB(0, 0), cB, voffB); PG8_STAGE(PG8_SA(0, 0), cA, voffA); PG8_STAGE(PG8_SB(0, 1), cB + hstep, voffB); PG8_STAGE(PG8_SA(0, 1), cA + hstepA, voffA);
        if (wr == 1) PG8_BAR;
        PG8_WAIT_V(4); PG8_BAR;
        PG8_STAGE(PG8_SB(1, 0), cB + kstep, voffB); PG8_STAGE(PG8_SA(1, 0), cA + kstep, voffA); PG8_STAGE(PG8_SB(1, 1), cB + hstep + kstep, voffB);
        PG8_WAIT_V(6); PG8_BAR;
    }
    for (;;) {
        const bool has_next = S.next(ui + 1, nxt);
        const char* nA = has_next ? (const char*)g.A + (size_t)nxt.pm * tstepA : cA; const char* nB = has_next ? (const char*)g.Bt + (size_t)nxt.pb * tstep : cB;
        for (int t = 0; t < nt; t += 2) {
            const bool last = (t == nt - 2);
            const char* a1 = cA + (size_t)(t + 1) * kstep;
            const char* a2 = last ? nA : cA + (size_t)(t + 2) * kstep; const char* b2 = last ? nB : cB + (size_t)(t + 2) * kstep;
            const char* a3 = a2 + kstep; const char* b3 = b2 + kstep;
            if (last && has_next) S.a_ready(nxt);
            if constexpr (SP2) {
            PG8_LDB(B0, 0, 0); PG8_LDB(B1, 0, 1); PG8_SCHED; PG8_LDA(At, 0, 0); PG8_STAGE(PG8_SA(1, 1), a1 + hstepA, voffA);
            PG8_WAIT_V(8); PG8_WAIT_L(0); PG8_BAR; PG8_MMA(0, 0, At, B0); PG8_MMA(0, 1, At, B1); PG8_BAR; PG8_SCHED;
            PG8_LDA(At, 0, 1); PG8_STAGE(PG8_SB(0, 0), b2, voffB); PG8_STAGE(PG8_SB(0, 1), b2 + hstep, voffB); PG8_STAGE(PG8_SA(0, 0), a2, voffA);
            PG8_WAIT_V(8); PG8_WAIT_L(0); PG8_BAR; PG8_MMA(1, 0, At, B0); PG8_MMA(1, 1, At, B1); PG8_BAR; PG8_SCHED;
            PG8_LDB(B0, 1, 0); PG8_LDB(B1, 1, 1); PG8_SCHED; PG8_LDA(At, 1, 0); PG8_STAGE(PG8_SA(0, 1), a2 + hstepA, voffA);
            PG8_WAIT_V(8); PG8_WAIT_L(0); PG8_BAR; PG8_MMA(0, 0, At, B0); PG8_MMA(0, 1, At, B1); PG8_BAR; PG8_SCHED;
            PG8_LDA(At, 1, 1); PG8_STAGE(PG8_SB(1, 0), b3, voffB); PG8_STAGE(PG8_SB(1, 1), b3 + hstep, voffB); PG8_STAGE(PG8_SA(1, 0), a3, voffA);
            PG8_WAIT_V(8); PG8_WAIT_L(0); PG8_BAR; PG8_MMA(1, 0, At, B0); PG8_MMA(1, 1, At, B1); PG8_BAR; PG8_SCHED;
            } else {
            PG8_LDB(B0, 0, 0); PG8_SCHED; PG8_LDA(At, 0, 0); PG8_STAGE(PG8_SA(1, 1), a1 + hstepA, voffA);
            PG8_WAIT_L(8); PG8_BAR; PG8_WAIT_L(0); PG8_MMA(0, 0, At, B0); PG8_BAR; PG8_SCHED;
            PG8_LDB(B1, 0, 1); PG8_STAGE(PG8_SB(0, 0), b2, voffB);
            PG8_BAR; PG8_WAIT_L(0); PG8_MMA(0, 1, At, B1); PG8_BAR;
            PG8_LDA(At, 0, 1); PG8_STAGE(PG8_SA(0, 0), a2, voffA);
            PG8_BAR; PG8_WAIT_L(0); PG8_MMA(1, 0, At, B0); PG8_BAR; PG8_SCHED;
            PG8_STAGE(PG8_SB(0, 1), b2 + hstep, voffB);
            PG8_WAIT_V(6); PG8_BAR; PG8_MMA(1, 1, At, B1); PG8_BAR;
            PG8_LDB(B0, 1, 0); PG8_SCHED; PG8_LDA(At, 1, 0); PG8_STAGE(PG8_SA(0, 1), a2 + hstepA, voffA);
            PG8_WAIT_L(8); PG8_BAR; PG8_WAIT_L(0); PG8_MMA(0, 0, At, B0); PG8_BAR; PG8_SCHED;
            PG8_LDB(B1, 1, 1); PG8_STAGE(PG8_SB(1, 0), b3, voffB);
            PG8_BAR; PG8_WAIT_L(0); PG8_MMA(0, 1, At, B1); PG8_BAR;
            PG8_LDA(At, 1, 1); PG8_STAGE(PG8_SA(1, 0), a3, voffA);
            PG8_BAR; PG8_WAIT_L(0); PG8_MMA(1, 0, At, B0); PG8_BAR; PG8_SCHED;
            PG8_STAGE(PG8_SB(1, 1), b3 + hstep, voffB);
            PG8_WAIT_V(6); PG8_BAR; PG8_MMA(1, 1, At, B1); PG8_BAR;
            }
        }
        if constexpr (ALIGN_EPI) { if (wr == 0) PG8_BAR; }
        if constexpr (!Epi::AFTER_DRAIN) { E(acc, cur, wr, wc, fr, fq); S.done(cur); }
        if (!has_next) break;
#pragma unroll
        for (int a = 0; a < 2; ++a)
#pragma unroll
            for (int b = 0; b < 2; ++b)
#pragma unroll
                for (int m = 0; m < 4; ++m)
#pragma unroll
                    for (int n = 0; n < 2; ++n) acc[a][b][m][n] = (f32x4){0.f, 0.f, 0.f, 0.f};
        cur = nxt; cA = nA; cB = nB; ++ui;
        if constexpr (ALIGN_EPI) { if (wr == 1) PG8_BAR; }
    }
    PG8_WAIT_V(0);
    if constexpr (!ALIGN_EPI) { if (wr == 0) PG8_BAR; }
    PG8_BAR;
    if constexpr (Epi::AFTER_DRAIN) { E.fused(acc, cur, wr, wc, fr, fq, lds, wid, lane); S.done(cur); }
#undef PG8_SA
#undef PG8_SB
#undef PG8_STAGE
#undef PG8_LDA
#undef PG8_LDB
#undef PG8_MMA
#undef PG8_WAIT_V
#undef PG8_WAIT_L
#undef PG8_BAR
#undef PG8_SCHED
}
}

constexpr int BATCH = 4, T = 4096, D = 1024, M = BATCH * T;
constexpr int N0 = 2320, N0P = 2560, N1 = 2840, N1P = 3072;
constexpr int FF = 2816, FFE = 3584, NEXP = 8;
constexpr int C0_GQ = 0, C0_GK = 256, C0_GV = 512, C0_GLOW = 1024, C0_GOUT = 1040, C0_SQ = 1552, C0_SK = 2064, C0_SV = 2192;
constexpr int C1_RQ = 0, C1_RK = 256, C1_RV = 512, C1_RG = 1024, C1_NQ = 1536, C1_KC = 2048, C1_VC = 2176, C1_KSL = 2304, C1_VSL = 2432, C1_KWN = 2560, C1_VWN = 2688, C1_NG = 2816;
constexpr float EPS = 1e-6f;
constexpr float LOG2E = 1.4426950408889634f;
constexpr int NCH = T / 64;
constexpr int NUNIT = BATCH * 4 * NCH;
constexpr int MAXTILES = 136, HALFTILES = 68, XS_ROWS = MAXTILES * 256;

constexpr size_t MiB = 1u << 20;
constexpr size_t WS_CTL = 0, CTL_ZERO_BYTES = 1 * MiB;
constexpr size_t WS_ROPE1 = 1 * MiB;
constexpr size_t WS_ROPE2 = 2 * MiB;
constexpr size_t WS_TAB = 6 * MiB;
constexpr size_t WS_CMPT = 7 * MiB;
constexpr size_t WS_WIN0 = 8 * MiB, WS_WOUT0 = 13 * MiB, WS_WGU = 15 * MiB, WS_WDN = 26 * MiB, WS_WIN1 = 32 * MiB, WS_WOUT1 = 38 * MiB, WS_WCMP = 40 * MiB;
constexpr size_t WS_MOEGU = 42 * MiB, WS_MOED = 154 * MiB;
constexpr size_t WS_XN = 210 * MiB;
constexpr size_t WS_PROJ = 242 * MiB;
constexpr size_t WS_RA = 338 * MiB;
constexpr size_t WS_END = 451 * MiB;
constexpr size_t WS_ONSA = 42 * MiB;
constexpr size_t WS_CMPH = 74 * MiB;
constexpr size_t WS_KCR = 80 * MiB, WS_VCR = 84 * MiB, WS_KW = 88 * MiB, WS_VWT = 92 * MiB;
constexpr size_t WS_QS = 338 * MiB;
constexpr size_t WS_KS = 354 * MiB;
constexpr size_t WS_VST = 358 * MiB;
constexpr size_t WS_QIN = 362 * MiB;
constexpr size_t WS_OINTRA = 370 * MiB;
constexpr size_t WS_UT = 402 * MiB;
constexpr size_t WS_DEC = 434 * MiB;
constexpr size_t WS_XS = 242 * MiB;
constexpr size_t WS_ACTH = 310 * MiB;
static_assert(WS_XS + (size_t)XS_ROWS * 1024 * 2 <= WS_ACTH && WS_ACTH + (size_t)HALFTILES * 256 * FFE * 2 <= WS_END, "moe map");
static_assert(WS_DEC + (size_t)NUNIT * 64 * 4 <= WS_END, "ws map");
constexpr size_t TB_TOKE = 0, TB_TOKW = 128 * 1024, TB_TOKR = 256 * 1024, TB_TOKS = 384 * 1024, TB_TILEE = 512 * 1024;
constexpr size_t CT_KCB = 0, CT_VCBT = 256 * 1024, CT_B1P = 512 * 1024;
constexpr int CW_BAR = 4096;
constexpr int CW_CNT = 16384;
constexpr int CW_NT = 16384 + 64;

constexpr int RING_BYTES = 131072;
constexpr int LDSCTL_OFF = RING_BYTES, MISC_OFF = LDSCTL_OFF + 320;
constexpr int LDS_BYTES = 147456;
constexpr int NWAVES = 8;

#define GAS __attribute__((address_space(1)))
#define LAS __attribute__((address_space(3)))
#define DI __device__ __forceinline__
typedef unsigned short bf16;
typedef unsigned v4u __attribute__((ext_vector_type(4)));
typedef unsigned v2u __attribute__((ext_vector_type(2)));
typedef float f32x4 __attribute__((ext_vector_type(4)));
typedef short bf16x8 __attribute__((ext_vector_type(8)));
DI unsigned f2bf(float f) { unsigned u = __builtin_bit_cast(unsigned, f); return (u + 0x7fffu + ((u >> 16) & 1u)) >> 16; }
DI unsigned pk2(float lo, float hi) { return f2bf(lo) | (f2bf(hi) << 16); }
DI float bflo(unsigned w) { return __builtin_bit_cast(float, w << 16); }
DI float bfhi(unsigned w) { return __builtin_bit_cast(float, w & 0xffff0000u); }
DI void unpack8(const v4u v, float (&x)[8]) { x[0] = bflo(v.x); x[1] = bfhi(v.x); x[2] = bflo(v.y); x[3] = bfhi(v.y); x[4] = bflo(v.z); x[5] = bfhi(v.z); x[6] = bflo(v.w); x[7] = bfhi(v.w); }
DI v4u pack8(const float (&x)[8]) { v4u v; v.x = pk2(x[0], x[1]); v.y = pk2(x[2], x[3]); v.z = pk2(x[4], x[5]); v.w = pk2(x[6], x[7]); return v; }
DI bf16x8 ldg16(const bf16* p) { return *(const bf16x8*)p; }
DI f32x4 mfma16(bf16x8 a, bf16x8 b, f32x4 c) { return __builtin_amdgcn_mfma_f32_16x16x32_bf16(a, b, c, 0, 0, 0); }
DI float wave_sum(float v) {
#pragma unroll
    for (int o = 1; o < 64; o <<= 1) v += __shfl_xor(v, o);
    return v;
}
DI float silu_f(float g) { return g / (1.0f + __expf(-g)); }

#define XB_TMO      128
#define XB_XCNT(j)  (256  + 64 * (j))
#define XB_XSUB(j)  (1280 + 64 * (j))
#define XB_XGEN(j)  (2304 + 64 * (j))
#define XB_TOP      3328
#define XB_TOPGEN   3392
#define XCD_BAR_WORDS 3456
#define XB_SPIN_CAP (1u << 18)

__device__ __forceinline__ unsigned xb_ld(unsigned* p)              { return __hip_atomic_load(p, __ATOMIC_RELAXED, __HIP_MEMORY_SCOPE_AGENT); }
__device__ __forceinline__ unsigned xb_add(unsigned* p, unsigned v) { return __hip_atomic_fetch_add(p, v, __ATOMIC_RELAXED, __HIP_MEMORY_SCOPE_AGENT); }
__device__ __forceinline__ unsigned xb_xcc_id() { return (unsigned)__builtin_amdgcn_s_getreg((3 << 11) | 20) & 0xFu; }
#define XB_SPIN(cond, bar) do { unsigned _sp = 0; while (cond) { __builtin_amdgcn_s_sleep(1); \
    if ((++_sp & 255u) == 0u) { if (xb_ld(&(bar)[XB_TMO])) break; if (_sp > XB_SPIN_CAP) { atomicAdd(&(bar)[XB_TMO], 1u); break; } } } } while (0)

struct XcdBarrier { unsigned* bar; unsigned x; volatile LAS unsigned* st; };

__device__ __forceinline__ XcdBarrier xcd_barrier_post(unsigned* bar, volatile LAS unsigned* st) {
    XcdBarrier b; b.bar = bar; b.x = xb_xcc_id(); b.st = st;
    if (threadIdx.x == 0) (void)xb_add(&bar[XB_XCNT(b.x)], 1u);
    return b;
}
__device__ __forceinline__ void xcd_barrier_complete(unsigned* bar, unsigned x, unsigned& nloc, unsigned& nx) {
    const unsigned G = gridDim.x * gridDim.y * gridDim.z;
    unsigned sum, cnt, mine, sp = 0u;
    for (;;) {
        sum = 0u; cnt = 0u; mine = 0u;
#pragma unroll
        for (unsigned j = 0; j < 16; ++j) { const unsigned c = xb_ld(&bar[XB_XCNT(j)]); sum += c; cnt += (c > 0u) ? 1u : 0u; mine = (j == x) ? c : mine; }
        if (sum == G) break;
        __builtin_amdgcn_s_sleep(1);
        if ((++sp & 255u) == 0u) { if (xb_ld(&bar[XB_TMO])) break; if (sp > XB_SPIN_CAP) { atomicAdd(&bar[XB_TMO], 1u); break; } }
    }
    nloc = mine > 0u ? mine : 1u; nx = cnt > 0u ? cnt : 1u;
}
__device__ __forceinline__ void xcd_barrier(const XcdBarrier& b) {
    asm volatile("s_waitcnt vmcnt(0)" ::: "memory");
    __syncthreads();
    if (threadIdx.x == 0) {
        unsigned* bar = b.bar;
        __builtin_amdgcn_s_waitcnt(0);
        unsigned nloc = b.st[0], nx = b.st[1];
        if (nloc == 0u) { xcd_barrier_complete(bar, b.x, nloc, nx); b.st[0] = nloc; b.st[1] = nx; }
        const unsigned old = xb_add(&bar[XB_XSUB(b.x)], 1u);
        const unsigned gen = old / nloc;
        if (old + 1u == (gen + 1u) * nloc) {
            __builtin_amdgcn_fence(__ATOMIC_RELEASE, "agent");
            asm volatile("s_waitcnt vmcnt(0)" ::: "memory");
            const unsigned og = xb_add(&bar[XB_TOP], 1u);
            const unsigned tg = og / nx;
            if (og + 1u == (tg + 1u) * nx) xb_add(&bar[XB_TOPGEN], 1u);
            else XB_SPIN(xb_ld(&bar[XB_TOPGEN]) == tg, bar);
            __builtin_amdgcn_fence(__ATOMIC_ACQUIRE, "agent");
            xb_add(&bar[XB_XGEN(b.x)], 1u);
            asm volatile("s_waitcnt vmcnt(0)" ::: "memory");
        } else {
            XB_SPIN(xb_ld(&bar[XB_XGEN(b.x)]) == gen, bar);
            __builtin_amdgcn_fence(__ATOMIC_ACQUIRE, "agent");
            asm volatile("s_waitcnt vmcnt(0)" ::: "memory");
        }
    }
    __syncthreads();
}

#define LDS_WAIT() asm volatile("s_waitcnt lgkmcnt(0)" ::: "memory")

DI void tr_item(const float* __restrict__ W, int N, bf16* __restrict__ WT, int kpitch, int drow0, int k0, int n0, const float* __restrict__ gain, LAS float* scr, int lane) {
    const int n = n0 + (lane & 31);
#pragma unroll 8
    for (int i = 0; i < 32; ++i) { const int kk = 2 * i + (lane >> 5);
        float v = (n < N) ? W[(size_t)(k0 + kk) * N + n] : 0.f; if (gain) v *= gain[k0 + kk];
        scr[kk * 33 + (lane & 31)] = v; }
    LDS_WAIT(); asm volatile("" ::: "memory");
    const int c = lane & 7;
#pragma unroll
    for (int j = 0; j < 4; ++j) { const int nn = (lane >> 3) + 8 * j; const LAS float* s = scr + (8 * c) * 33 + nn;
        v4u o; o.x = pk2(s[0 * 33], s[1 * 33]); o.y = pk2(s[2 * 33], s[3 * 33]); o.z = pk2(s[4 * 33], s[5 * 33]); o.w = pk2(s[6 * 33], s[7 * 33]);
        *(v4u*)(WT + (size_t)(drow0 + nn) * kpitch + k0 + 8 * c) = o; }
    LDS_WAIT(); asm volatile("" ::: "memory");
}
DI void conv_mat(const float* W, int K, int N, int NP, bf16* WT, int mode, const float* gain, LAS float* scr, int gw, int NGW, int lane) {
    const int nblk = NP / 32, nit = nblk * (K / 64);
    for (int it = gw; it < nit; it += NGW) { const int kb = it / nblk, nb = it - kb * nblk, n0 = nb * 32;
        const int drow0 = (mode == 0) ? n0 : ((n0 >> 7) * 256 + (n0 & 127) + (mode == 2 ? 128 : 0));
        tr_item(W, N, WT, K, drow0, kb * 64, n0, gain, scr, lane); }
}
DI void rope_tables(const int* __restrict__ pos, float* __restrict__ R1, float* __restrict__ R2, int gtid, int NT) {
    for (int idx = gtid; idx < M * 40; idx += NT) { const int m = idx / 40, i = idx - m * 40; const float p = (float)pos[m];
        float inv; if (i < 8) inv = exp2f(-(float)i * (18.931568569324174f / 8.0f)); else inv = exp2f(-(float)(i - 8) * (13.287712379549449f / 32.0f));
        double rev = (double)p * (double)inv * 0.15915494309189535; rev -= floor(rev); const float fr = (float)rev;
        const float c = __builtin_amdgcn_cosf(fr), s = __builtin_amdgcn_sinf(fr);
        if (i < 8) { R1[m * 16 + i] = c; R1[m * 16 + 8 + i] = s; } else { R2[m * 64 + (i - 8)] = c; R2[m * 64 + 32 + (i - 8)] = s; } }
}
DI void rms_row_bf16(const float* __restrict__ xrow, bf16* __restrict__ orow, int lane) {
    const f32x4* xr = (const f32x4*)xrow + lane;
    f32x4 v[4]; float s = 0.f;
#pragma unroll
    for (int j = 0; j < 4; ++j) { v[j] = xr[64 * j]; s += (v[j].x * v[j].x + v[j].y * v[j].y) + (v[j].z * v[j].z + v[j].w * v[j].w); }
    const float rstd = 1.f / sqrtf(wave_sum(s) * (1.f / D) + EPS);
    unsigned long long* o8 = (unsigned long long*)orow + lane;
#pragma unroll
    for (int j = 0; j < 4; ++j) o8[64 * j] = (unsigned long long)pk2(v[j].x * rstd, v[j].y * rstd) | ((unsigned long long)pk2(v[j].z * rstd, v[j].w * rstd) << 32);
}
DI void rms_phase(const float* src, bf16* dst, int gw, int NGW, int lane) {
    for (int m = gw; m < M; m += NGW) rms_row_bf16(src + (size_t)m * D, dst + (size_t)m * D, lane);
}
DI void cmp_bias_item(const float* __restrict__ posf, const float* __restrict__ w1, float* __restrict__ outp, int jb, int ch, int lane) {
    const int j = jb * 64 + lane; float a0 = 0.f, a1 = 0.f, a2 = 0.f, a3 = 0.f;
#pragma unroll 2
    for (int i = ch * 256; i < ch * 256 + 256; i += 4) {
        a0 += posf[i] * w1[(size_t)i * 256 + j]; a1 += posf[i + 1] * w1[(size_t)(i + 1) * 256 + j];
        a2 += posf[i + 2] * w1[(size_t)(i + 2) * 256 + j]; a3 += posf[i + 3] * w1[(size_t)(i + 3) * 256 + j]; }
    outp[ch * 256 + j] = (a0 + a1) + (a2 + a3);
}

DI void head_norm_rope(float (&x)[8], const float* __restrict__ gain, int sub, const float* __restrict__ cs) {
    float ss = 0.f;
#pragma unroll
    for (int i = 0; i < 8; ++i) ss += x[i] * x[i];
    ss += __shfl_xor(ss, 1); ss += __shfl_xor(ss, 2); ss += __shfl_xor(ss, 4);
    const float rstd = 1.f / sqrtf(ss * (1.f / 64.f) + EPS);
#pragma unroll
    for (int i = 0; i < 8; ++i) x[i] = x[i] * rstd * gain[sub * 8 + i];
#pragma unroll
    for (int i = 0; i < 8; ++i) { const float other = __shfl_xor(x[i], 1); const float c = cs[i], s = cs[8 + i];
        if (sub == 0) x[i] = x[i] * c - other * s; else if (sub == 1) x[i] = x[i] * c + other * s; }
}
DI void q8_token(const bf16* __restrict__ src, const float* __restrict__ gain, const float* __restrict__ cs, bf16* __restrict__ dst, size_t hstride, int lane) {
    const int head = lane >> 3, sub = lane & 7; float x[8];
    unpack8(*(const v4u*)(src + head * 64 + sub * 8), x);
    head_norm_rope(x, gain, sub, cs);
    *(v4u*)(dst + (size_t)head * hstride + sub * 8) = pack8(x);
}

constexpr int LP = 72;
constexpr int L_QIN = 0, L_KIN = 64 * LP * 2, L_KST = 2 * 64 * LP * 2, L_VT = 3 * 64 * LP * 2;

template <bool RET>
DI void chunk_phaseA(LAS unsigned char* lds, const bf16* __restrict__ PROJ, int ldp, int cq, int ck, int cv, int cglow,
                     const float* __restrict__ gate_up, const float* __restrict__ gate_bias, const float* __restrict__ rope2,
                     bf16* __restrict__ QIN, float* __restrict__ OINTRA, float* __restrict__ UT, float* __restrict__ DEC,
                     int lane, int w, int bid, int G) {
    const int r = lane & 15, quad = lane >> 4;
    for (int unit = bid; unit < NUNIT; unit += G) {
        const int b = unit >> 8, h = (unit >> 6) & 3, n = unit & 63;
        const int m = b * T + n * 64 + lane;
        const bf16* prow = PROJ + (size_t)m * ldp;
        float la[8];
        if (!RET) {
            float gl[16]; { float t8[8]; unpack8(*(const v4u*)(prow + cglow), t8);
#pragma unroll
                for (int i = 0; i < 8; ++i) gl[i] = t8[i];
                unpack8(*(const v4u*)(prow + cglow + 8), t8);
#pragma unroll
                for (int i = 0; i < 8; ++i) gl[8 + i] = t8[i]; }
#pragma unroll
            for (int cc = 0; cc < 8; ++cc) { const int c = h * 64 + 8 * w + cc; float x = gate_bias[c];
#pragma unroll
                for (int rr = 0; rr < 16; ++rr) x += gl[rr] * gate_up[rr * 256 + c];
                la[cc] = (fminf(x, 0.f) - log1pf(expf(-fabsf(x)))) * (1.f / 16.f); }
        } else {
            const float lg = logf(1.f - exp2f(-5.f - (float)h));
#pragma unroll
            for (int cc = 0; cc < 8; ++cc) la[cc] = lg;
        }
        float bl[8];
#pragma unroll
        for (int cc = 0; cc < 8; ++cc) { float v = la[cc];
#pragma unroll
            for (int off = 1; off < 64; off <<= 1) { const float t = __shfl_up(v, off); if (lane >= off) v += t; }
            la[cc] = v; bl[cc] = __shfl(v, 63); }
        float q[8], k[8];
        if (!RET) {
            unpack8(*(const v4u*)(prow + cq + h * 64 + 8 * w), q); unpack8(*(const v4u*)(prow + ck + h * 64 + 8 * w), k);
#pragma unroll
            for (int i = 0; i < 8; ++i) q[i] *= 0.125f;
        } else {
            const int c0 = 8 * w, cp = (c0 + 32) & 63; float qp[8], kp[8];
            unpack8(*(const v4u*)(prow + cq + h * 64 + c0), q); unpack8(*(const v4u*)(prow + cq + h * 64 + cp), qp);
            unpack8(*(const v4u*)(prow + ck + h * 64 + c0), k); unpack8(*(const v4u*)(prow + ck + h * 64 + cp), kp);
            const float* cs = rope2 + (size_t)m * 64 + (c0 & 31);
#pragma unroll
            for (int i = 0; i < 8; ++i) { const float c = cs[i], s = cs[32 + i];
                if (c0 < 32) { q[i] = q[i] * c - qp[i] * s; k[i] = (k[i] * c - kp[i] * s) * 0.125f; }
                else         { q[i] = q[i] * c + qp[i] * s; k[i] = (k[i] * c + kp[i] * s) * 0.125f; } }
        }
        float qin[8], kin[8];
        LAS bf16* kst = (LAS bf16*)(lds + L_KST);
#pragma unroll
        for (int cc = 0; cc < 8; ++cc) { qin[cc] = q[cc] * expf(la[cc]); kin[cc] = k[cc] * expf(-la[cc]);
            kst[(8 * w + cc) * LP + lane] = (bf16)f2bf(k[cc] * expf(bl[cc] - la[cc])); }
        const v4u qv = pack8(qin), kv = pack8(kin);
        *(LAS v4u*)(lds + L_QIN + (lane * LP + 8 * w) * 2) = qv;
        *(LAS v4u*)(lds + L_KIN + (lane * LP + 8 * w) * 2) = kv;
        *(v4u*)(QIN + (size_t)unit * 4096 + lane * 64 + 8 * w) = qv;
        if (lane == 63) {
#pragma unroll
            for (int cc = 0; cc < 8; ++cc) DEC[(size_t)unit * 64 + 8 * w + cc] = expf(bl[cc]); }
        { float v0[8], v1[8]; unpack8(*(const v4u*)(prow + cv + h * 128 + 16 * w), v0); unpack8(*(const v4u*)(prow + cv + h * 128 + 16 * w + 8), v1);
            LAS bf16* vt = (LAS bf16*)(lds + L_VT);
#pragma unroll
            for (int i = 0; i < 8; ++i) { vt[(16 * w + i) * LP + lane] = (bf16)f2bf(v0[i]); vt[(16 * w + 8 + i) * LP + lane] = (bf16)f2bf(v1[i]); } }
        __syncthreads();
        {
            const int tt = w & 3, dh = w >> 2;
            const bf16x8 qf0 = *(const LAS bf16x8*)(lds + L_QIN + ((tt * 16 + r) * LP + quad * 8) * 2), qf1 = *(const LAS bf16x8*)(lds + L_QIN + ((tt * 16 + r) * LP + 32 + quad * 8) * 2);
            f32x4 acc[4];
#pragma unroll
            for (int d4 = 0; d4 < 4; ++d4) acc[d4] = (f32x4){0.f, 0.f, 0.f, 0.f};
            const int nks = (tt >> 1) + 1;
            for (int ks = 0; ks < nks; ++ks) { const int kb = 32 * ks, krow = kb + ((r >> 2) << 3) + (r & 3);
                const LAS unsigned char* kp = lds + L_KIN + (krow * LP + quad * 8) * 2;
                const bf16x8 k00 = *(const LAS bf16x8*)kp, k01 = *(const LAS bf16x8*)(kp + 64), k10 = *(const LAS bf16x8*)(kp + 4 * LP * 2), k11 = *(const LAS bf16x8*)(kp + 4 * LP * 2 + 64);
                f32x4 s0 = mfma16(k00, qf0, (f32x4){0.f, 0.f, 0.f, 0.f}); s0 = mfma16(k01, qf1, s0);
                f32x4 s1 = mfma16(k10, qf0, (f32x4){0.f, 0.f, 0.f, 0.f}); s1 = mfma16(k11, qf1, s1);
                const int tok = tt * 16 + r, key0 = kb + 8 * quad; float p[8];
#pragma unroll
                for (int jj = 0; jj < 4; ++jj) { p[jj] = (key0 + jj <= tok) ? s0[jj] : 0.f; p[4 + jj] = (key0 + 4 + jj <= tok) ? s1[jj] : 0.f; }
                const bf16x8 pf = __builtin_bit_cast(bf16x8, pack8(p));
#pragma unroll
                for (int d4 = 0; d4 < 4; ++d4) { const bf16x8 vf = *(const LAS bf16x8*)(lds + L_VT + ((dh * 64 + d4 * 16 + r) * LP + kb + quad * 8) * 2); acc[d4] = mfma16(vf, pf, acc[d4]); }
            }
#pragma unroll
            for (int d4 = 0; d4 < 4; ++d4) *(f32x4*)(OINTRA + (size_t)unit * 8192 + (tt * 16 + r) * 128 + dh * 64 + d4 * 16 + 4 * quad) = acc[d4];
        }
        {
#pragma unroll
            for (int dkt = 0; dkt < 4; ++dkt) { f32x4 au = (f32x4){0.f, 0.f, 0.f, 0.f};
#pragma unroll
                for (int ks = 0; ks < 2; ++ks) { const bf16x8 a = *(const LAS bf16x8*)(lds + L_VT + ((16 * w + r) * LP + 32 * ks + quad * 8) * 2);
                    const bf16x8 bq = *(const LAS bf16x8*)(lds + L_KST + ((dkt * 16 + r) * LP + 32 * ks + quad * 8) * 2); au = mfma16(a, bq, au); }
#pragma unroll
                for (int i = 0; i < 4; ++i) UT[(size_t)unit * 8192 + (16 * w + 4 * quad + i) * 64 + dkt * 16 + r] = au[i]; }
        }
        __syncthreads();
    }
}
DI void chunk_scan(float* __restrict__ UT, const float* __restrict__ DEC, int gtid, int NT) {
    for (int e = gtid; e < 16 * 8192; e += NT) { const int bh = e >> 13, idx = e & 8191, dk = idx & 63; float S = 0.f;
        float* up = UT + (size_t)bh * 64 * 8192 + idx; const float* dp = DEC + (size_t)bh * 64 * 64 + dk;
#pragma unroll 8
        for (int n = 0; n < 64; ++n) { const float u = up[(size_t)n * 8192], d = dp[n * 64]; up[(size_t)n * 8192] = S; S = d * S + u; } }
}
template <bool RET>
DI void chunk_phaseC(const bf16* __restrict__ QIN, const float* __restrict__ OINTRA, const float* __restrict__ UT, const bf16* __restrict__ PROJ, int ldp, int cgate,
                     const float* __restrict__ gnorm, bf16* __restrict__ MIXED, int gw, int NGW, int lane) {
    const int r = lane & 15, quad = lane >> 4;
    for (int wu = gw; wu < NUNIT * 4; wu += NGW) { const int unit = wu >> 2, tt = wu & 3; const int b = unit >> 8, h = (unit >> 6) & 3, n = unit & 63;
        const bf16* qp = QIN + (size_t)unit * 4096 + (tt * 16 + r) * 64 + quad * 8; const bf16x8 qf0 = ldg16(qp), qf1 = ldg16(qp + 32);
        f32x4 acc[8];
#pragma unroll
        for (int dt = 0; dt < 8; ++dt) { acc[dt] = *(const f32x4*)(OINTRA + (size_t)unit * 8192 + (tt * 16 + r) * 128 + dt * 16 + 4 * quad);
#pragma unroll
            for (int kk = 0; kk < 2; ++kk) { const float* sp = UT + (size_t)unit * 8192 + (dt * 16 + r) * 64 + kk * 32 + quad * 8; const f32x4 a = *(const f32x4*)sp, c = *(const f32x4*)(sp + 4);
                v4u pa; pa.x = pk2(a[0], a[1]); pa.y = pk2(a[2], a[3]); pa.z = pk2(c[0], c[1]); pa.w = pk2(c[2], c[3]);
                acc[dt] = mfma16(__builtin_bit_cast(bf16x8, pa), kk ? qf1 : qf0, acc[dt]); } }
        const int m = b * T + n * 64 + tt * 16 + r;
        float mean = 0.f;
        if (RET) { float s = 0.f;
#pragma unroll
            for (int dt = 0; dt < 8; ++dt) s += (acc[dt][0] + acc[dt][1]) + (acc[dt][2] + acc[dt][3]);
            s += __shfl_xor(s, 16); s += __shfl_xor(s, 32); mean = s * (1.f / 128.f); }
        float ss = 0.f;
#pragma unroll
        for (int dt = 0; dt < 8; ++dt)
#pragma unroll
            for (int i = 0; i < 4; ++i) { const float d = acc[dt][i] - mean; ss += d * d; }
        ss += __shfl_xor(ss, 16); ss += __shfl_xor(ss, 32);
        const float rstd = 1.f / sqrtf(ss * (1.f / 128.f) + EPS);
#pragma unroll
        for (int dt = 0; dt < 8; ++dt) { const int dv = dt * 16 + 4 * quad;
            const v2u gv = *(const v2u*)(PROJ + (size_t)m * ldp + cgate + h * 128 + dv);
            const float g0 = bflo(gv.x), g1 = bfhi(gv.x), g2 = bflo(gv.y), g3 = bfhi(gv.y);
            const float* gn = gnorm + (RET ? h * 128 : 0) + dv;
            const float y0 = (acc[dt][0] - mean) * rstd * gn[0] * silu_f(g0), y1 = (acc[dt][1] - mean) * rstd * gn[1] * silu_f(g1);
            const float y2 = (acc[dt][2] - mean) * rstd * gn[2] * silu_f(g2), y3 = (acc[dt][3] - mean) * rstd * gn[3] * silu_f(g3);
            v2u o; o.x = pk2(y0, y1); o.y = pk2(y2, y3);
            *(v2u*)(MIXED + (size_t)m * 1024 + h * 128 + dv) = o; }
    }
}

DI void attn_step(const bf16* __restrict__ Kb, const bf16* __restrict__ VTb, int Tv, int kb, unsigned vm, const bf16x8 (&qf)[4][2],
                  f32x4 (&acc)[4][4], float (&mrow)[4], float (&lrow)[4], int r, int quad, float sc2) {
    const bf16* kp = Kb + (size_t)(kb + ((r >> 2) << 3) + (r & 3)) * 64 + quad * 8;
    const bf16x8 k00 = ldg16(kp), k01 = ldg16(kp + 32), k10 = ldg16(kp + 256), k11 = ldg16(kp + 288);
    const bf16* vp = VTb + (size_t)r * Tv + kb + quad * 8;
    bf16x8 vf[4];
#pragma unroll
    for (int dt = 0; dt < 4; ++dt) vf[dt] = ldg16(vp + (size_t)dt * 16 * Tv);
#pragma unroll
    for (int g = 0; g < 4; ++g) {
        f32x4 s0 = mfma16(k00, qf[g][0], (f32x4){0.f, 0.f, 0.f, 0.f}); s0 = mfma16(k01, qf[g][1], s0);
        f32x4 s1 = mfma16(k10, qf[g][0], (f32x4){0.f, 0.f, 0.f, 0.f}); s1 = mfma16(k11, qf[g][1], s1);
        float sv[8]; float mx = -1e30f;
#pragma unroll
        for (int jj = 0; jj < 8; ++jj) { sv[jj] = (jj < 4 ? s0[jj & 3] : s1[jj & 3]) * sc2; if ((vm >> jj) & 1u) mx = fmaxf(mx, sv[jj]); }
        mx = fmaxf(mx, __shfl_xor(mx, 16)); mx = fmaxf(mx, __shfl_xor(mx, 32));
        const float mnew = fmaxf(mrow[g], mx), alpha = __builtin_amdgcn_exp2f(mrow[g] - mnew);
        float p[8]; float ls = 0.f;
#pragma unroll
        for (int jj = 0; jj < 8; ++jj) { p[jj] = ((vm >> jj) & 1u) ? __builtin_amdgcn_exp2f(sv[jj] - mnew) : 0.f; ls += p[jj]; }
        ls += __shfl_xor(ls, 16); ls += __shfl_xor(ls, 32);
        lrow[g] = lrow[g] * alpha + ls; mrow[g] = mnew;
        const bf16x8 pf = __builtin_bit_cast(bf16x8, pack8(p));
#pragma unroll
        for (int dt = 0; dt < 4; ++dt) acc[g][dt] = mfma16(vf[dt], pf, acc[g][dt] * alpha);
    }
}
DI unsigned win_mask(int kb, int quad, int tok, int W) { unsigned vm = 0u;
#pragma unroll
    for (int jj = 0; jj < 8; ++jj) { const int key = kb + 8 * quad + jj; if (key <= tok && key > tok - W) vm |= 1u << jj; }
    return vm; }
DI void load_q(bf16x8 (&qf)[4][2], const bf16* __restrict__ Q, int b, int hk, int t0, int r, int quad) {
#pragma unroll
    for (int g = 0; g < 4; ++g) { const bf16* qp = Q + ((size_t)(b * 8 + hk * 4 + g) * T + t0 + r) * 64 + quad * 8; qf[g][0] = ldg16(qp); qf[g][1] = ldg16(qp + 32); }
}
template <bool SINK, bool TO_MIXED>
DI void window_attn(const bf16* __restrict__ Q, const bf16* __restrict__ Kx, const bf16* __restrict__ VT, int W, const float* __restrict__ sinks,
                    bf16* __restrict__ MIXED, float* __restrict__ ONSA, const bf16* __restrict__ PROJ1, int gw, int NGW, int lane) {
    const int r = lane & 15, quad = lane >> 4; const float sc2 = 0.125f * LOG2E;
    for (int wu = gw; wu < BATCH * 2 * 256; wu += NGW) { const int tile = wu & 255, hk = (wu >> 8) & 1, b = wu >> 9, t0 = tile * 16, tok = t0 + r;
        bf16x8 qf[4][2]; load_q(qf, Q, b, hk, t0, r, quad);
        f32x4 acc[4][4]; float mrow[4], lrow[4];
#pragma unroll
        for (int g = 0; g < 4; ++g) { mrow[g] = SINK ? sinks[hk * 4 + g] * LOG2E : -1e30f; lrow[g] = SINK ? 1.f : 0.f;
#pragma unroll
            for (int dt = 0; dt < 4; ++dt) acc[g][dt] = (f32x4){0.f, 0.f, 0.f, 0.f}; }
        const bf16* Kb = Kx + (size_t)(b * 2 + hk) * T * 64; const bf16* VTb = VT + (size_t)(b * 2 + hk) * 64 * T;
        int kb0 = t0 - (W - 1); kb0 = kb0 < 0 ? 0 : (kb0 & ~31);
        for (int kb = kb0; kb <= t0; kb += 32) attn_step(Kb, VTb, T, kb, win_mask(kb, quad, tok, W), qf, acc, mrow, lrow, r, quad, sc2);
        const size_t m = (size_t)b * T + tok;
#pragma unroll
        for (int g = 0; g < 4; ++g) { float inv = lrow[g] > 0.f ? 1.f / lrow[g] : 0.f;
            if (!TO_MIXED) { const float gl = __builtin_bit_cast(float, ((unsigned)PROJ1[m * N1P + C1_NG + hk * 12 + g * 3 + 2]) << 16); inv *= 1.f / (1.f + __expf(-gl)); }
#pragma unroll
            for (int dt = 0; dt < 4; ++dt) { const f32x4 o = acc[g][dt] * inv; const int col = (hk * 4 + g) * 64 + dt * 16 + 4 * quad;
                if (TO_MIXED) { v2u w2; w2.x = pk2(o[0], o[1]); w2.y = pk2(o[2], o[3]); *(v2u*)(MIXED + m * 1024 + 512 + col) = w2; }
                else *(f32x4*)(ONSA + m * 512 + col) = o; } }
    }
}

DI void nsa_cmp_slc(const bf16* __restrict__ Q, const bf16* __restrict__ KCB, const bf16* __restrict__ VCBT, const bf16* __restrict__ KSL, const bf16* __restrict__ VSLT,
                    const bf16* __restrict__ PROJ1, float* __restrict__ ONSA, bf16* __restrict__ MIXED, LAS float* plds, int gw, int NGW, int lane) {
    const int r = lane & 15, quad = lane >> 4; const float sc2 = 0.125f * LOG2E;
    for (int wu = gw; wu < BATCH * 2 * 256; wu += NGW) { const int tile = wu & 255, hk = (wu >> 8) & 1, b = wu >> 9, t0 = tile * 16, tok = t0 + r;
        bf16x8 qf[4][2]; load_q(qf, Q, b, hk, t0, r, quad);
        const size_t m = (size_t)b * T + tok;
        float gate0[4], gate1[4];
#pragma unroll
        for (int g = 0; g < 4; ++g) { const bf16* gp = PROJ1 + m * N1P + C1_NG + hk * 12 + g * 3;
            gate0[g] = 1.f / (1.f + __expf(-__builtin_bit_cast(float, ((unsigned)gp[0]) << 16))); gate1[g] = 1.f / (1.f + __expf(-__builtin_bit_cast(float, ((unsigned)gp[1]) << 16))); }
#pragma unroll
        for (int i = 0; i < 16; ++i) *(LAS f32x4*)(plds + (i * 64 + lane) * 4) = (f32x4){0.f, 0.f, 0.f, 0.f};
        const bf16* Kc = KCB + (size_t)(b * 2 + hk) * 256 * 64; const bf16* Vc = VCBT + (size_t)(b * 2 + hk) * 64 * 256;
        const int nsteps = ((t0 >> 4) + 31) >> 5;
        float mrow[4], lrow[4];
#pragma unroll
        for (int g = 0; g < 4; ++g) { mrow[g] = -1e30f; lrow[g] = 0.f; }
        for (int st = 0; st < nsteps; ++st) { const int kb = 32 * st;
            const bf16* kp = Kc + (size_t)(kb + ((r >> 2) << 3) + (r & 3)) * 64 + quad * 8;
            const bf16x8 k00 = ldg16(kp), k01 = ldg16(kp + 32), k10 = ldg16(kp + 256), k11 = ldg16(kp + 288);
            unsigned vm = 0u;
#pragma unroll
            for (int jj = 0; jj < 8; ++jj) if (16 * (kb + 8 * quad + jj) + 31 <= tok) vm |= 1u << jj;
#pragma unroll
            for (int g = 0; g < 4; ++g) {
                f32x4 s0 = mfma16(k00, qf[g][0], (f32x4){0.f, 0.f, 0.f, 0.f}); s0 = mfma16(k01, qf[g][1], s0);
                f32x4 s1 = mfma16(k10, qf[g][0], (f32x4){0.f, 0.f, 0.f, 0.f}); s1 = mfma16(k11, qf[g][1], s1);
                float sv[8]; float mx = -1e30f;
#pragma unroll
                for (int jj = 0; jj < 8; ++jj) { sv[jj] = (jj < 4 ? s0[jj & 3] : s1[jj & 3]) * sc2; if ((vm >> jj) & 1u) mx = fmaxf(mx, sv[jj]); }
                mx = fmaxf(mx, __shfl_xor(mx, 16)); mx = fmaxf(mx, __shfl_xor(mx, 32));
                const float mnew = fmaxf(mrow[g], mx), alpha = __builtin_amdgcn_exp2f(mrow[g] - mnew); float ls = 0.f;
#pragma unroll
                for (int jj = 0; jj < 8; ++jj) ls += ((vm >> jj) & 1u) ? __builtin_amdgcn_exp2f(sv[jj] - mnew) : 0.f;
                ls += __shfl_xor(ls, 16); ls += __shfl_xor(ls, 32);
                lrow[g] = lrow[g] * alpha + ls; mrow[g] = mnew; } }
        float invl[4];
#pragma unroll
        for (int g = 0; g < 4; ++g) invl[g] = lrow[g] > 0.f ? 1.f / lrow[g] : 0.f;
        f32x4 acc[4][4];
#pragma unroll
        for (int g = 0; g < 4; ++g)
#pragma unroll
            for (int dt = 0; dt < 4; ++dt) acc[g][dt] = (f32x4){0.f, 0.f, 0.f, 0.f};
        for (int st = 0; st < nsteps; ++st) { const int kb = 32 * st;
            const bf16* kp = Kc + (size_t)(kb + ((r >> 2) << 3) + (r & 3)) * 64 + quad * 8;
            const bf16x8 k00 = ldg16(kp), k01 = ldg16(kp + 32), k10 = ldg16(kp + 256), k11 = ldg16(kp + 288);
            const bf16* vp = Vc + (size_t)r * 256 + kb + quad * 8;
            bf16x8 vf[4];
#pragma unroll
            for (int dt = 0; dt < 4; ++dt) vf[dt] = ldg16(vp + (size_t)dt * 16 * 256);
            unsigned vm = 0u;
#pragma unroll
            for (int jj = 0; jj < 8; ++jj) if (16 * (kb + 8 * quad + jj) + 31 <= tok) vm |= 1u << jj;
            float psum[8];
#pragma unroll
            for (int jj = 0; jj < 8; ++jj) psum[jj] = 0.f;
#pragma unroll
            for (int g = 0; g < 4; ++g) {
                f32x4 s0 = mfma16(k00, qf[g][0], (f32x4){0.f, 0.f, 0.f, 0.f}); s0 = mfma16(k01, qf[g][1], s0);
                f32x4 s1 = mfma16(k10, qf[g][0], (f32x4){0.f, 0.f, 0.f, 0.f}); s1 = mfma16(k11, qf[g][1], s1);
                float p[8];
#pragma unroll
                for (int jj = 0; jj < 8; ++jj) { const float s = (jj < 4 ? s0[jj & 3] : s1[jj & 3]) * sc2; p[jj] = ((vm >> jj) & 1u) ? __builtin_amdgcn_exp2f(s - mrow[g]) * invl[g] : 0.f; psum[jj] += p[jj]; }
                const bf16x8 pf = __builtin_bit_cast(bf16x8, pack8(p));
#pragma unroll
                for (int dt = 0; dt < 4; ++dt) acc[g][dt] = mfma16(vf[dt], pf, acc[g][dt]); }
            *(LAS f32x4*)(plds + r * 256 + kb + 8 * quad) = (f32x4){psum[0], psum[1], psum[2], psum[3]};
            *(LAS f32x4*)(plds + r * 256 + kb + 8 * quad + 4) = (f32x4){psum[4], psum[5], psum[6], psum[7]}; }
#pragma unroll
        for (int g = 0; g < 4; ++g)
#pragma unroll
            for (int dt = 0; dt < 4; ++dt) { float* op = ONSA + m * 512 + (hk * 4 + g) * 64 + dt * 16 + 4 * quad; *(f32x4*)op = *(const f32x4*)op + acc[g][dt] * gate0[g]; }
        LDS_WAIT(); asm volatile("" ::: "memory"); __builtin_amdgcn_wave_barrier();
        unsigned long long mymask = 0ull, uni = 0ull;
        for (int tk = 0; tk < 16; ++tk) { const int tblk = (t0 + tk) >> 6, j = lane; const LAS float* pr = plds + tk * 256 + 4 * j;
            const f32x4 pv = *(const LAS f32x4*)pr; const float pm1 = (j > 0) ? pr[-1] : 0.f;
            const float imp = pm1 + 2.f * pv[0] + 2.f * pv[1] + 2.f * pv[2] + pv[3];
            const bool forced = (j == 0) || (j == tblk) || (j == tblk - 1), allowed = j <= tblk;
            const float score = forced ? 1e9f : (allowed ? imp : -1e9f);
            int rank = 0;
#pragma unroll
            for (int i = 0; i < 64; ++i) { const float si = __builtin_bit_cast(float, __builtin_amdgcn_readlane(__builtin_bit_cast(int, score), i)); rank += ((si > score) || (si == score && i < j)) ? 1 : 0; }
            const unsigned long long mask = __ballot((rank < 16) && allowed);
            if (r == tk) mymask = mask;
            uni |= mask; }
#pragma unroll
        for (int g = 0; g < 4; ++g) { mrow[g] = -1e30f; lrow[g] = 0.f;
#pragma unroll
            for (int dt = 0; dt < 4; ++dt) acc[g][dt] = (f32x4){0.f, 0.f, 0.f, 0.f}; }
        const bf16* Kb = KSL + (size_t)(b * 2 + hk) * T * 64; const bf16* VTb = VSLT + (size_t)(b * 2 + hk) * 64 * T;
        while (uni) { const int j = __builtin_ctzll(uni); uni &= uni - 1ull; const bool sb = (mymask >> j) & 1ull;
#pragma unroll
            for (int hf = 0; hf < 2; ++hf) { const int kb = 64 * j + 32 * hf; unsigned vm = 0u;
#pragma unroll
                for (int jj = 0; jj < 8; ++jj) if (sb && (kb + 8 * quad + jj <= tok)) vm |= 1u << jj;
                attn_step(Kb, VTb, T, kb, vm, qf, acc, mrow, lrow, r, quad, sc2); } }
#pragma unroll
        for (int g = 0; g < 4; ++g) { const float inv = (lrow[g] > 0.f ? 1.f / lrow[g] : 0.f) * gate1[g];
#pragma unroll
            for (int dt = 0; dt < 4; ++dt) { const int col = (hk * 4 + g) * 64 + dt * 16 + 4 * quad; const f32x4 o = *(const f32x4*)(ONSA + m * 512 + col) + acc[g][dt] * inv;
                v2u w2; w2.x = pk2(o[0], o[1]); w2.y = pk2(o[2], o[3]); *(v2u*)(MIXED + m * 1024 + 512 + col) = w2; } }
        __builtin_amdgcn_wave_barrier();
    }
}
DI void cmp_layer1(const bf16* __restrict__ KCR, const bf16* __restrict__ VCR, const bf16* __restrict__ WCMP, const float* __restrict__ B1P, const float* __restrict__ b1k, const float* __restrict__ b1v, float* __restrict__ CMPH, int gw, int NGW, int lane) {
    const int r = lane & 15, quad = lane >> 4;
    for (int wu = gw; wu < 4096; wu += NGW) { const int kv = wu >> 11, rt = (wu >> 4) & 127, ct = wu & 15;
        const bf16* ap = (kv ? VCR : KCR) + (size_t)(rt * 16 + r) * 1024 + quad * 8; const bf16* bp = WCMP + (size_t)kv * 256 * 2048 + (size_t)(ct * 16 + r) * 2048 + quad * 8;
        f32x4 acc = (f32x4){0.f, 0.f, 0.f, 0.f};
#pragma unroll 8
        for (int kk = 0; kk < 64; ++kk) acc = mfma16(ldg16(ap + kk * 32), ldg16(bp + kk * 32), acc);
        float bias = (kv ? b1v : b1k)[ct * 16 + r];
#pragma unroll
        for (int c = 0; c < 8; ++c) bias += B1P[(kv * 8 + c) * 256 + ct * 16 + r];
#pragma unroll
        for (int i = 0; i < 4; ++i) CMPH[((size_t)kv * 2048 + rt * 16 + 4 * quad + i) * 256 + ct * 16 + r] = acc[i] + bias; }
}
DI float gelu_tanh(float x) { const float u = 0.7978845608028654f * (x + 0.044715f * x * x * x); const float e = __expf(2.f * u); const float th = 1.f - 2.f / (e + 1.f); return 0.5f * x * (1.f + th); }
DI void cmp_layer2(const float* __restrict__ CMPH, const float* __restrict__ w2k, const float* __restrict__ b2k, const float* __restrict__ w2v, const float* __restrict__ b2v,
                   const float* __restrict__ kcnorm, const float* __restrict__ rope1, bf16* __restrict__ KCB, bf16* __restrict__ VCBT, int gw, int NGW, int lane) {
    for (int wu = gw; wu < 4096; wu += NGW) { const int kv = wu >> 11, row = wu & 2047, bh = row >> 8, n = row & 255;
        if (n == 255) { if (kv == 0) KCB[((size_t)bh * 256 + 255) * 64 + lane] = 0; else VCBT[((size_t)bh * 64 + lane) * 256 + 255] = 0; continue; }
        const float* hrow = CMPH + ((size_t)kv * 2048 + row) * 256; const float* w2 = kv ? w2v : w2k;
        float g4[4];
#pragma unroll
        for (int i = 0; i < 4; ++i) g4[i] = gelu_tanh(hrow[lane + 64 * i]);
        float acc = (kv ? b2v : b2k)[lane];
#pragma unroll
        for (int i = 0; i < 4; ++i)
#pragma unroll 16
            for (int j = 0; j < 64; ++j) { const float gj = __builtin_bit_cast(float, __builtin_amdgcn_readlane(__builtin_bit_cast(int, g4[i]), j)); acc += gj * w2[(size_t)(i * 64 + j) * 64 + lane]; }
        if (kv == 0) { const float ss = wave_sum(acc * acc); float y = acc * (1.f / sqrtf(ss * (1.f / 64.f) + EPS)) * kcnorm[lane];
            const int b = bh >> 1; const float* cs = rope1 + ((size_t)b * T + 16 * n + 31) * 16; const float other = __shfl_xor(y, 8);
            if (lane < 8) y = y * cs[lane] - other * cs[8 + lane]; else if (lane < 16) y = y * cs[lane - 8] + other * cs[lane];
            KCB[((size_t)bh * 256 + n) * 64 + lane] = (bf16)f2bf(y);
        } else VCBT[((size_t)bh * 64 + lane) * 256 + n] = (bf16)f2bf(acc);
    }
}

DI void prep0_swa(const bf16* __restrict__ PROJ, const float* __restrict__ qn, const float* __restrict__ kn, const float* __restrict__ rope1,
                  bf16* __restrict__ QS, bf16* __restrict__ KS, bf16* __restrict__ VST, int lane, int w, int bid, int G) {
    for (int grp = bid; grp < M / 64; grp += G) { const int m0 = grp * 64, b = m0 / T, t0 = m0 % T;
        for (int i = 0; i < 8; ++i) { const int tl = 8 * w + i; const size_t m = (size_t)m0 + tl;
            q8_token(PROJ + m * N0P + C0_SQ, qn, rope1 + m * 16, QS + ((size_t)(b * 8) * T + t0 + tl) * 64, (size_t)T * 64, lane); }
        for (int p = 0; p < 2; ++p) { const int tl = 8 * w + 4 * p + (lane >> 4), head = (lane >> 3) & 1, sub = lane & 7; const size_t m = (size_t)m0 + tl; float x[8];
            unpack8(*(const v4u*)(PROJ + m * N0P + C0_SK + head * 64 + sub * 8), x); head_norm_rope(x, kn, sub, rope1 + m * 16);
            *(v4u*)(KS + ((size_t)(b * 2 + head) * T + t0 + tl) * 64 + sub * 8) = pack8(x); }
        { const size_t m = (size_t)m0 + lane; const v4u a = *(const v4u*)(PROJ + m * N0P + C0_SV + 16 * w), c = *(const v4u*)(PROJ + m * N0P + C0_SV + 16 * w + 8);
            const unsigned wv[8] = {a.x, a.y, a.z, a.w, c.x, c.y, c.z, c.w};
#pragma unroll
            for (int i = 0; i < 16; ++i) { const int hd = 16 * w + i; VST[((size_t)(b * 2 + (hd >> 6)) * 64 + (hd & 63)) * T + t0 + lane] = (bf16)((i & 1) ? (wv[i >> 1] >> 16) : (wv[i >> 1] & 0xffffu)); } }
    }
}
DI void prep1_nsa(const bf16* __restrict__ PROJ, const float* __restrict__ qn, const float* __restrict__ ksn, const float* __restrict__ kwn, const float* __restrict__ rope1,
                  bf16* __restrict__ QS, bf16* __restrict__ KS, bf16* __restrict__ KW, bf16* __restrict__ KCR, bf16* __restrict__ VCR, bf16* __restrict__ VST, bf16* __restrict__ VWT,
                  int lane, int w, int bid, int G) {
    for (int grp = bid; grp < M / 64; grp += G) { const int m0 = grp * 64, b = m0 / T, t0 = m0 % T;
        for (int i = 0; i < 8; ++i) { const int tl = 8 * w + i; const size_t m = (size_t)m0 + tl;
            q8_token(PROJ + m * N1P + C1_NQ, qn, rope1 + m * 16, QS + ((size_t)(b * 8) * T + t0 + tl) * 64, (size_t)T * 64, lane); }
        for (int p = 0; p < 2; ++p) { const int tl = 8 * w + 4 * p + (lane >> 4), head = (lane >> 3) & 1, sub = lane & 7; const size_t m = (size_t)m0 + tl; float x[8];
            const size_t dsto = ((size_t)(b * 2 + head) * T + t0 + tl) * 64 + sub * 8;
            unpack8(*(const v4u*)(PROJ + m * N1P + C1_KSL + head * 64 + sub * 8), x); head_norm_rope(x, ksn, sub, rope1 + m * 16); *(v4u*)(KS + dsto) = pack8(x);
            unpack8(*(const v4u*)(PROJ + m * N1P + C1_KWN + head * 64 + sub * 8), x); head_norm_rope(x, kwn, sub, rope1 + m * 16); *(v4u*)(KW + dsto) = pack8(x);
            *(v4u*)(KCR + dsto) = *(const v4u*)(PROJ + m * N1P + C1_KC + head * 64 + sub * 8);
            *(v4u*)(VCR + dsto) = *(const v4u*)(PROJ + m * N1P + C1_VC + head * 64 + sub * 8); }
#pragma unroll
        for (int which = 0; which < 2; ++which) { const size_t m = (size_t)m0 + lane; const int cbase = which ? C1_VWN : C1_VSL; bf16* dst = which ? VWT : VST;
            const v4u a = *(const v4u*)(PROJ + m * N1P + cbase + 16 * w), c = *(const v4u*)(PROJ + m * N1P + cbase + 16 * w + 8);
            const unsigned wv[8] = {a.x, a.y, a.z, a.w, c.x, c.y, c.z, c.w};
#pragma unroll
            for (int i = 0; i < 16; ++i) { const int hd = 16 * w + i; dst[((size_t)(b * 2 + (hd >> 6)) * 64 + (hd & 63)) * T + t0 + lane] = (bf16)((i & 1) ? (wv[i >> 1] >> 16) : (wv[i >> 1] & 0xffffu)); } }
    }
}

DI void moe_route(const float* __restrict__ H, const float* __restrict__ gln, const float* __restrict__ rw, const float* __restrict__ rb, bf16* __restrict__ XN,
                  int* __restrict__ TOKE, float* __restrict__ TOKW, int* __restrict__ TOKR, unsigned* CNT, LAS unsigned char* lds, int tid, int lane, int w, int bid, int G) {
    LAS unsigned* lcnt = (LAS unsigned*)lds; LAS int* le = (LAS int*)(lds + 64); LAS int* lr = (LAS int*)(lds + 64 + 512);
    for (int blk = bid; blk < M / 64; blk += G) {
        if (tid < 16) lcnt[tid] = 0u;
        __syncthreads();
        for (int i = 0; i < 8; ++i) { const int rl = 8 * w + i; const size_t m = (size_t)blk * 64 + rl;
            const f32x4* xr = (const f32x4*)(H + m * D) + lane; f32x4 v[4]; float s = 0.f;
#pragma unroll
            for (int j = 0; j < 4; ++j) { v[j] = xr[64 * j]; s += (v[j].x * v[j].x + v[j].y * v[j].y) + (v[j].z * v[j].z + v[j].w * v[j].w); }
            const float rstd = 1.f / sqrtf(wave_sum(s) * (1.f / D) + EPS);
            unsigned long long* o8 = (unsigned long long*)(XN + m * D) + lane;
            float lg[8];
#pragma unroll
            for (int e = 0; e < 8; ++e) lg[e] = 0.f;
#pragma unroll
            for (int j = 0; j < 4; ++j) { o8[64 * j] = (unsigned long long)pk2(v[j].x * rstd, v[j].y * rstd) | ((unsigned long long)pk2(v[j].z * rstd, v[j].w * rstd) << 32);
#pragma unroll
                for (int c = 0; c < 4; ++c) { const int col = (lane + 64 * j) * 4 + c; const float x = v[j][c] * rstd * gln[col]; const f32x4* wr = (const f32x4*)(rw + (size_t)col * 8); const f32x4 a = wr[0], bq = wr[1];
                    lg[0] += x * a[0]; lg[1] += x * a[1]; lg[2] += x * a[2]; lg[3] += x * a[3]; lg[4] += x * bq[0]; lg[5] += x * bq[1]; lg[6] += x * bq[2]; lg[7] += x * bq[3]; } }
#pragma unroll
            for (int e = 0; e < 8; ++e) lg[e] = wave_sum(lg[e]) + rb[e];
            if (lane == 0) { float v1 = lg[0]; int e1 = 0;
#pragma unroll
                for (int e = 1; e < 8; ++e) if (lg[e] > v1) { v1 = lg[e]; e1 = e; }
                float v2 = -3.0e38f; int e2 = 0;
#pragma unroll
                for (int e = 0; e < 8; ++e) if (e != e1 && lg[e] > v2) { v2 = lg[e]; e2 = e; }
                const float w1 = 1.f / (1.f + expf(v2 - v1));
                TOKE[2 * m] = e1; TOKE[2 * m + 1] = e2; TOKW[2 * m] = w1; TOKW[2 * m + 1] = 1.f - w1;
                le[2 * rl] = e1; le[2 * rl + 1] = e2; lr[2 * rl] = (int)atomicAdd((unsigned*)&lcnt[e1], 1u); lr[2 * rl + 1] = (int)atomicAdd((unsigned*)&lcnt[e2], 1u); }
        }
        __syncthreads();
        if (tid < 8) lcnt[8 + tid] = __hip_atomic_fetch_add(CNT + tid, lcnt[tid], __ATOMIC_RELAXED, __HIP_MEMORY_SCOPE_AGENT);
        __syncthreads();
        if (tid < 128) { const size_t m = (size_t)blk * 64 + (tid >> 1); TOKR[2 * m + (tid & 1)] = lr[tid] + (int)lcnt[8 + le[tid]]; }
        __syncthreads();
    }
}
DI void moe_dispatch(unsigned* CNT, const bf16* __restrict__ XN, const int* __restrict__ TOKE, const int* __restrict__ TOKR, int* __restrict__ TOKS, bf16* __restrict__ XS,
                     int* __restrict__ TILEE, unsigned* NTW, LAS unsigned char* lds, int tid, int lane, int w, int bid, int G) {
    LAS int* lbase = (LAS int*)lds;
    if (tid == 0) { int acc = 0;
        for (int e = 0; e < 8; ++e) { const int c = (int)__hip_atomic_load(CNT + e, __ATOMIC_RELAXED, __HIP_MEMORY_SCOPE_AGENT); lbase[e] = acc; lbase[16 + e] = c; acc += (c + 255) & ~255; }
        lbase[8] = acc; }
    __syncthreads();
    const int ntiles = lbase[8] >> 8;
    if (bid == 0) { for (int t = tid; t < ntiles; t += 512) { int e = 0;
#pragma unroll
            for (int k = 1; k < 8; ++k) if (t * 256 >= lbase[k]) e = k;
            TILEE[t] = e; }
        if (tid == 0) *NTW = (unsigned)ntiles; }
    const int gw = bid * NWAVES + w, NGW = G * NWAVES;
    for (int m = gw; m < M; m += NGW) {
#pragma unroll
        for (int k = 0; k < 2; ++k) { const int e = TOKE[2 * m + k], slot = lbase[e] + TOKR[2 * m + k]; if (lane == 0) TOKS[2 * m + k] = slot;
            const v4u* src = (const v4u*)(XN + (size_t)m * D) + lane; v4u* dst = (v4u*)(XS + (size_t)slot * D) + lane; dst[0] = src[0]; dst[64] = src[64]; } }
    for (int e = 0; e < 8; ++e) { const int lo = lbase[e] + lbase[16 + e], hi = lbase[e + 1];
        for (int row = lo + gw; row < hi; row += NGW) { v4u* dst = (v4u*)(XS + (size_t)row * D) + lane; dst[0] = (v4u){0u, 0u, 0u, 0u}; dst[64] = (v4u){0u, 0u, 0u, 0u}; } }
}
DI void moe_combine(float* __restrict__ OUT, const bf16* __restrict__ Y, const int* __restrict__ TOKS, const float* __restrict__ TOKW, int gw, int NGW, int lane) {
    for (int m = gw; m < M; m += NGW) { const int s0 = TOKS[2 * m], s1 = TOKS[2 * m + 1]; const float w0 = TOKW[2 * m], w1 = TOKW[2 * m + 1];
#pragma unroll
        for (int j = 0; j < 4; ++j) { const int col = lane * 4 + 256 * j; f32x4* op = (f32x4*)(OUT + (size_t)m * D + col);
            const v2u a = *(const v2u*)(Y + (size_t)s0 * D + col), c = *(const v2u*)(Y + (size_t)s1 * D + col); f32x4 o = *op;
            o[0] += w0 * bflo(a.x) + w1 * bflo(c.x); o[1] += w0 * bfhi(a.x) + w1 * bfhi(c.x); o[2] += w0 * bflo(a.y) + w1 * bflo(c.y); o[3] += w0 * bfhi(a.y) + w1 * bfhi(c.y); *op = o; } }
}

#ifndef ONE_LAUNCH
#define ONE_LAUNCH 1
#endif
#ifndef STOP_PHASE
#define STOP_PHASE 23
#endif
constexpr int NPHASE = 23;
struct Args { const void* in[39]; float* out; unsigned char* ws; int ph_lo, ph_hi; };

__global__ void __launch_bounds__(NWAVES * 64, 2) hybrid_fwd(Args args) {
    extern __shared__ __attribute__((aligned(16))) unsigned char lds_raw[];
    LAS unsigned char* lds = (LAS unsigned char*)lds_raw;
    const int tid = threadIdx.x, lane = tid & 63, w = __builtin_amdgcn_readfirstlane(tid >> 6);
    const int G = gridDim.x, bid = blockIdx.x;
    const int gw = bid * NWAVES + w, NGW = G * NWAVES, gtid = bid * (NWAVES * 64) + tid, NTH = G * NWAVES * 64;
    unsigned char* ws = args.ws;
    unsigned* CTL = (unsigned*)(ws + WS_CTL);
    for (int u = tid; u < (LDS_BYTES - LDSCTL_OFF) / 4; u += NWAVES * 64) ((LAS unsigned*)(lds + LDSCTL_OFF))[u] = 0u;
    __syncthreads();
    XcdBarrier bar; bar.bar = CTL + CW_BAR; bar.x = 0; bar.st = nullptr;
    if (ONE_LAUNCH) bar = xcd_barrier_post(CTL + CW_BAR, (volatile LAS unsigned*)(lds + MISC_OFF) + 8);
    const int lo = args.ph_lo, hi = args.ph_hi < STOP_PHASE ? args.ph_hi : STOP_PHASE;
#define IN(k) (lo <= (k) && (k) < hi)
#define SEAM(k) do { if (ONE_LAUNCH && IN(k) && IN((k) + 1)) xcd_barrier(bar); } while (0)

    const float* x = (const float*)args.in[0]; const int* positions = (const int*)args.in[1];
    const float* ln_mix_e = (const float*)args.in[2]; const float* w_in_e = (const float*)args.in[3];
    const float* gla_gate_up = (const float*)args.in[4]; const float* gla_gate_bias = (const float*)args.in[5]; const float* gla_out_norm = (const float*)args.in[6];
    const float* swa_q_norm = (const float*)args.in[7]; const float* swa_k_norm = (const float*)args.in[8]; const float* swa_sinks = (const float*)args.in[9];
    const float* w_out_e = (const float*)args.in[10]; const float* ln_ffn_e = (const float*)args.in[11];
    const float* ffn_w_gate = (const float*)args.in[12]; const float* ffn_w_up = (const float*)args.in[13]; const float* ffn_w_down = (const float*)args.in[14];
    const float* ln_mix_o = (const float*)args.in[15]; const float* w_in_o = (const float*)args.in[16]; const float* ret_out_norm = (const float*)args.in[17];
    const float* nsa_q_norm = (const float*)args.in[18]; const float* nsa_kc_norm = (const float*)args.in[19]; const float* nsa_ks_norm = (const float*)args.in[20]; const float* nsa_kw_norm = (const float*)args.in[21];
    const float* cmp_pos_k = (const float*)args.in[22]; const float* cmp_w1_k = (const float*)args.in[23]; const float* cmp_b1_k = (const float*)args.in[24]; const float* cmp_w2_k = (const float*)args.in[25]; const float* cmp_b2_k = (const float*)args.in[26];
    const float* cmp_pos_v = (const float*)args.in[27]; const float* cmp_w1_v = (const float*)args.in[28]; const float* cmp_b1_v = (const float*)args.in[29]; const float* cmp_w2_v = (const float*)args.in[30]; const float* cmp_b2_v = (const float*)args.in[31];
    const float* w_out_o = (const float*)args.in[32]; const float* ln_ffn_o = (const float*)args.in[33]; const float* router_w = (const float*)args.in[34]; const float* router_b = (const float*)args.in[35];
    const float* exp_w_gate = (const float*)args.in[36]; const float* exp_w_up = (const float*)args.in[37]; const float* exp_w_down = (const float*)args.in[38];
    float* out = args.out;
    float* ROPE1 = (float*)(ws + WS_ROPE1); float* ROPE2 = (float*)(ws + WS_ROPE2);
    bf16* WIN0 = (bf16*)(ws + WS_WIN0); bf16* WOUT0 = (bf16*)(ws + WS_WOUT0); bf16* WGU = (bf16*)(ws + WS_WGU); bf16* WDN = (bf16*)(ws + WS_WDN);
    bf16* WIN1 = (bf16*)(ws + WS_WIN1); bf16* WOUT1 = (bf16*)(ws + WS_WOUT1); bf16* WCMP = (bf16*)(ws + WS_WCMP); bf16* MOEGU = (bf16*)(ws + WS_MOEGU); bf16* MOED = (bf16*)(ws + WS_MOED);
    bf16* XN = (bf16*)(ws + WS_XN); bf16* MIXED = XN; bf16* PROJ = (bf16*)(ws + WS_PROJ); bf16* ACT = PROJ;
    bf16* QS = (bf16*)(ws + WS_QS); bf16* KS = (bf16*)(ws + WS_KS); bf16* VST = (bf16*)(ws + WS_VST);
    bf16* QIN = (bf16*)(ws + WS_QIN); float* OINTRA = (float*)(ws + WS_OINTRA); float* UT = (float*)(ws + WS_UT); float* DEC = (float*)(ws + WS_DEC);
    float* ONSA = (float*)(ws + WS_ONSA); float* CMPH = (float*)(ws + WS_CMPH);
    bf16* KCR = (bf16*)(ws + WS_KCR); bf16* VCR = (bf16*)(ws + WS_VCR); bf16* KW = (bf16*)(ws + WS_KW); bf16* VWT = (bf16*)(ws + WS_VWT);
    bf16* KCB = (bf16*)(ws + WS_CMPT + CT_KCB); bf16* VCBT = (bf16*)(ws + WS_CMPT + CT_VCBT); float* B1P = (float*)(ws + WS_CMPT + CT_B1P);
    int* TOKE = (int*)(ws + WS_TAB + TB_TOKE); float* TOKW = (float*)(ws + WS_TAB + TB_TOKW); int* TOKR = (int*)(ws + WS_TAB + TB_TOKR); int* TOKS = (int*)(ws + WS_TAB + TB_TOKS); int* TILEE = (int*)(ws + WS_TAB + TB_TILEE);
    bf16* XS = (bf16*)(ws + WS_XS); bf16* ACTH = (bf16*)(ws + WS_ACTH);
    LAS float* scr = (LAS float*)(lds + w * 16384);

    if (IN(0)) {
        if (gw < 64) { const int kv = gw >> 5; cmp_bias_item(kv ? cmp_pos_v : cmp_pos_k, kv ? cmp_w1_v : cmp_w1_k, B1P + kv * 2048, (gw >> 3) & 3, gw & 7, lane); }
        conv_mat(w_in_e, D, N0, N0P, WIN0, 0, ln_mix_e, scr, gw, NGW, lane);
        conv_mat(w_out_e, D, D, D, WOUT0, 0, nullptr, scr, gw, NGW, lane);
        conv_mat(ffn_w_gate, D, FF, FF, WGU, 1, ln_ffn_e, scr, gw, NGW, lane);
        conv_mat(ffn_w_up, D, FF, FF, WGU, 2, ln_ffn_e, scr, gw, NGW, lane);
        conv_mat(ffn_w_down, FF, D, D, WDN, 0, nullptr, scr, gw, NGW, lane);
        conv_mat(w_in_o, D, N1, N1P, WIN1, 0, ln_mix_o, scr, gw, NGW, lane);
        conv_mat(w_out_o, D, D, D, WOUT1, 0, nullptr, scr, gw, NGW, lane);
        conv_mat(cmp_w1_k, 2048, 256, 256, WCMP, 0, nullptr, scr, gw, NGW, lane);
        conv_mat(cmp_w1_v, 2048, 256, 256, WCMP + 256 * 2048, 0, nullptr, scr, gw, NGW, lane);
        rope_tables(positions, ROPE1, ROPE2, gtid, NTH);
        rms_phase(x, XN, gw, NGW, lane);
    }
    SEAM(0);
    if (IN(1)) { pg8::Gemm g{XN, WIN0, M, N0P, D, D}; pg8::StaticOrder S; S.init(M, N0P, G, bid); pg8::EpiBf16Plain E{PROJ, N0P};
        pg8::gemm_phase<pg8::EpiBf16Plain, pg8::StaticOrder, true, true>(lds, g, S, E); }
    SEAM(1);
    if (IN(2)) {
        prep0_swa(PROJ, swa_q_norm, swa_k_norm, ROPE1, QS, KS, VST, lane, w, bid, G);
        chunk_phaseA<false>(lds, PROJ, N0P, C0_GQ, C0_GK, C0_GV, C0_GLOW, gla_gate_up, gla_gate_bias, nullptr, QIN, OINTRA, UT, DEC, lane, w, bid, G);
    }
    SEAM(2);
    if (IN(3)) {
        chunk_scan(UT, DEC, gtid, NTH);
        window_attn<true, true>(QS, KS, VST, 128, swa_sinks, MIXED, nullptr, nullptr, gw, NGW, lane);
    }
    SEAM(3);
    if (IN(4)) chunk_phaseC<false>(QIN, OINTRA, UT, PROJ, N0P, C0_GOUT, gla_out_norm, MIXED, gw, NGW, lane);
    SEAM(4);
    if (IN(5)) { pg8::Gemm g{MIXED, WOUT0, M, D, D, D}; pg8::StaticOrder S; S.init(M, D, G, bid); pg8::EpiResF32 E{x, out, D};
        pg8::gemm_phase<pg8::EpiResF32, pg8::StaticOrder, true, true>(lds, g, S, E); }
    SEAM(5);
    if (IN(6)) rms_phase(out, XN, gw, NGW, lane);
    SEAM(6);
    if (IN(7)) { pg8::Gemm g{XN, WGU, M, 2 * FF, D, D}; pg8::StaticOrder S; S.init(M, 2 * FF, G, bid); pg8::EpiSwiglu E{ACT, FF};
        pg8::gemm_phase<pg8::EpiSwiglu, pg8::StaticOrder, true, true>(lds, g, S, E); }
    SEAM(7);
    if (IN(8)) { pg8::Gemm g{ACT, WDN, M, D, FF, FF}; pg8::StaticOrder S; S.init(M, D, G, bid); pg8::EpiResF32 E{out, out, D};
        pg8::gemm_phase<pg8::EpiResF32, pg8::StaticOrder, true, true>(lds, g, S, E); }
    SEAM(8);
    if (IN(9)) rms_phase(out, XN, gw, NGW, lane);
    SEAM(9);
    if (IN(10)) { pg8::Gemm g{XN, WIN1, M, N1P, D, D}; pg8::StaticOrder S; S.init(M, N1P, G, bid); pg8::EpiBf16Plain E{PROJ, N1P};
        pg8::gemm_phase<pg8::EpiBf16Plain, pg8::StaticOrder, true, true>(lds, g, S, E); }
    SEAM(10);
    if (IN(11)) {
        prep1_nsa(PROJ, nsa_q_norm, nsa_ks_norm, nsa_kw_norm, ROPE1, QS, KS, KW, KCR, VCR, VST, VWT, lane, w, bid, G);
        chunk_phaseA<true>(lds, PROJ, N1P, C1_RQ, C1_RK, C1_RV, 0, nullptr, nullptr, ROPE2, QIN, OINTRA, UT, DEC, lane, w, bid, G);
    }
    SEAM(11);
    if (IN(12)) {
        cmp_layer1(KCR, VCR, WCMP, B1P, cmp_b1_k, cmp_b1_v, CMPH, gw, NGW, lane);
        chunk_scan(UT, DEC, gtid, NTH);
        window_attn<false, false>(QS, KW, VWT, 512, nullptr, nullptr, ONSA, PROJ, gw, NGW, lane);
    }
    SEAM(12);
    if (IN(13)) {
        cmp_layer2(CMPH, cmp_w2_k, cmp_b2_k, cmp_w2_v, cmp_b2_v, nsa_kc_norm, ROPE1, KCB, VCBT, gw, NGW, lane);
        chunk_phaseC<true>(QIN, OINTRA, UT, PROJ, N1P, C1_RG, ret_out_norm, MIXED, gw, NGW, lane);
    }
    SEAM(13);
    if (IN(14)) nsa_cmp_slc(QS, KCB, VCBT, KS, VST, PROJ, ONSA, MIXED, (LAS float*)(lds + w * 16384), gw, NGW, lane);
    SEAM(14);
    if (IN(15)) { pg8::Gemm g{MIXED, WOUT1, M, D, D, D}; pg8::StaticOrder S; S.init(M, D, G, bid); pg8::EpiResF32 E{out, out, D};
        pg8::gemm_phase<pg8::EpiResF32, pg8::StaticOrder, true, true>(lds, g, S, E); }
    SEAM(15);
    if (IN(16)) {
        moe_route(out, ln_ffn_o, router_w, router_b, XN, TOKE, TOKW, TOKR, CTL + CW_CNT, lds + 126976, tid, lane, w, bid, G);
#pragma unroll 1
        for (int e = 0; e < NEXP; ++e) {
            conv_mat(exp_w_gate + (size_t)e * D * FFE, D, FFE, FFE, MOEGU + (size_t)e * 2 * FFE * D, 1, ln_ffn_o, scr, gw, NGW, lane);
            conv_mat(exp_w_up + (size_t)e * D * FFE, D, FFE, FFE, MOEGU + (size_t)e * 2 * FFE * D, 2, ln_ffn_o, scr, gw, NGW, lane);
            conv_mat(exp_w_down + (size_t)e * FFE * D, FFE, D, D, MOED + (size_t)e * D * FFE, 0, nullptr, scr, gw, NGW, lane);
        }
    }
    SEAM(16);
    if (IN(17)) moe_dispatch(CTL + CW_CNT, XN, TOKE, TOKR, TOKS, XS, TILEE, CTL + CW_NT, lds, tid, lane, w, bid, G);
    SEAM(17);
#pragma unroll
    for (int hf = 0; hf < 2; ++hf) {
        if (IN(18 + 2 * hf)) { const int nt = (int)__hip_atomic_load(CTL + CW_NT, __ATOMIC_RELAXED, __HIP_MEMORY_SCOPE_AGENT);
            const int t0 = hf * HALFTILES, t1 = hf ? nt : (nt < HALFTILES ? nt : HALFTILES);
            if (t1 > t0) { pg8::Gemm g{XS, MOEGU, 0, 2 * FFE, D, D}; pg8::MoeOrder S{TILEE, t0, t1, 2 * FFE / 256, G, bid}; pg8::EpiSwiglu E{ACTH - (size_t)t0 * 256 * FFE, FFE};
                pg8::gemm_phase<pg8::EpiSwiglu, pg8::MoeOrder, true, true>(lds, g, S, E); } }
        SEAM(18 + 2 * hf);
        if (IN(19 + 2 * hf)) { const int nt = (int)__hip_atomic_load(CTL + CW_NT, __ATOMIC_RELAXED, __HIP_MEMORY_SCOPE_AGENT);
            const int t0 = hf * HALFTILES, t1 = hf ? nt : (nt < HALFTILES ? nt : HALFTILES);
            if (t1 > t0) { pg8::Gemm g{ACTH - (size_t)t0 * 256 * FFE, MOED, 0, D, FFE, FFE}; pg8::MoeOrder S{TILEE, t0, t1, D / 256, G, bid}; pg8::EpiBf16Plain E{XS, D};
                pg8::gemm_phase<pg8::EpiBf16Plain, pg8::MoeOrder, true, true>(lds, g, S, E); } }
        SEAM(19 + 2 * hf);
    }
    if (IN(22)) moe_combine(out, XS, TOKS, TOKW, gw, NGW, lane);
#undef IN
#undef SEAM
}

extern "C" void kernel_launch(void* const* d_in, const int* in_sizes, int n_in, void* d_out, int out_size, void* d_ws, size_t ws_size, hipStream_t stream) {
    static int grid = 0;
    if (grid == 0) {
        if (n_in != 39 || out_size != M * D || ws_size < WS_END) { fprintf(stderr, "kernel_launch: unexpected problem (n_in %d, out %d, ws %zu < %zu)\n", n_in, out_size, ws_size, (size_t)WS_END); grid = -1; return; }
        int dev = 0, cus = 0, per_cu = 0;
        if (hipGetDevice(&dev) != hipSuccess || hipDeviceGetAttribute(&cus, hipDeviceAttributeMultiprocessorCount, dev) != hipSuccess) { grid = -1; return; }
        if (hipFuncSetAttribute((const void*)hybrid_fwd, hipFuncAttributeMaxDynamicSharedMemorySize, LDS_BYTES) != hipSuccess) { fprintf(stderr, "kernel_launch: hipFuncSetAttribute failed\n"); grid = -1; return; }
        if (hipOccupancyMaxActiveBlocksPerMultiprocessor(&per_cu, (const void*)hybrid_fwd, NWAVES * 64, LDS_BYTES) != hipSuccess || per_cu < 1) { fprintf(stderr, "kernel_launch: occupancy query says %d\n", per_cu); }
        (void)hipGetLastError();
        grid = cus;
    }
    if (grid < 0) return;
    if (hipMemsetAsync((char*)d_ws + WS_CTL, 0, CTL_ZERO_BYTES, stream) != hipSuccess) return;
    Args a{};
    for (int i = 0; i < 39; ++i) a.in[i] = d_in[i];
    a.out = (float*)d_out; a.ws = (unsigned char*)d_ws;
#if ONE_LAUNCH
    a.ph_lo = 0; a.ph_hi = NPHASE;
    hipLaunchKernelGGL(hybrid_fwd, dim3(grid), dim3(NWAVES * 64), LDS_BYTES, stream, a);
#else
    for (int p = 0; p < NPHASE && p < STOP_PHASE; ++p) { a.ph_lo = p; a.ph_hi = p + 1; hipLaunchKernelGGL(hybrid_fwd, dim3(grid), dim3(NWAVES * 64), LDS_BYTES, stream, a); }
#endif
}
```

```cpp
#include <hip/hip_runtime.h>
#include <cstdio>
#include <cstdint>
namespace pg8 {
#define PG8_LAS __attribute__((address_space(3)))
typedef unsigned short bf16_t;
typedef short bf16x8 __attribute__((ext_vector_type(8)));
typedef float f32x4 __attribute__((ext_vector_type(4)));
typedef unsigned u32x4 __attribute__((ext_vector_type(4)));
constexpr int BM = 256, BK = 64, HALF = 128, HTB = HALF * BK * 2  , STAGE_BYTES = 8 * HTB, NXCD = 8, WGM = 8;

__host__ __device__ __forceinline__ int lds_byte(int r, int c) { const int st = (r >> 4) * 2 + (c >> 5), rr = r & 15, cc = c & 31, ob = rr * 64 + cc * 2; return st * 1024 + (ob ^ (((ob >> 9) & 1) << 5)); }
__host__ __device__ __forceinline__ void stage_rc(int b, int& R, int& C) { const int st = b / 1024, sb = b % 1024, swz = sb ^ (((sb >> 9) & 1) << 5); R = (st >> 1) * 16 + swz / 64; C = (st & 1) * 32 + (swz % 64) / 2; }
__host__ __device__ __forceinline__ int perm32(int rho) { const int n = rho >> 4, i = rho & 15; return 8 * (i >> 2) + 4 * n + (i & 3); }

struct Unit { int pm, pn, pb; };
struct Gemm { const bf16_t* A; const bf16_t* Bt; int M, N, K, lda; };

struct StaticOrder {
    int nM, nN, nwg, G, c;
    __host__ __device__ void init(int M, int N, int G_, int c_) { nM = M / BM; nN = N / BM; nwg = nM * nN; G = G_; c = c_; }
    __host__ __device__ bool next(int i, Unit& u) const {
        const long L = (long)i * G + c; if (L >= nwg) return false;
        int wgid = (int)L; { const int q = nwg / NXCD, r = nwg % NXCD, xcd = wgid % NXCD, off = wgid / NXCD; wgid = (xcd < r ? xcd * (q + 1) : r * (q + 1) + (xcd - r) * q) + off; }
        const int nig = WGM * nN, gid = wgid / nig, fm = gid * WGM, gsz = (nM - fm) < WGM ? (nM - fm) : WGM;
        u.pm = fm + ((wgid % nig) % gsz); u.pn = (wgid % nig) / gsz; u.pb = u.pn; return true;
    }
    __device__ __forceinline__ void a_ready(const Unit&) const {}
    __device__ __forceinline__ void done(const Unit&) const {}
};
struct MoeOrder {
    const int* tile_e; int t0, t1, nN, G, c;
    __device__ bool next(int i, Unit& u) const {
        const long L = (long)i * G + c; const long n = (long)(t1 - t0) * nN; if (L >= n) return false;
        u.pm = t0 + (int)(L / nN); u.pn = (int)(L % nN); u.pb = tile_e[u.pm] * nN + u.pn; return true;
    }
    __device__ __forceinline__ void a_ready(const Unit&) const {}
    __device__ __forceinline__ void done(const Unit&) const {}
};

__device__ __forceinline__ unsigned cvt_pk_bf16(float lo, float hi) { unsigned r; asm volatile("v_cvt_pk_bf16_f32 %0, %1, %2" : "=v"(r) : "v"(lo), "v"(hi)); return r; }

struct EpiBf16Plain {
    static constexpr bool PERM = true, AFTER_DRAIN = false;
    bf16_t* O; int ldc;
    __device__ __forceinline__ void operator()(const f32x4 (&acc)[2][2][4][2], const Unit& u, int wr, int wc, int fr, int fq) const {
        const int row0 = u.pm * BM + wr * 64 + fr, col0 = u.pn * BM + wc * 32 + 8 * fq;
#pragma unroll
        for (int ai = 0; ai < 2; ++ai)
#pragma unroll
            for (int m = 0; m < 4; ++m) { bf16_t* rowp = O + (size_t)(row0 + ai * HALF + m * 16) * ldc + col0;
#pragma unroll
                for (int bj = 0; bj < 2; ++bj) { const f32x4 v0 = acc[ai][bj][m][0], v1 = acc[ai][bj][m][1];
                    u32x4 w; w.x = cvt_pk_bf16(v0[0], v0[1]); w.y = cvt_pk_bf16(v0[2], v0[3]); w.z = cvt_pk_bf16(v1[0], v1[1]); w.w = cvt_pk_bf16(v1[2], v1[3]);
                    *(u32x4*)(rowp + bj * HALF) = w; } }
    }
};
struct EpiResF32 {
    static constexpr bool PERM = false, AFTER_DRAIN = false;
    const float* base; float* out; int ldc;
    __device__ __forceinline__ void operator()(const f32x4 (&acc)[2][2][4][2], const Unit& u, int wr, int wc, int fr, int fq) const {
        const int row0 = u.pm * BM + wr * 64 + fr, col0 = u.pn * BM + wc * 32 + 4 * fq;
#pragma unroll
        for (int ai = 0; ai < 2; ++ai)
#pragma unroll
            for (int m = 0; m < 4; ++m) { const size_t ro = (size_t)(row0 + ai * HALF + m * 16) * ldc + col0;
#pragma unroll
                for (int bj = 0; bj < 2; ++bj)
#pragma unroll
                    for (int n = 0; n < 2; ++n) { const size_t o = ro + bj * HALF + n * 16; const f32x4 b = *(const f32x4*)(base + o); *(f32x4*)(out + o) = b + acc[ai][bj][m][n]; } }
    }
};
struct EpiSwiglu {
    static constexpr bool PERM = true, AFTER_DRAIN = false;
    bf16_t* O; int ldc;
    __device__ __forceinline__ void operator()(const f32x4 (&acc)[2][2][4][2], const Unit& u, int wr, int wc, int fr, int fq) const {
        const int row0 = u.pm * BM + wr * 64 + fr, col0 = u.pn * HALF + wc * 32 + 8 * fq;
#pragma unroll
        for (int ai = 0; ai < 2; ++ai)
#pragma unroll
            for (int m = 0; m < 4; ++m) { bf16_t* rowp = O + (size_t)(row0 + ai * HALF + m * 16) * ldc + col0;
                float r[8];
#pragma unroll
                for (int n = 0; n < 2; ++n)
#pragma unroll
                    for (int i = 0; i < 4; ++i) { const float g = acc[ai][0][m][n][i], up = acc[ai][1][m][n][i]; r[n * 4 + i] = g * __builtin_amdgcn_rcpf(1.0f + __expf(-g)) * up; }
                u32x4 w; w.x = cvt_pk_bf16(r[0], r[1]); w.y = cvt_pk_bf16(r[2], r[3]); w.z = cvt_pk_bf16(r[4], r[5]); w.w = cvt_pk_bf16(r[6], r[7]);
                *(u32x4*)rowp = w; }
    }
};

struct CmpOrder {
    int G, c;
    __device__ bool next(int i, Unit& u) const { const int L = i * G + c; if (L >= 16) return false; u.pm = L; u.pn = 0; u.pb = L >> 3; return true; }
    __device__ __forceinline__ void a_ready(const Unit&) const {}
    __device__ __forceinline__ void done(const Unit&) const {}
};
struct EpiCmp {
    static constexpr bool PERM = false, AFTER_DRAIN = false;
    float* C; const float* bias;
    __device__ __forceinline__ void operator()(const f32x4 (&acc)[2][2][4][2], const Unit& u, int wr, int wc, int fr, int fq) const {
        const int row0 = u.pm * BM + wr * 64 + fr, col0 = wc * 32 + 4 * fq; const float* bp = bias + u.pb * 256 + col0;
#pragma unroll
        for (int ai = 0; ai < 2; ++ai)
#pragma unroll
            for (int m = 0; m < 4; ++m) { float* rowp = C + (size_t)(row0 + ai * HALF + m * 16) * 256 + col0;
#pragma unroll
                for (int bj = 0; bj < 2; ++bj)
#pragma unroll
                    for (int n = 0; n < 2; ++n) *(f32x4*)(rowp + bj * HALF + n * 16) = acc[ai][bj][m][n] + *(const f32x4*)(bp + bj * HALF + n * 16); }
    }
};
template <class Epi, class Sched, bool ALIGN_EPI = false, bool SP2 = false>
__device__ __forceinline__ void gemm_phase(PG8_LAS unsigned char* lds, const Gemm g, const Sched& S, const Epi& E) {
    const int tid = threadIdx.x, wid = __builtin_amdgcn_readfirstlane(tid >> 6), lane = tid & 63, wr = wid >> 2, wc = wid & 3, fr = lane & 15, fq = lane >> 4;
    const int K = g.K, nt = K / BK;
    unsigned voffA[2], voffB[2];
#pragma unroll
    for (int i = 0; i < 2; ++i) { int R, C; stage_rc(tid * 16 + i * 8192, R, C); const int Rb = Epi::PERM ? ((R & ~31) + perm32(R & 31)) : R;
        voffA[i] = (unsigned)(R * g.lda + C) * 2u; voffB[i] = (unsigned)(Rb * K + C) * 2u; }
    const size_t kstep = (size_t)(BK * 2);
    const size_t hstep = (size_t)HALF * K * 2;
    const size_t tstep = 2 * hstep; const size_t hstepA = (size_t)HALF * g.lda * 2, tstepA = 2 * hstepA;
    const unsigned ldsw = (unsigned)wid * 1024u;
    const int aoff = lds_byte(wr * 64 + fr, fq * 8), boff = lds_byte(wc * 32 + fr, fq * 8);
#define PG8_SA(b, h) (((b) * 2 + (h)) * HTB)
#define PG8_SB(b, h) ((4 + (b) * 2 + (h)) * HTB)
#define PG8_STAGE(bufoff, gbase, voff) do { _Pragma("unroll") for (int _i = 0; _i < 2; ++_i) \
        __builtin_amdgcn_global_load_lds((const unsigned*)((const char*)(gbase) + (voff)[_i]), (PG8_LAS unsigned*)(lds + (bufoff) + ldsw + _i * 8192), 16, 0, 0); } while (0)
#define PG8_LDA(dst, b, h) do { _Pragma("unroll") for (int m = 0; m < 4; ++m) _Pragma("unroll") for (int k = 0; k < 2; ++k) dst[m][k] = *(const PG8_LAS bf16x8*)(lds + PG8_SA(b, h) + aoff + m * 2048 + k * 1024); } while (0)
#define PG8_LDB(dst, b, h) do { _Pragma("unroll") for (int n = 0; n < 2; ++n) _Pragma("unroll") for (int k = 0; k < 2; ++k) dst[n][k] = *(const PG8_LAS bf16x8*)(lds + PG8_SB(b, h) + boff + n * 2048 + k * 1024); } while (0)
#define PG8_MMA(ai, bj, At, Bt) do { __builtin_amdgcn_s_setprio(1); _Pragma("unroll") for (int m = 0; m < 4; ++m) _Pragma("unroll") for (int n = 0; n < 2; ++n) _Pragma("unroll") for (int k = 0; k < 2; ++k) \
        acc[ai][bj][m][n] = __builtin_amdgcn_mfma_f32_16x16x32_bf16(Bt[n][k], At[m][k], acc[ai][bj][m][n], 0, 0, 0); __builtin_amdgcn_s_setprio(0); } while (0)
#define PG8_WAIT_V(n) asm volatile("s_waitcnt vmcnt(" #n ")" ::: "memory")
#define PG8_WAIT_L(n) asm volatile("s_waitcnt lgkmcnt(" #n ")" ::: "memory")
#define PG8_BAR __builtin_amdgcn_s_barrier()
#define PG8_SCHED __builtin_amdgcn_sched_barrier(0)
    Unit cur, nxt; int ui = 0;
    if (!S.next(0, cur)) return;
    f32x4 acc[2][2][4][2];
#pragma unroll
    for (int a = 0; a < 2; ++a)
#pragma unroll
        for (int b = 0; b < 2; ++b)
#pragma unroll
            for (int m = 0; m < 4; ++m)
#pragma unroll
                for (int n = 0; n < 2; ++n) acc[a][b][m][n] = (f32x4){0.f, 0.f, 0.f, 0.f};
    bf16x8 At[4][2], B0[2][2], B1[2][2];
    const char* cA = (const char*)g.A + (size_t)cur.pm * tstepA; const char* cB = (const char*)g.Bt + (size_t)cur.pb * tstep;
    S.a_ready(cur);
    if constexpr (SP2) {
        PG8_STAGE(PG8_SB(0, 0), cB, voffB); PG8_STAGE(PG8_SB(0, 1), cB + hstep, voffB); PG8_STAGE(PG8_SA(0, 0), cA, voffA); PG8_STAGE(PG8_SA(0, 1), cA + hstepA, voffA);
        if (wr == 1) PG8_BAR;
        PG8_WAIT_V(2); PG8_BAR;
        PG8_STAGE(PG8_SB(1, 0), cB + kstep, voffB); PG8_STAGE(PG8_SA(1, 0), cA + kstep, voffA); PG8_STAGE(PG8_SB(1, 1), cB + hstep + kstep, voffB);
        PG8_WAIT_V(6); PG8_BAR;
    } else {
        PG8_STAGE(PG8_SB(0, 0), cB, voffB); PG8_STAGE(PG8_SA(0, 0), cA, voffA); PG8_STAGE(PG8_SB(0, 1), cB + hstep, voffB); PG8_STAGE(PG8_SA(0, 1), cA + hstepA, voffA);
        if (wr == 1) PG8_BAR;
        PG8_WAIT_V(4); PG8_BAR;
        PG8_STAGE(PG8_SB(1, 0), cB + kstep, voffB); PG8_STAGE(PG8_SA(1, 0), cA + kstep, voffA); PG8_STAGE(PG8_SB(1, 1), cB + hstep + kstep, voffB);
        PG8_WAIT_V(6); PG8_BAR;
    }
    for (;;) {
        const bool has_next = S.next(ui + 1, nxt);
        const char* nA = has_next ? (const char*)g.A + (size_t)nxt.pm * tstepA : cA; const char* nB = has_next ? (const char*)g.Bt + (size_t)nxt.pb * tstep : cB;
        for (int t = 0; t < nt; t += 2) {
            const bool last = (t == nt - 2);
            const char* a1 = cA + (size_t)(t + 1) * kstep;
            const char* a2 = last ? nA : cA + (size_t)(t + 2) * kstep; const char* b2 = last ? nB : cB + (size_t)(t + 2) * kstep;
            const char* a3 = a2 + kstep; const char* b3 = b2 + kstep;
            if (last && has_next) S.a_ready(nxt);
            if constexpr (SP2) {
            PG8_LDB(B0, 0, 0); PG8_LDB(B1, 0, 1); PG8_SCHED; PG8_LDA(At, 0, 0); PG8_STAGE(PG8_SA(1, 1), a1 + hstepA, voffA);
            PG8_WAIT_V(8); PG8_WAIT_L(0); PG8_BAR; PG8_MMA(0, 0, At, B0); PG8_MMA(0, 1, At, B1); PG8_BAR; PG8_SCHED;
            PG8_LDA(At, 0, 1); PG8_STAGE(PG8_SB(0, 0), b2, voffB); PG8_STAGE(PG8_SB(0, 1), b2 + hstep, voffB); PG8_STAGE(PG8_SA(0, 0), a2, voffA);
            PG8_WAIT_V(8); PG8_WAIT_L(0); PG8_BAR; PG8_MMA(1, 0, At, B0); PG8_MMA(1, 1, At, B1); PG8_BAR; PG8_SCHED;
            PG8_LDB(B0, 1, 0); PG8_LDB(B1, 1, 1); PG8_SCHED; PG8_LDA(At, 1, 0); PG8_STAGE(PG8_SA(0, 1), a2 + hstepA, voffA);
            PG8_WAIT_V(8); PG8_WAIT_L(0); PG8_BAR; PG8_MMA(0, 0, At, B0); PG8_MMA(0, 1, At, B1); PG8_BAR; PG8_SCHED;
            PG8_LDA(At, 1, 1); PG8_STAGE(PG8_SB(1, 0), b3, voffB); PG8_STAGE(PG8_SB(1, 1), b3 + hstep, voffB); PG8_STAGE(PG8_SA(1, 0), a3, voffA);
            PG8_WAIT_V(8); PG8_WAIT_L(0); PG8_BAR; PG8_MMA(1, 0, At, B0); PG8_MMA(1, 1, At, B1); PG8_BAR; PG8_SCHED;
            } else {
            PG8_LDB(B0, 0, 0); PG8_SCHED; PG8_LDA(At, 0, 0); PG8_STAGE(PG8_SA(1, 1), a1 + hstepA, voffA);
            PG8_WAIT_L(8); PG8_BAR; PG8_WAIT_L(0); PG8_MMA(0, 0, At, B0); PG8_BAR; PG8_SCHED;
            PG8_LDB(B1, 0, 1); PG8_STAGE(PG8_SB(0, 0), b2, voffB);
            PG8_BAR; PG8_WAIT_L(0); PG8_MMA(0, 1, At, B1); PG8_BAR;
            PG8_LDA(At, 0, 1); PG8_STAGE(PG8_SA(0, 0), a2, voffA);
            PG8_BAR; PG8_WAIT_L(0); PG8_MMA(1, 0, At, B0); PG8_BAR; PG8_SCHED;
            PG8_STAGE(PG8_SB(0, 1), b2 + hstep, voffB);
            PG8_WAIT_V(6); PG8_BAR; PG8_MMA(1, 1, At, B1); PG8_BAR;
            PG8_LDB(B0, 1, 0); PG8_SCHED; PG8_LDA(At, 1, 0); PG8_STAGE(PG8_SA(0, 1), a2 + hstepA, voffA);
            PG8_WAIT_L(8); PG8_BAR; PG8_WAIT_L(0); PG8_MMA(0, 0, At, B0); PG8_BAR; PG8_SCHED;
            PG8_LDB(B1, 1, 1); PG8_STAGE(PG8_SB(1, 0), b3, voffB);
            PG8_BAR; PG8_WAIT_L(0); PG8_MMA(0, 1, At, B1); PG8_BAR;
            PG8_LDA(At, 1, 1); PG8_STAGE(PG8_SA(1, 0), a3, voffA);
            PG8_BAR; PG8_WAIT_L(0); PG8_MMA(1, 0, At, B0); PG8_BAR; PG8_SCHED;
            PG8_STAGE(PG8_SB(1, 1), b3 + hstep, voffB);
            PG8_WAIT_V(6); PG8_BAR; PG8_MMA(1, 1, At, B1); PG8_BAR;
            }
        }
        if constexpr (ALIGN_EPI) { if (wr == 0) PG8_BAR; }
        if constexpr (!Epi::AFTER_DRAIN) { E(acc, cur, wr, wc, fr, fq); S.done(cur); }
        if (!has_next) break;
#pragma unroll
        for (int a = 0; a < 2; ++a)
#pragma unroll
            for (int b = 0; b < 2; ++b)
#pragma unroll
                for (int m = 0; m < 4; ++m)
#pragma unroll
                    for (int n = 0; n < 2; ++n) acc[a][b][m][n] = (f32x4){0.f, 0.f, 0.f, 0.f};
        cur = nxt; cA = nA; cB = nB; ++ui;
        if constexpr (ALIGN_EPI) { if (wr == 1) PG8_BAR; }
    }
    PG8_WAIT_V(0);
    if constexpr (!ALIGN_EPI) { if (wr == 0) PG8_BAR; }
    PG8_BAR;
    if constexpr (Epi::AFTER_DRAIN) { E.fused(acc, cur, wr, wc, fr, fq, lds, wid, lane); S.done(cur); }
#undef PG8_SA
#undef PG8_SB
#undef PG8_STAGE
#undef PG8_LDA
#undef PG8_LDB
#undef PG8_MMA
#undef PG8_WAIT_V
#undef PG8_WAIT_L
#undef PG8_BAR
#undef PG8_SCHED
}
}

constexpr int BATCH = 4, T = 4096, D = 1024, M = BATCH * T;
constexpr int N0 = 2320, N0P = 2560, N1 = 2840, N1P = 3072;
constexpr int FF = 2816, FFE = 3584, NEXP = 8;
constexpr int C0_GQ = 0, C0_GK = 256, C0_GV = 512, C0_GLOW = 1024, C0_GOUT = 1040, C0_SQ = 1552, C0_SK = 2064, C0_SV = 2192;
constexpr int C1_RQ = 0, C1_RK = 256, C1_RV = 512, C1_RG = 1024, C1_NQ = 1536, C1_KC = 2048, C1_VC = 2176, C1_KSL = 2304, C1_VSL = 2432, C1_KWN = 2560, C1_VWN = 2688, C1_NG = 2816;
constexpr float EPS = 1e-6f;
constexpr float LOG2E = 1.4426950408889634f;
constexpr int NCH = T / 64;
constexpr int NUNIT = BATCH * 4 * NCH;
constexpr int MAXTILES = 136, HALFTILES = 68, XS_ROWS = MAXTILES * 256;

constexpr size_t MiB = 1u << 20;
constexpr size_t WS_CTL = 0, CTL_ZERO_BYTES = 1 * MiB;
constexpr size_t WS_ROPE1 = 1 * MiB;
constexpr size_t WS_ROPE2 = 2 * MiB;
constexpr size_t WS_TAB = 6 * MiB;
constexpr size_t WS_CMPT = 7 * MiB;
constexpr size_t WS_WIN0 = 8 * MiB, WS_WOUT0 = 13 * MiB, WS_WGU = 15 * MiB, WS_WDN = 26 * MiB, WS_WIN1 = 32 * MiB, WS_WOUT1 = 38 * MiB, WS_WCMP = 40 * MiB;
constexpr size_t WS_MOEGU = 42 * MiB, WS_MOED = 154 * MiB;
constexpr size_t WS_XN = 210 * MiB;
constexpr size_t WS_PROJ = 242 * MiB;
constexpr size_t WS_RA = 338 * MiB;
constexpr size_t WS_END = 451 * MiB;
constexpr size_t WS_ONSA = 42 * MiB;
constexpr size_t WS_CMPH = 74 * MiB;
constexpr size_t WS_KCR = 80 * MiB, WS_VCR = 84 * MiB, WS_KW = 88 * MiB, WS_VWT = 92 * MiB;
constexpr size_t WS_QS = 338 * MiB;
constexpr size_t WS_KS = 354 * MiB;
constexpr size_t WS_VST = 358 * MiB;
constexpr size_t WS_QIN = 362 * MiB;
constexpr size_t WS_OINTRA = 370 * MiB;
constexpr size_t WS_UT = 402 * MiB;
constexpr size_t WS_DEC = 434 * MiB;
constexpr size_t WS_XS = 242 * MiB;
constexpr size_t WS_ACTH = 310 * MiB;
static_assert(WS_XS + (size_t)XS_ROWS * 1024 * 2 <= WS_ACTH && WS_ACTH + (size_t)HALFTILES * 256 * FFE * 2 <= WS_END, "moe map");
static_assert(WS_DEC + (size_t)NUNIT * 64 * 4 <= WS_END, "ws map");
constexpr size_t TB_TOKE = 0, TB_TOKW = 128 * 1024, TB_TOKR = 256 * 1024, TB_TOKS = 384 * 1024, TB_TILEE = 512 * 1024;
constexpr size_t CT_KCB = 0, CT_VCBT = 256 * 1024, CT_B1P = 512 * 1024, CT_W2T = 768 * 1024;
constexpr int CW_BAR = 4096;
constexpr int CW_CNT = 16384;
constexpr int CW_NT = 16384 + 64;

constexpr int RING_BYTES = 131072;
constexpr int LDSCTL_OFF = RING_BYTES, MISC_OFF = LDSCTL_OFF + 320;
constexpr int LDS_BYTES = 147456;
constexpr int NWAVES = 8;

#define GAS __attribute__((address_space(1)))
#define LAS __attribute__((address_space(3)))
#define DI __device__ __forceinline__
typedef unsigned short bf16;
typedef unsigned v4u __attribute__((ext_vector_type(4)));
typedef unsigned v2u __attribute__((ext_vector_type(2)));
typedef float f32x4 __attribute__((ext_vector_type(4)));
typedef short bf16x8 __attribute__((ext_vector_type(8)));
typedef float f32x2_t __attribute__((ext_vector_type(2))); typedef __bf16 bf16x2_t __attribute__((ext_vector_type(2)));
DI unsigned pk2(float lo, float hi) { f32x2_t v = {lo, hi}; bf16x2_t b = __builtin_convertvector(v, bf16x2_t); return __builtin_bit_cast(unsigned, b); }
DI unsigned f2bf(float f) { return pk2(f, 0.f) & 0xffffu; }
DI float bflo(unsigned w) { return __builtin_bit_cast(float, w << 16); }
DI float bfhi(unsigned w) { return __builtin_bit_cast(float, w & 0xffff0000u); }
DI void unpack8(const v4u v, float (&x)[8]) { x[0] = bflo(v.x); x[1] = bfhi(v.x); x[2] = bflo(v.y); x[3] = bfhi(v.y); x[4] = bflo(v.z); x[5] = bfhi(v.z); x[6] = bflo(v.w); x[7] = bfhi(v.w); }
DI v4u pack8(const float (&x)[8]) { v4u v; v.x = pk2(x[0], x[1]); v.y = pk2(x[2], x[3]); v.z = pk2(x[4], x[5]); v.w = pk2(x[6], x[7]); return v; }
DI bf16x8 ldg16(const bf16* p) { return *(const bf16x8*)p; }
DI f32x4 mfma16(bf16x8 a, bf16x8 b, f32x4 c) { return __builtin_amdgcn_mfma_f32_16x16x32_bf16(a, b, c, 0, 0, 0); }
template <int CTRL> DI float dppf(float v) { return __builtin_bit_cast(float, __builtin_amdgcn_update_dpp(0, __builtin_bit_cast(int, v), CTRL, 0xf, 0xf, true)); }
DI float rdlane(float v, int l) { return __builtin_bit_cast(float, __builtin_amdgcn_readlane(__builtin_bit_cast(int, v), l)); }
DI float sum8(float v) { v += dppf<0xB1>(v); v += dppf<0x4E>(v); v += dppf<0x141>(v); return v; }
DI float sum16(float v) { v = sum8(v); v += dppf<0x140>(v); return v; }
DI float wave_sum(float v) { v = sum16(v); return (rdlane(v, 0) + rdlane(v, 16)) + (rdlane(v, 32) + rdlane(v, 48)); }
DI float xor1(float v) { return dppf<0xB1>(v); }
DI float scan64(float v, int lane, float& total) {
    v += dppf<0x111>(v); v += dppf<0x112>(v); v += dppf<0x114>(v); v += dppf<0x118>(v);
    const float s0 = rdlane(v, 15), s1 = rdlane(v, 31), s2 = rdlane(v, 47), s3 = rdlane(v, 63); const int row = lane >> 4;
    v += (row >= 1 ? s0 : 0.f) + (row >= 2 ? s1 : 0.f) + (row >= 3 ? s2 : 0.f);
    total = (s0 + s1) + (s2 + s3); return v;
}
DI float silu_f(float g) { return g / (1.0f + __expf(-g)); }

#define XB_TMO      128
#define XB_XCNT(j)  (256  + 64 * (j))
#define XB_XSUB(j)  (1280 + 64 * (j))
#define XB_XGEN(j)  (2304 + 64 * (j))
#define XB_TOP      3328
#define XB_TOPGEN   3392
#define XCD_BAR_WORDS 3456
#define XB_SPIN_CAP (1u << 18)

__device__ __forceinline__ unsigned xb_ld(unsigned* p)              { return __hip_atomic_load(p, __ATOMIC_RELAXED, __HIP_MEMORY_SCOPE_AGENT); }
__device__ __forceinline__ unsigned xb_add(unsigned* p, unsigned v) { return __hip_atomic_fetch_add(p, v, __ATOMIC_RELAXED, __HIP_MEMORY_SCOPE_AGENT); }
__device__ __forceinline__ unsigned xb_xcc_id() { return (unsigned)__builtin_amdgcn_s_getreg((3 << 11) | 20) & 0xFu; }
#define XB_SPIN(cond, bar) do { unsigned _sp = 0; while (cond) { __builtin_amdgcn_s_sleep(1); \
    if ((++_sp & 255u) == 0u) { if (xb_ld(&(bar)[XB_TMO])) break; if (_sp > XB_SPIN_CAP) { atomicAdd(&(bar)[XB_TMO], 1u); break; } } } } while (0)

struct XcdBarrier { unsigned* bar; unsigned x; volatile LAS unsigned* st; };

__device__ __forceinline__ XcdBarrier xcd_barrier_post(unsigned* bar, volatile LAS unsigned* st) {
    XcdBarrier b; b.bar = bar; b.x = xb_xcc_id(); b.st = st;
    if (threadIdx.x == 0) (void)xb_add(&bar[XB_XCNT(b.x)], 1u);
    return b;
}
__device__ __forceinline__ void xcd_barrier_complete(unsigned* bar, unsigned x, unsigned& nloc, unsigned& nx) {
    const unsigned G = gridDim.x * gridDim.y * gridDim.z;
    unsigned sum, cnt, mine, sp = 0u;
    for (;;) {
        sum = 0u; cnt = 0u; mine = 0u;
#pragma unroll
        for (unsigned j = 0; j < 16; ++j) { const unsigned c = xb_ld(&bar[XB_XCNT(j)]); sum += c; cnt += (c > 0u) ? 1u : 0u; mine = (j == x) ? c : mine; }
        if (sum == G) break;
        __builtin_amdgcn_s_sleep(1);
        if ((++sp & 255u) == 0u) { if (xb_ld(&bar[XB_TMO])) break; if (sp > XB_SPIN_CAP) { atomicAdd(&bar[XB_TMO], 1u); break; } }
    }
    nloc = mine > 0u ? mine : 1u; nx = cnt > 0u ? cnt : 1u;
}
__device__ __forceinline__ void xcd_barrier(const XcdBarrier& b) {
    asm volatile("s_waitcnt vmcnt(0)" ::: "memory");
    __syncthreads();
    if (threadIdx.x == 0) {
        unsigned* bar = b.bar;
        __builtin_amdgcn_s_waitcnt(0);
        unsigned nloc = b.st[0], nx = b.st[1];
        if (nloc == 0u) { xcd_barrier_complete(bar, b.x, nloc, nx); b.st[0] = nloc; b.st[1] = nx; }
        const unsigned old = xb_add(&bar[XB_XSUB(b.x)], 1u);
        const unsigned gen = old / nloc;
        if (old + 1u == (gen + 1u) * nloc) {
            __builtin_amdgcn_fence(__ATOMIC_RELEASE, "agent");
            asm volatile("s_waitcnt vmcnt(0)" ::: "memory");
            const unsigned og = xb_add(&bar[XB_TOP], 1u);
            const unsigned tg = og / nx;
            if (og + 1u == (tg + 1u) * nx) xb_add(&bar[XB_TOPGEN], 1u);
            else XB_SPIN(xb_ld(&bar[XB_TOPGEN]) == tg, bar);
            __builtin_amdgcn_fence(__ATOMIC_ACQUIRE, "agent");
            xb_add(&bar[XB_XGEN(b.x)], 1u);
            asm volatile("s_waitcnt vmcnt(0)" ::: "memory");
        } else {
            XB_SPIN(xb_ld(&bar[XB_XGEN(b.x)]) == gen, bar);
            __builtin_amdgcn_fence(__ATOMIC_ACQUIRE, "agent");
            asm volatile("s_waitcnt vmcnt(0)" ::: "memory");
        }
    }
    __syncthreads();
}

#define LDS_WAIT() asm volatile("s_waitcnt lgkmcnt(0)" ::: "memory")

DI void tr_item64(const float* __restrict__ W, int N, bf16* __restrict__ WT, int kpitch, int drow0, int k0, int n0, const float* __restrict__ gain, LAS unsigned char* scr, int lane) {
    const int n4 = lane & 15, kq = lane >> 4, n = n0 + 4 * n4; const bool ok = n < N;
    f32x4 v[4][4];
#pragma unroll
    for (int g = 0; g < 4; ++g)
#pragma unroll
        for (int j = 0; j < 4; ++j) v[g][j] = ok ? __builtin_nontemporal_load((const f32x4*)(W + (size_t)(k0 + 16 * g + 4 * kq + j) * N + n)) : (f32x4){0.f, 0.f, 0.f, 0.f};
#pragma unroll
    for (int g = 0; g < 4; ++g) { float gj[4];
#pragma unroll
        for (int j = 0; j < 4; ++j) gj[j] = gain ? gain[k0 + 16 * g + 4 * kq + j] : 1.f;
        const int chunk = 2 * g + (kq >> 1), half = kq & 1;
#pragma unroll
        for (int i = 0; i < 4; ++i) { const int nn = 4 * n4 + i; v2u wv; wv.x = pk2(v[g][0][i] * gj[0], v[g][1][i] * gj[1]); wv.y = pk2(v[g][2][i] * gj[2], v[g][3][i] * gj[3]);
            *(LAS v2u*)(scr + nn * 128 + ((chunk ^ (n4 & 7)) << 4) + half * 8) = wv; } }
    LDS_WAIT(); asm volatile("" ::: "memory");
#pragma unroll
    for (int jj = 0; jj < 8; ++jj) { const int nn = (lane >> 3) + 8 * jj, c = lane & 7; const v4u o = *(const LAS v4u*)(scr + nn * 128 + ((c ^ ((nn >> 2) & 7)) << 4));
        *(v4u*)(WT + (size_t)(drow0 + nn) * kpitch + k0 + 8 * c) = o; }
    LDS_WAIT(); asm volatile("" ::: "memory");
}
DI void conv_mat(const float* W, int K, int N, int NP, bf16* WT, int mode, const float* gain, LAS unsigned char* scr, int gw, int NGW, int lane) {
    const int nblk = NP / 64, nit = nblk * (K / 64);
    for (int it = gw; it < nit; it += NGW) { const int kb = it / nblk, nb = it - kb * nblk, n0 = nb * 64;
        const int drow0 = (mode == 0) ? n0 : ((n0 >> 7) * 256 + (n0 & 127) + (mode == 2 ? 128 : 0));
        tr_item64(W, N, WT, K, drow0, kb * 64, n0, gain, scr, lane); }
}
DI void rope_tables(const int* __restrict__ pos, float* __restrict__ R1, float* __restrict__ R2, int gtid, int NT) {
    for (int idx = gtid; idx < M * 40; idx += NT) { const int m = idx / 40, i = idx - m * 40; const float p = (float)pos[m];
        float inv; if (i < 8) inv = exp2f(-(float)i * (18.931568569324174f / 8.0f)); else inv = exp2f(-(float)(i - 8) * (13.287712379549449f / 32.0f));
        double rev = (double)p * (double)inv * 0.15915494309189535; rev -= floor(rev); const float fr = (float)rev;
        const float c = __builtin_amdgcn_cosf(fr), s = __builtin_amdgcn_sinf(fr);
        if (i < 8) { R1[m * 16 + i] = c; R1[m * 16 + 8 + i] = s; } else { R2[m * 64 + (i - 8)] = c; R2[m * 64 + 32 + (i - 8)] = s; } }
}
DI void rms_row_bf16(const float* __restrict__ xrow, bf16* __restrict__ orow, int lane) {
    const f32x4* xr = (const f32x4*)xrow + lane;
    f32x4 v[4]; float s = 0.f;
#pragma unroll
    for (int j = 0; j < 4; ++j) { v[j] = xr[64 * j]; s += (v[j].x * v[j].x + v[j].y * v[j].y) + (v[j].z * v[j].z + v[j].w * v[j].w); }
    const float rstd = 1.f / sqrtf(wave_sum(s) * (1.f / D) + EPS);
    unsigned long long* o8 = (unsigned long long*)orow + lane;
#pragma unroll
    for (int j = 0; j < 4; ++j) o8[64 * j] = (unsigned long long)pk2(v[j].x * rstd, v[j].y * rstd) | ((unsigned long long)pk2(v[j].z * rstd, v[j].w * rstd) << 32);
}
DI void rms_phase(const float* src, bf16* dst, int gw, int NGW, int lane) {
    for (int m = gw; m < M; m += NGW) rms_row_bf16(src + (size_t)m * D, dst + (size_t)m * D, lane);
}
DI void cmp_bias_item(const float* __restrict__ posf, const float* __restrict__ w1, float* __restrict__ outp, int jb, int ch, int lane) {
    const int j = jb * 64 + lane; float a0 = 0.f, a1 = 0.f, a2 = 0.f, a3 = 0.f;
#pragma unroll 2
    for (int i = ch * 256; i < ch * 256 + 256; i += 4) {
        a0 += posf[i] * w1[(size_t)i * 256 + j]; a1 += posf[i + 1] * w1[(size_t)(i + 1) * 256 + j];
        a2 += posf[i + 2] * w1[(size_t)(i + 2) * 256 + j]; a3 += posf[i + 3] * w1[(size_t)(i + 3) * 256 + j]; }
    outp[ch * 256 + j] = (a0 + a1) + (a2 + a3);
}

DI void head_norm_rope(float (&x)[8], const float* __restrict__ gain, int sub, const float* __restrict__ cs) {
    float ss = 0.f;
#pragma unroll
    for (int i = 0; i < 8; ++i) ss += x[i] * x[i];
    ss = sum8(ss);
    const float rstd = 1.f / sqrtf(ss * (1.f / 64.f) + EPS);
#pragma unroll
    for (int i = 0; i < 8; ++i) x[i] = x[i] * rstd * gain[sub * 8 + i];
#pragma unroll
    for (int i = 0; i < 8; ++i) { const float other = xor1(x[i]); const float c = cs[i], s = cs[8 + i];
        if (sub == 0) x[i] = x[i] * c - other * s; else if (sub == 1) x[i] = x[i] * c + other * s; }
}
DI void q8_token(const bf16* __restrict__ src, const float* __restrict__ gain, const float* __restrict__ cs, bf16* __restrict__ dst, size_t hstride, int lane) {
    const int head = lane >> 3, sub = lane & 7; float x[8];
    unpack8(*(const v4u*)(src + head * 64 + sub * 8), x);
    head_norm_rope(x, gain, sub, cs);
    *(v4u*)(dst + (size_t)head * hstride + sub * 8) = pack8(x);
}

constexpr int LP = 72;
constexpr int L_QIN = 0, L_KIN = 64 * LP * 2, L_KST = 2 * 64 * LP * 2, L_VT = 3 * 64 * LP * 2;

template <bool RET>
DI void chunk_phaseA(LAS unsigned char* lds, const bf16* __restrict__ PROJ, int ldp, int cq, int ck, int cv, int cglow,
                     const float* __restrict__ gate_up, const float* __restrict__ gate_bias, const float* __restrict__ rope2,
                     bf16* __restrict__ QIN, float* __restrict__ OINTRA, float* __restrict__ UT, float* __restrict__ DEC,
                     int lane, int w, int bid, int G) {
    const int r = lane & 15, quad = lane >> 4;
    for (int unit = bid; unit < NUNIT; unit += G) {
        const int b = unit >> 8, h = (unit >> 6) & 3, n = unit & 63;
        const int m = b * T + n * 64 + lane;
        const bf16* prow = PROJ + (size_t)m * ldp;
        float la[8];
        if (!RET) {
            float gl[16]; { float t8[8]; unpack8(*(const v4u*)(prow + cglow), t8);
#pragma unroll
                for (int i = 0; i < 8; ++i) gl[i] = t8[i];
                unpack8(*(const v4u*)(prow + cglow + 8), t8);
#pragma unroll
                for (int i = 0; i < 8; ++i) gl[8 + i] = t8[i]; }
#pragma unroll
            for (int cc = 0; cc < 8; ++cc) { const int c = h * 64 + 8 * w + cc; float x = gate_bias[c];
#pragma unroll
                for (int rr = 0; rr < 16; ++rr) x += gl[rr] * gate_up[rr * 256 + c];
                la[cc] = (fminf(x, 0.f) - __logf(1.f + __expf(-fabsf(x)))) * (1.f / 16.f); }
        } else {
            const float lg = logf(1.f - exp2f(-5.f - (float)h));
#pragma unroll
            for (int cc = 0; cc < 8; ++cc) la[cc] = lg;
        }
        float bl[8];
#pragma unroll
        for (int cc = 0; cc < 8; ++cc) la[cc] = scan64(la[cc], lane, bl[cc]);
        float q[8], k[8];
        if (!RET) {
            unpack8(*(const v4u*)(prow + cq + h * 64 + 8 * w), q); unpack8(*(const v4u*)(prow + ck + h * 64 + 8 * w), k);
#pragma unroll
            for (int i = 0; i < 8; ++i) q[i] *= 0.125f;
        } else {
            const int c0 = 8 * w, cp = (c0 + 32) & 63; float qp[8], kp[8];
            unpack8(*(const v4u*)(prow + cq + h * 64 + c0), q); unpack8(*(const v4u*)(prow + cq + h * 64 + cp), qp);
            unpack8(*(const v4u*)(prow + ck + h * 64 + c0), k); unpack8(*(const v4u*)(prow + ck + h * 64 + cp), kp);
            const float* cs = rope2 + (size_t)m * 64 + (c0 & 31);
#pragma unroll
            for (int i = 0; i < 8; ++i) { const float c = cs[i], s = cs[32 + i];
                if (c0 < 32) { q[i] = q[i] * c - qp[i] * s; k[i] = (k[i] * c - kp[i] * s) * 0.125f; }
                else         { q[i] = q[i] * c + qp[i] * s; k[i] = (k[i] * c + kp[i] * s) * 0.125f; } }
        }
        float qin[8], kin[8];
        LAS bf16* kst = (LAS bf16*)(lds + L_KST);
#pragma unroll
        for (int cc = 0; cc < 8; ++cc) { qin[cc] = q[cc] * __expf(la[cc]); kin[cc] = k[cc] * __expf(-la[cc]);
            kst[(8 * w + cc) * LP + lane] = (bf16)f2bf(k[cc] * __expf(bl[cc] - la[cc])); }
        const v4u qv = pack8(qin), kv = pack8(kin);
        *(LAS v4u*)(lds + L_QIN + (lane * LP + 8 * w) * 2) = qv;
        *(LAS v4u*)(lds + L_KIN + (lane * LP + 8 * w) * 2) = kv;
        *(v4u*)(QIN + (size_t)unit * 4096 + lane * 64 + 8 * w) = qv;
        if (lane == 63) {
#pragma unroll
            for (int cc = 0; cc < 8; ++cc) DEC[(size_t)unit * 64 + 8 * w + cc] = __expf(bl[cc]); }
        { float v0[8], v1[8]; unpack8(*(const v4u*)(prow + cv + h * 128 + 16 * w), v0); unpack8(*(const v4u*)(prow + cv + h * 128 + 16 * w + 8), v1);
            LAS bf16* vt = (LAS bf16*)(lds + L_VT);
#pragma unroll
            for (int i = 0; i < 8; ++i) { vt[(16 * w + i) * LP + lane] = (bf16)f2bf(v0[i]); vt[(16 * w + 8 + i) * LP + lane] = (bf16)f2bf(v1[i]); } }
        __syncthreads();
        {
            const int tt = w & 3, dh = w >> 2;
            const bf16x8 qf0 = *(const LAS bf16x8*)(lds + L_QIN + ((tt * 16 + r) * LP + quad * 8) * 2), qf1 = *(const LAS bf16x8*)(lds + L_QIN + ((tt * 16 + r) * LP + 32 + quad * 8) * 2);
            f32x4 acc[4];
#pragma unroll
            for (int d4 = 0; d4 < 4; ++d4) acc[d4] = (f32x4){0.f, 0.f, 0.f, 0.f};
            const int nks = (tt >> 1) + 1;
            for (int ks = 0; ks < nks; ++ks) { const int kb = 32 * ks, krow = kb + ((r >> 2) << 3) + (r & 3);
                const LAS unsigned char* kp = lds + L_KIN + (krow * LP + quad * 8) * 2;
                const bf16x8 k00 = *(const LAS bf16x8*)kp, k01 = *(const LAS bf16x8*)(kp + 64), k10 = *(const LAS bf16x8*)(kp + 4 * LP * 2), k11 = *(const LAS bf16x8*)(kp + 4 * LP * 2 + 64);
                f32x4 s0 = mfma16(k00, qf0, (f32x4){0.f, 0.f, 0.f, 0.f}); s0 = mfma16(k01, qf1, s0);
                f32x4 s1 = mfma16(k10, qf0, (f32x4){0.f, 0.f, 0.f, 0.f}); s1 = mfma16(k11, qf1, s1);
                const int tok = tt * 16 + r, key0 = kb + 8 * quad; float p[8];
#pragma unroll
                for (int jj = 0; jj < 4; ++jj) { p[jj] = (key0 + jj <= tok) ? s0[jj] : 0.f; p[4 + jj] = (key0 + 4 + jj <= tok) ? s1[jj] : 0.f; }
                const bf16x8 pf = __builtin_bit_cast(bf16x8, pack8(p));
#pragma unroll
                for (int d4 = 0; d4 < 4; ++d4) { const bf16x8 vf = *(const LAS bf16x8*)(lds + L_VT + ((dh * 64 + d4 * 16 + r) * LP + kb + quad * 8) * 2); acc[d4] = mfma16(vf, pf, acc[d4]); }
            }
#pragma unroll
            for (int d4 = 0; d4 < 4; ++d4) *(f32x4*)(OINTRA + (size_t)unit * 8192 + (tt * 16 + r) * 128 + dh * 64 + d4 * 16 + 4 * quad) = acc[d4];
        }
        {
#pragma unroll
            for (int dkt = 0; dkt < 4; ++dkt) { f32x4 au = (f32x4){0.f, 0.f, 0.f, 0.f};
#pragma unroll
                for (int ks = 0; ks < 2; ++ks) { const bf16x8 a = *(const LAS bf16x8*)(lds + L_VT + ((16 * w + r) * LP + 32 * ks + quad * 8) * 2);
                    const bf16x8 bq = *(const LAS bf16x8*)(lds + L_KST + ((dkt * 16 + r) * LP + 32 * ks + quad * 8) * 2); au = mfma16(a, bq, au); }
#pragma unroll
                for (int i = 0; i < 4; ++i) UT[(size_t)unit * 8192 + (16 * w + 4 * quad + i) * 64 + dkt * 16 + r] = au[i]; }
        }
        __syncthreads();
    }
}
DI void chunk_scan(float* __restrict__ UT, const float* __restrict__ DEC, int gtid, int NT) {
    for (int e = gtid; e < 16 * 8192; e += NT) { const int bh = e >> 13, idx = e & 8191, dk = idx & 63; float S = 0.f;
        float* up = UT + (size_t)bh * 64 * 8192 + idx; const float* dp = DEC + (size_t)bh * 64 * 64 + dk;
#pragma unroll 8
        for (int n = 0; n < 64; ++n) { const float u = up[(size_t)n * 8192], d = dp[n * 64]; up[(size_t)n * 8192] = S; S = d * S + u; } }
}
template <bool RET>
DI void chunk_phaseC(const bf16* __restrict__ QIN, const float* __restrict__ OINTRA, const float* __restrict__ UT, const bf16* __restrict__ PROJ, int ldp, int cgate,
                     const float* __restrict__ gnorm, bf16* __restrict__ MIXED, int gw, int NGW, int lane) {
    const int r = lane & 15, quad = lane >> 4;
    for (int wu = gw; wu < NUNIT * 4; wu += NGW) { const int unit = wu >> 2, tt = wu & 3; const int b = unit >> 8, h = (unit >> 6) & 3, n = unit & 63;
        const bf16* qp = QIN + (size_t)unit * 4096 + (tt * 16 + r) * 64 + quad * 8; const bf16x8 qf0 = ldg16(qp), qf1 = ldg16(qp + 32);
        f32x4 acc[8];
#pragma unroll
        for (int dt = 0; dt < 8; ++dt) { acc[dt] = *(const f32x4*)(OINTRA + (size_t)unit * 8192 + (tt * 16 + r) * 128 + dt * 16 + 4 * quad);
#pragma unroll
            for (int kk = 0; kk < 2; ++kk) { const float* sp = UT + (size_t)unit * 8192 + (dt * 16 + r) * 64 + kk * 32 + quad * 8; const f32x4 a = *(const f32x4*)sp, c = *(const f32x4*)(sp + 4);
                v4u pa; pa.x = pk2(a[0], a[1]); pa.y = pk2(a[2], a[3]); pa.z = pk2(c[0], c[1]); pa.w = pk2(c[2], c[3]);
                acc[dt] = mfma16(__builtin_bit_cast(bf16x8, pa), kk ? qf1 : qf0, acc[dt]); } }
        const int m = b * T + n * 64 + tt * 16 + r;
        float mean = 0.f;
        if (RET) { float s = 0.f;
#pragma unroll
            for (int dt = 0; dt < 8; ++dt) s += (acc[dt][0] + acc[dt][1]) + (acc[dt][2] + acc[dt][3]);
            s += __shfl_xor(s, 16); s += __shfl_xor(s, 32); mean = s * (1.f / 128.f); }
        float ss = 0.f;
#pragma unroll
        for (int dt = 0; dt < 8; ++dt)
#pragma unroll
            for (int i = 0; i < 4; ++i) { const float d = acc[dt][i] - mean; ss += d * d; }
        ss += __shfl_xor(ss, 16); ss += __shfl_xor(ss, 32);
        const float rstd = 1.f / sqrtf(ss * (1.f / 128.f) + EPS);
#pragma unroll
        for (int dt = 0; dt < 8; ++dt) { const int dv = dt * 16 + 4 * quad;
            const v2u gv = *(const v2u*)(PROJ + (size_t)m * ldp + cgate + h * 128 + dv);
            const float g0 = bflo(gv.x), g1 = bfhi(gv.x), g2 = bflo(gv.y), g3 = bfhi(gv.y);
            const float* gn = gnorm + (RET ? h * 128 : 0) + dv;
            const float y0 = (acc[dt][0] - mean) * rstd * gn[0] * silu_f(g0), y1 = (acc[dt][1] - mean) * rstd * gn[1] * silu_f(g1);
            const float y2 = (acc[dt][2] - mean) * rstd * gn[2] * silu_f(g2), y3 = (acc[dt][3] - mean) * rstd * gn[3] * silu_f(g3);
            v2u o; o.x = pk2(y0, y1); o.y = pk2(y2, y3);
            *(v2u*)(MIXED + (size_t)m * 1024 + h * 128 + dv) = o; }
    }
}

struct KVF { bf16x8 k[4]; bf16x8 v[4]; };
DI void kv_load(KVF& f, const bf16* __restrict__ Kb, const bf16* __restrict__ VTb, int kb, int r, int quad) {
    const bf16* kp = Kb + (size_t)(kb + ((r >> 2) << 3) + (r & 3)) * 64 + quad * 8;
    f.k[0] = ldg16(kp); f.k[1] = ldg16(kp + 32); f.k[2] = ldg16(kp + 256); f.k[3] = ldg16(kp + 288);
    const bf16* vp = VTb + (size_t)(kb >> 5) * 2048 + r * 32 + quad * 8;
#pragma unroll
    for (int dt = 0; dt < 4; ++dt) f.v[dt] = ldg16(vp + dt * 512);
}
DI void k_load(KVF& f, const bf16* __restrict__ Kb, int kb, int r, int quad) {
    const bf16* kp = Kb + (size_t)(kb + ((r >> 2) << 3) + (r & 3)) * 64 + quad * 8;
    f.k[0] = ldg16(kp); f.k[1] = ldg16(kp + 32); f.k[2] = ldg16(kp + 256); f.k[3] = ldg16(kp + 288);
}
DI void scores8(const KVF& f, const bf16x8 (&q)[2], float sc2, const float (&bias)[8], float (&sv)[8]) {
    f32x4 s0 = mfma16(f.k[0], q[0], (f32x4){0.f, 0.f, 0.f, 0.f}); s0 = mfma16(f.k[1], q[1], s0);
    f32x4 s1 = mfma16(f.k[2], q[0], (f32x4){0.f, 0.f, 0.f, 0.f}); s1 = mfma16(f.k[3], q[1], s1);
#pragma unroll
    for (int jj = 0; jj < 4; ++jj) { sv[jj] = s0[jj] * sc2 + bias[jj]; sv[4 + jj] = s1[jj] * sc2 + bias[4 + jj]; }
}
DI void mask_bias(unsigned vm, float c2, float (&bias)[8]) {
#pragma unroll
    for (int jj = 0; jj < 8; ++jj) bias[jj] = ((vm >> jj) & 1u) ? -c2 : -1e30f; }
DI void attn_compute(const KVF& f, unsigned vm, const bf16x8 (&qf)[4][2], f32x4 (&acc)[4][4], float (&lsum)[4], float sc2, float c2) {
    float bias[8]; mask_bias(vm, c2, bias);
#pragma unroll
    for (int g = 0; g < 4; ++g) { float sv[8]; scores8(f, qf[g], sc2, bias, sv); float p[8]; float ls = 0.f;
#pragma unroll
        for (int jj = 0; jj < 8; ++jj) { p[jj] = __builtin_amdgcn_exp2f(sv[jj]); ls += p[jj]; }
        lsum[g] += ls;
        const bf16x8 pf = __builtin_bit_cast(bf16x8, pack8(p));
#pragma unroll
        for (int dt = 0; dt < 4; ++dt) acc[g][dt] = mfma16(f.v[dt], pf, acc[g][dt]); }
}
DI unsigned win_mask(int kb, int quad, int tok, int W) { unsigned vm = 0u;
#pragma unroll
    for (int jj = 0; jj < 8; ++jj) { const int key = kb + 8 * quad + jj; if (key <= tok && key > tok - W) vm |= 1u << jj; }
    return vm; }
DI void load_q(bf16x8 (&qf)[4][2], const bf16* __restrict__ Q, int b, int hk, int t0, int r, int quad) {
#pragma unroll
    for (int g = 0; g < 4; ++g) { const bf16* qp = Q + ((size_t)(b * 8 + hk * 4 + g) * T + t0 + r) * 64 + quad * 8; qf[g][0] = ldg16(qp); qf[g][1] = ldg16(qp + 32); }
}
DI float wave_max_abs64(const float* __restrict__ g, int lane) { float v = fabsf(g[lane]);
#pragma unroll
    for (int o = 1; o < 64; o <<= 1) v = fmaxf(v, __shfl_xor(v, o));
    return v; }
DI int bal_tile(int wu) { const int u = wu & 255, w = u & 7, q = u >> 3, pair = q * 4 + (w & 3); return (w < 4) ? pair : 255 - pair; }
DI float quad_sum(float v) { v += __shfl_xor(v, 16); v += __shfl_xor(v, 32); return v; }
template <bool SINK, bool TO_MIXED>
DI void window_attn(const bf16* __restrict__ Q, const bf16* __restrict__ Kx, const bf16* __restrict__ VT, int W, const float* __restrict__ sinks, const float* __restrict__ gq, const float* __restrict__ gk,
                    bf16* __restrict__ MIXED, float* __restrict__ ONSA, const bf16* __restrict__ PROJ1, int gw, int NGW, int lane) {
    const int r = lane & 15, quad = lane >> 4; const float sc2 = 0.125f * LOG2E;
    float c2 = sc2 * 64.f * wave_max_abs64(gq, lane) * wave_max_abs64(gk, lane);
    if (SINK) { c2 = fmaxf(c2, fmaxf(fmaxf(sinks[0], sinks[1]), fmaxf(sinks[2], sinks[3])) * LOG2E); c2 = fmaxf(c2, fmaxf(fmaxf(sinks[4], sinks[5]), fmaxf(sinks[6], sinks[7])) * LOG2E); }
    for (int wu = gw; wu < BATCH * 2 * 256; wu += NGW) { const int tile = bal_tile(wu), hk = (wu >> 8) & 1, b = wu >> 9, t0 = tile * 16, tok = t0 + r;
        bf16x8 qf[4][2]; load_q(qf, Q, b, hk, t0, r, quad);
        f32x4 acc[4][4]; float lsum[4];
#pragma unroll
        for (int g = 0; g < 4; ++g) { lsum[g] = 0.f;
#pragma unroll
            for (int dt = 0; dt < 4; ++dt) acc[g][dt] = (f32x4){0.f, 0.f, 0.f, 0.f}; }
        const bf16* Kb = Kx + (size_t)(b * 2 + hk) * T * 64; const bf16* VTb = VT + (size_t)(b * 2 + hk) * 64 * T;
        int kb = t0 - (W - 1); kb = kb < 0 ? 0 : (kb & ~31);
        KVF cur, nxt; kv_load(cur, Kb, VTb, kb, r, quad);
        for (;;) { const int kbn = kb + 32; const bool more = kbn <= t0;
            if (more) kv_load(nxt, Kb, VTb, kbn, r, quad);
            attn_compute(cur, win_mask(kb, quad, tok, W), qf, acc, lsum, sc2, c2);
            if (!more) break;
            cur = nxt; kb = kbn; }
        const size_t m = (size_t)b * T + tok;
#pragma unroll
        for (int g = 0; g < 4; ++g) { float l = quad_sum(lsum[g]); if (SINK) l += __builtin_amdgcn_exp2f(sinks[hk * 4 + g] * LOG2E - c2);
            float inv = l > 0.f ? 1.f / l : 0.f;
            if (!TO_MIXED) { const float gl = __builtin_bit_cast(float, ((unsigned)PROJ1[m * N1P + C1_NG + hk * 12 + g * 3 + 2]) << 16); inv *= 1.f / (1.f + __expf(-gl)); }
#pragma unroll
            for (int dt = 0; dt < 4; ++dt) { const f32x4 o = acc[g][dt] * inv; const int col = (hk * 4 + g) * 64 + dt * 16 + 4 * quad;
                if (TO_MIXED) { v2u w2; w2.x = pk2(o[0], o[1]); w2.y = pk2(o[2], o[3]); *(v2u*)(MIXED + m * 1024 + 512 + col) = w2; }
                else *(f32x4*)(ONSA + m * 512 + col) = o; } }
    }
}

DI void nsa_cmp_slc(const bf16* __restrict__ Q, const bf16* __restrict__ KCB, const bf16* __restrict__ VCBT, const bf16* __restrict__ KSL, const bf16* __restrict__ VSLT,
                    const float* __restrict__ gq, const float* __restrict__ gkc, const float* __restrict__ gks,
                    const bf16* __restrict__ PROJ1, float* __restrict__ ONSA, bf16* __restrict__ MIXED, LAS float* plds, int gw, int NGW, int lane) {
    const int r = lane & 15, quad = lane >> 4; const float sc2 = 0.125f * LOG2E;
    const float gqm = wave_max_abs64(gq, lane); const float c2c = sc2 * 64.f * gqm * wave_max_abs64(gkc, lane), c2s = sc2 * 64.f * gqm * wave_max_abs64(gks, lane);
    for (int wu = gw; wu < BATCH * 2 * 256; wu += NGW) { const int tile = bal_tile(wu), hk = (wu >> 8) & 1, b = wu >> 9, t0 = tile * 16, tok = t0 + r;
        bf16x8 qf[4][2]; load_q(qf, Q, b, hk, t0, r, quad);
        const size_t m = (size_t)b * T + tok;
#pragma unroll
        for (int i = 0; i < 16; ++i) *(LAS f32x4*)(plds + (i * 64 + lane) * 4) = (f32x4){0.f, 0.f, 0.f, 0.f};
        const bf16* Kc = KCB + (size_t)(b * 2 + hk) * 256 * 64; const bf16* Vc = VCBT + (size_t)(b * 2 + hk) * 64 * 256;
        const int nsteps = ((t0 >> 4) + 31) >> 5;
        float lsum[4];
#pragma unroll
        for (int g = 0; g < 4; ++g) lsum[g] = 0.f;
        KVF cur;
        for (int st = 0; st < nsteps; ++st) { const int kb = 32 * st; k_load(cur, Kc, kb, r, quad);
            unsigned vm = 0u;
#pragma unroll
            for (int jj = 0; jj < 8; ++jj) if (16 * (kb + 8 * quad + jj) + 31 <= tok) vm |= 1u << jj;
            float bias[8]; mask_bias(vm, c2c, bias);
#pragma unroll
            for (int g = 0; g < 4; ++g) { float sv[8]; scores8(cur, qf[g], sc2, bias, sv);
#pragma unroll
                for (int jj = 0; jj < 8; ++jj) lsum[g] += __builtin_amdgcn_exp2f(sv[jj]); } }
        float invl[4];
#pragma unroll
        for (int g = 0; g < 4; ++g) { const float l = quad_sum(lsum[g]); invl[g] = l > 0.f ? 1.f / l : 0.f; }
        f32x4 acc[4][4];
#pragma unroll
        for (int g = 0; g < 4; ++g)
#pragma unroll
            for (int dt = 0; dt < 4; ++dt) acc[g][dt] = (f32x4){0.f, 0.f, 0.f, 0.f};
        for (int st = 0; st < nsteps; ++st) { const int kb = 32 * st; kv_load(cur, Kc, Vc, kb, r, quad);
            unsigned vm = 0u;
#pragma unroll
            for (int jj = 0; jj < 8; ++jj) if (16 * (kb + 8 * quad + jj) + 31 <= tok) vm |= 1u << jj;
            float bias[8]; mask_bias(vm, c2c, bias);
            float psum[8];
#pragma unroll
            for (int jj = 0; jj < 8; ++jj) psum[jj] = 0.f;
#pragma unroll
            for (int g = 0; g < 4; ++g) { float sv[8]; scores8(cur, qf[g], sc2, bias, sv); float p[8];
#pragma unroll
                for (int jj = 0; jj < 8; ++jj) { p[jj] = __builtin_amdgcn_exp2f(sv[jj]) * invl[g]; psum[jj] += p[jj]; }
                const bf16x8 pf = __builtin_bit_cast(bf16x8, pack8(p));
#pragma unroll
                for (int dt = 0; dt < 4; ++dt) acc[g][dt] = mfma16(cur.v[dt], pf, acc[g][dt]); }
            *(LAS f32x4*)(plds + r * 256 + kb + 8 * quad) = (f32x4){psum[0], psum[1], psum[2], psum[3]};
            *(LAS f32x4*)(plds + r * 256 + kb + 8 * quad + 4) = (f32x4){psum[4], psum[5], psum[6], psum[7]}; }
#pragma unroll
        for (int g = 0; g < 4; ++g) { const float gate0 = 1.f / (1.f + __expf(-__builtin_bit_cast(float, ((unsigned)PROJ1[m * N1P + C1_NG + hk * 12 + g * 3]) << 16)));
#pragma unroll
            for (int dt = 0; dt < 4; ++dt) { float* op = ONSA + m * 512 + (hk * 4 + g) * 64 + dt * 16 + 4 * quad; *(f32x4*)op = *(const f32x4*)op + acc[g][dt] * gate0; } }
        LDS_WAIT(); asm volatile("" ::: "memory"); __builtin_amdgcn_wave_barrier();
        unsigned long long mymask = 0ull, uni = 0ull;
        for (int tk = 0; tk < 16; ++tk) { const int tblk = (t0 + tk) >> 6, j = lane; const LAS float* pr = plds + tk * 256 + 4 * j;
            const f32x4 pv = *(const LAS f32x4*)pr; const float pm1 = (j > 0) ? pr[-1] : 0.f;
            const float imp = pm1 + 2.f * pv[0] + 2.f * pv[1] + 2.f * pv[2] + pv[3];
            const bool forced = (j == 0) || (j == tblk) || (j == tblk - 1), allowed = j <= tblk;
            const float score = forced ? 1e9f : (allowed ? imp : -1e9f);
            unsigned u = __builtin_bit_cast(unsigned, score); u = (u & 0x80000000u) ? ~u : (u | 0x80000000u);
            const unsigned key = (u & ~63u) | (unsigned)(63 - j);
            unsigned prefix = 0u;
#pragma unroll
            for (int bit = 31; bit >= 0; --bit) { const unsigned cand = prefix | (1u << bit); const unsigned long long ge = __ballot(key >= cand); if (__builtin_popcountll(ge) >= 16) prefix = cand; }
            const unsigned long long mask = __ballot((key >= prefix) && allowed);
            if (r == tk) mymask = mask;
            uni |= mask; }
#pragma unroll
        for (int g = 0; g < 4; ++g) { lsum[g] = 0.f;
#pragma unroll
            for (int dt = 0; dt < 4; ++dt) acc[g][dt] = (f32x4){0.f, 0.f, 0.f, 0.f}; }
        const bf16* Kb = KSL + (size_t)(b * 2 + hk) * T * 64; const bf16* VTb = VSLT + (size_t)(b * 2 + hk) * 64 * T;
        {
            int j = __builtin_ctzll(uni), hf = 0; uni &= uni - 1ull; KVF nxt;
            kv_load(cur, Kb, VTb, 64 * j, r, quad);
            for (;;) { int jn = j, hn = 1; bool more = true;
                if (hf) { if (uni) { jn = __builtin_ctzll(uni); uni &= uni - 1ull; hn = 0; } else more = false; }
                if (more) kv_load(nxt, Kb, VTb, 64 * jn + 32 * hn, r, quad);
                const int kb = 64 * j + 32 * hf; const bool sb = (mymask >> j) & 1ull; unsigned vm = 0u;
#pragma unroll
                for (int jj = 0; jj < 8; ++jj) if (sb && (kb + 8 * quad + jj <= tok)) vm |= 1u << jj;
                attn_compute(cur, vm, qf, acc, lsum, sc2, c2s);
                if (!more) break;
                cur = nxt; j = jn; hf = hn; } }
#pragma unroll
        for (int g = 0; g < 4; ++g) { const float l = quad_sum(lsum[g]); const float gate1 = 1.f / (1.f + __expf(-__builtin_bit_cast(float, ((unsigned)PROJ1[m * N1P + C1_NG + hk * 12 + g * 3 + 1]) << 16)));
            const float inv = (l > 0.f ? 1.f / l : 0.f) * gate1;
#pragma unroll
            for (int dt = 0; dt < 4; ++dt) { const int col = (hk * 4 + g) * 64 + dt * 16 + 4 * quad; const f32x4 o = *(const f32x4*)(ONSA + m * 512 + col) + acc[g][dt] * inv;
                v2u w2; w2.x = pk2(o[0], o[1]); w2.y = pk2(o[2], o[3]); *(v2u*)(MIXED + m * 1024 + 512 + col) = w2; } }
        __builtin_amdgcn_wave_barrier();
    }
}
DI float gelu_tanh(float x) { const float u = 0.7978845608028654f * (x + 0.044715f * x * x * x); const float e = __expf(2.f * u); const float th = 1.f - 2.f / (e + 1.f); return 0.5f * x * (1.f + th); }
DI void cmp_layer2(const float* __restrict__ CMPH, const bf16* __restrict__ W2T, const float* __restrict__ b2k, const float* __restrict__ b2v,
                   const float* __restrict__ kcnorm, const float* __restrict__ rope1, bf16* __restrict__ KCB, bf16* __restrict__ VCBT, int gw, int NGW, int lane) {
    const int r = lane & 15, quad = lane >> 4;
    for (int wu = gw; wu < 256; wu += NGW) { const int kv = wu >> 7, rt = wu & 127;
        const float* hp = CMPH + ((size_t)kv * 2048 + rt * 16 + r) * 256 + quad * 8; const bf16* wp = W2T + (size_t)kv * 64 * 256 + (size_t)r * 256 + quad * 8;
        f32x4 acc[4];
#pragma unroll
        for (int nt = 0; nt < 4; ++nt) acc[nt] = (f32x4){0.f, 0.f, 0.f, 0.f};
#pragma unroll
        for (int kk = 0; kk < 8; ++kk) { const f32x4 h0 = *(const f32x4*)(hp + kk * 32), h1 = *(const f32x4*)(hp + kk * 32 + 4);
            float ge[8];
#pragma unroll
            for (int i = 0; i < 4; ++i) { ge[i] = gelu_tanh(h0[i]); ge[4 + i] = gelu_tanh(h1[i]); }
            const bf16x8 af = __builtin_bit_cast(bf16x8, pack8(ge));
#pragma unroll
            for (int nt = 0; nt < 4; ++nt) acc[nt] = mfma16(af, ldg16(wp + (size_t)nt * 16 * 256 + kk * 32), acc[nt]); }
        const float* b2 = kv ? b2v : b2k;
#pragma unroll
        for (int nt = 0; nt < 4; ++nt) { const float bb = b2[nt * 16 + r]; acc[nt] = acc[nt] + bb; }
#pragma unroll
        for (int i = 0; i < 4; ++i) { const int row = rt * 16 + 4 * quad + i, bh = row >> 8, n = row & 255; const bool pad = (n == 255);
            if (kv == 0) { float ss = 0.f;
#pragma unroll
                for (int nt = 0; nt < 4; ++nt) ss += acc[nt][i] * acc[nt][i];
                ss = sum16(ss); const float rstd = 1.f / sqrtf(ss * (1.f / 64.f) + EPS);
                float y[4];
#pragma unroll
                for (int nt = 0; nt < 4; ++nt) y[nt] = acc[nt][i] * rstd * kcnorm[nt * 16 + r];
                const float other = dppf<0x128>(y[0]);
                const float* cs = rope1 + ((size_t)(bh >> 1) * T + (pad ? 0 : 16 * n + 31)) * 16;
                y[0] = (r < 8) ? y[0] * cs[r] - other * cs[8 + r] : y[0] * cs[r - 8] + other * cs[r];
#pragma unroll
                for (int nt = 0; nt < 4; ++nt) KCB[((size_t)bh * 256 + n) * 64 + nt * 16 + r] = pad ? (bf16)0 : (bf16)f2bf(y[nt]);
            } else {
#pragma unroll
                for (int nt = 0; nt < 4; ++nt) VCBT[(((size_t)bh * 8 + (n >> 5)) * 64 + nt * 16 + r) * 32 + (n & 31)] = pad ? (bf16)0 : (bf16)f2bf(acc[nt][i]);
            } }
    }
}

DI void prep0_swa(const bf16* __restrict__ PROJ, const float* __restrict__ qn, const float* __restrict__ kn, const float* __restrict__ rope1,
                  bf16* __restrict__ QS, bf16* __restrict__ KS, bf16* __restrict__ VST, int lane, int w, int bid, int G) {
    for (int grp = bid; grp < M / 64; grp += G) { const int m0 = grp * 64, b = m0 / T, t0 = m0 % T;
#pragma unroll 4
        for (int i = 0; i < 8; ++i) { const int tl = 8 * w + i; const size_t m = (size_t)m0 + tl;
            q8_token(PROJ + m * N0P + C0_SQ, qn, rope1 + m * 16, QS + ((size_t)(b * 8) * T + t0 + tl) * 64, (size_t)T * 64, lane); }
        for (int p = 0; p < 2; ++p) { const int tl = 8 * w + 4 * p + (lane >> 4), head = (lane >> 3) & 1, sub = lane & 7; const size_t m = (size_t)m0 + tl; float x[8];
            unpack8(*(const v4u*)(PROJ + m * N0P + C0_SK + head * 64 + sub * 8), x); head_norm_rope(x, kn, sub, rope1 + m * 16);
            *(v4u*)(KS + ((size_t)(b * 2 + head) * T + t0 + tl) * 64 + sub * 8) = pack8(x); }
        { const size_t m = (size_t)m0 + lane; const v4u a = *(const v4u*)(PROJ + m * N0P + C0_SV + 16 * w), c = *(const v4u*)(PROJ + m * N0P + C0_SV + 16 * w + 8);
            const unsigned wv[8] = {a.x, a.y, a.z, a.w, c.x, c.y, c.z, c.w};
#pragma unroll
            for (int i = 0; i < 16; ++i) { const int hd = 16 * w + i; VST[(((size_t)(b * 2 + (hd >> 6)) * (T / 32) + ((t0 + lane) >> 5)) * 64 + (hd & 63)) * 32 + ((t0 + lane) & 31)] = (bf16)((i & 1) ? (wv[i >> 1] >> 16) : (wv[i >> 1] & 0xffffu)); } }
    }
}
DI void prep1_nsa(const bf16* __restrict__ PROJ, const float* __restrict__ qn, const float* __restrict__ ksn, const float* __restrict__ kwn, const float* __restrict__ rope1,
                  bf16* __restrict__ QS, bf16* __restrict__ KS, bf16* __restrict__ KW, bf16* __restrict__ KCR, bf16* __restrict__ VCR, bf16* __restrict__ VST, bf16* __restrict__ VWT,
                  int lane, int w, int bid, int G) {
    for (int grp = bid; grp < M / 64; grp += G) { const int m0 = grp * 64, b = m0 / T, t0 = m0 % T;
#pragma unroll 4
        for (int i = 0; i < 8; ++i) { const int tl = 8 * w + i; const size_t m = (size_t)m0 + tl;
            q8_token(PROJ + m * N1P + C1_NQ, qn, rope1 + m * 16, QS + ((size_t)(b * 8) * T + t0 + tl) * 64, (size_t)T * 64, lane); }
        for (int p = 0; p < 2; ++p) { const int tl = 8 * w + 4 * p + (lane >> 4), head = (lane >> 3) & 1, sub = lane & 7; const size_t m = (size_t)m0 + tl; float x[8];
            const size_t dsto = ((size_t)(b * 2 + head) * T + t0 + tl) * 64 + sub * 8;
            unpack8(*(const v4u*)(PROJ + m * N1P + C1_KSL + head * 64 + sub * 8), x); head_norm_rope(x, ksn, sub, rope1 + m * 16); *(v4u*)(KS + dsto) = pack8(x);
            unpack8(*(const v4u*)(PROJ + m * N1P + C1_KWN + head * 64 + sub * 8), x); head_norm_rope(x, kwn, sub, rope1 + m * 16); *(v4u*)(KW + dsto) = pack8(x);
            *(v4u*)(KCR + dsto) = *(const v4u*)(PROJ + m * N1P + C1_KC + head * 64 + sub * 8);
            *(v4u*)(VCR + dsto) = *(const v4u*)(PROJ + m * N1P + C1_VC + head * 64 + sub * 8); }
#pragma unroll
        for (int which = 0; which < 2; ++which) { const size_t m = (size_t)m0 + lane; const int cbase = which ? C1_VWN : C1_VSL; bf16* dst = which ? VWT : VST;
            const v4u a = *(const v4u*)(PROJ + m * N1P + cbase + 16 * w), c = *(const v4u*)(PROJ + m * N1P + cbase + 16 * w + 8);
            const unsigned wv[8] = {a.x, a.y, a.z, a.w, c.x, c.y, c.z, c.w};
#pragma unroll
            for (int i = 0; i < 16; ++i) { const int hd = 16 * w + i; dst[(((size_t)(b * 2 + (hd >> 6)) * (T / 32) + ((t0 + lane) >> 5)) * 64 + (hd & 63)) * 32 + ((t0 + lane) & 31)] = (bf16)((i & 1) ? (wv[i >> 1] >> 16) : (wv[i >> 1] & 0xffffu)); } }
    }
}

DI void moe_route(const float* __restrict__ H, const float* __restrict__ gln, const float* __restrict__ rw, const float* __restrict__ rb, bf16* __restrict__ XN,
                  int* __restrict__ TOKE, float* __restrict__ TOKW, int* __restrict__ TOKR, unsigned* CNT, LAS unsigned char* lds, int tid, int lane, int w, int bid, int G) {
    LAS unsigned* lcnt = (LAS unsigned*)lds; LAS int* le = (LAS int*)(lds + 64); LAS int* lr = (LAS int*)(lds + 64 + 512);
    for (int blk = bid; blk < M / 64; blk += G) {
        if (tid < 16) lcnt[tid] = 0u;
        __syncthreads();
        for (int i = 0; i < 8; ++i) { const int rl = 8 * w + i; const size_t m = (size_t)blk * 64 + rl;
            const f32x4* xr = (const f32x4*)(H + m * D) + lane; f32x4 v[4]; float s = 0.f;
#pragma unroll
            for (int j = 0; j < 4; ++j) { v[j] = xr[64 * j]; s += (v[j].x * v[j].x + v[j].y * v[j].y) + (v[j].z * v[j].z + v[j].w * v[j].w); }
            const float rstd = 1.f / sqrtf(wave_sum(s) * (1.f / D) + EPS);
            unsigned long long* o8 = (unsigned long long*)(XN + m * D) + lane;
            float lg[8];
#pragma unroll
            for (int e = 0; e < 8; ++e) lg[e] = 0.f;
#pragma unroll
            for (int j = 0; j < 4; ++j) { o8[64 * j] = (unsigned long long)pk2(v[j].x * rstd, v[j].y * rstd) | ((unsigned long long)pk2(v[j].z * rstd, v[j].w * rstd) << 32);
#pragma unroll
                for (int c = 0; c < 4; ++c) { const int col = (lane + 64 * j) * 4 + c; const float x = v[j][c] * rstd * gln[col]; const f32x4* wr = (const f32x4*)(rw + (size_t)col * 8); const f32x4 a = wr[0], bq = wr[1];
                    lg[0] += x * a[0]; lg[1] += x * a[1]; lg[2] += x * a[2]; lg[3] += x * a[3]; lg[4] += x * bq[0]; lg[5] += x * bq[1]; lg[6] += x * bq[2]; lg[7] += x * bq[3]; } }
#pragma unroll
            for (int e = 0; e < 8; ++e) lg[e] = wave_sum(lg[e]) + rb[e];
            if (lane == 0) { float v1 = lg[0]; int e1 = 0;
#pragma unroll
                for (int e = 1; e < 8; ++e) if (lg[e] > v1) { v1 = lg[e]; e1 = e; }
                float v2 = -3.0e38f; int e2 = 0;
#pragma unroll
                for (int e = 0; e < 8; ++e) if (e != e1 && lg[e] > v2) { v2 = lg[e]; e2 = e; }
                const float w1 = 1.f / (1.f + expf(v2 - v1));
                TOKE[2 * m] = e1; TOKE[2 * m + 1] = e2; TOKW[2 * m] = w1; TOKW[2 * m + 1] = 1.f - w1;
                le[2 * rl] = e1; le[2 * rl + 1] = e2; lr[2 * rl] = (int)atomicAdd((unsigned*)&lcnt[e1], 1u); lr[2 * rl + 1] = (int)atomicAdd((unsigned*)&lcnt[e2], 1u); }
        }
        __syncthreads();
        if (tid < 8) lcnt[8 + tid] = __hip_atomic_fetch_add(CNT + tid, lcnt[tid], __ATOMIC_RELAXED, __HIP_MEMORY_SCOPE_AGENT);
        __syncthreads();
        if (tid < 128) { const size_t m = (size_t)blk * 64 + (tid >> 1); TOKR[2 * m + (tid & 1)] = lr[tid] + (int)lcnt[8 + le[tid]]; }
        __syncthreads();
    }
}
DI void moe_dispatch(unsigned* CNT, const bf16* __restrict__ XN, const int* __restrict__ TOKE, const int* __restrict__ TOKR, int* __restrict__ TOKS, bf16* __restrict__ XS,
                     int* __restrict__ TILEE, unsigned* NTW, LAS unsigned char* lds, int tid, int lane, int w, int bid, int G) {
    LAS int* lbase = (LAS int*)lds;
    if (tid == 0) { int acc = 0;
        for (int e = 0; e < 8; ++e) { const int c = (int)__hip_atomic_load(CNT + e, __ATOMIC_RELAXED, __HIP_MEMORY_SCOPE_AGENT); lbase[e] = acc; lbase[16 + e] = c; acc += (c + 255) & ~255; }
        lbase[8] = acc; }
    __syncthreads();
    const int ntiles = lbase[8] >> 8;
    if (bid == 0) { for (int t = tid; t < ntiles; t += 512) { int e = 0;
#pragma unroll
            for (int k = 1; k < 8; ++k) if (t * 256 >= lbase[k]) e = k;
            TILEE[t] = e; }
        if (tid == 0) *NTW = (unsigned)ntiles; }
    const int gw = bid * NWAVES + w, NGW = G * NWAVES;
    for (int m = gw; m < M; m += NGW) {
#pragma unroll
        for (int k = 0; k < 2; ++k) { const int e = TOKE[2 * m + k], slot = lbase[e] + TOKR[2 * m + k]; if (lane == 0) TOKS[2 * m + k] = slot;
            const v4u* src = (const v4u*)(XN + (size_t)m * D) + lane; v4u* dst = (v4u*)(XS + (size_t)slot * D) + lane; dst[0] = src[0]; dst[64] = src[64]; } }
    for (int e = 0; e < 8; ++e) { const int lo = lbase[e] + lbase[16 + e], hi = lbase[e + 1];
        for (int row = lo + gw; row < hi; row += NGW) { v4u* dst = (v4u*)(XS + (size_t)row * D) + lane; dst[0] = (v4u){0u, 0u, 0u, 0u}; dst[64] = (v4u){0u, 0u, 0u, 0u}; } }
}
DI void moe_combine(float* __restrict__ OUT, const bf16* __restrict__ Y, const int* __restrict__ TOKS, const float* __restrict__ TOKW, int gw, int NGW, int lane) {
    for (int m = gw; m < M; m += NGW) { const int s0 = TOKS[2 * m], s1 = TOKS[2 * m + 1]; const float w0 = TOKW[2 * m], w1 = TOKW[2 * m + 1];
#pragma unroll
        for (int j = 0; j < 4; ++j) { const int col = lane * 4 + 256 * j; f32x4* op = (f32x4*)(OUT + (size_t)m * D + col);
            const v2u a = *(const v2u*)(Y + (size_t)s0 * D + col), c = *(const v2u*)(Y + (size_t)s1 * D + col); f32x4 o = *op;
            o[0] += w0 * bflo(a.x) + w1 * bflo(c.x); o[1] += w0 * bfhi(a.x) + w1 * bfhi(c.x); o[2] += w0 * bflo(a.y) + w1 * bflo(c.y); o[3] += w0 * bfhi(a.y) + w1 * bfhi(c.y); *op = o; } }
}

#ifndef ONE_LAUNCH
#define ONE_LAUNCH 1
#endif
#ifndef STOP_PHASE
#define STOP_PHASE 23
#endif
constexpr int NPHASE = 23;
#ifndef DUP_MASK
#define DUP_MASK 0u
#endif
#define DUPN(k) (int)((DUP_MASK >> (k)) & 1u)
#define REP(k) _Pragma("unroll") for (int rep = 0; rep <= DUPN(k); ++rep)
#define REPBAR() do { if (rep) xcd_barrier(bar); } while (0)
struct Args { const void* in[39]; float* out; unsigned char* ws; int ph_lo, ph_hi; };

__global__ void __launch_bounds__(NWAVES * 64, 2) hybrid_fwd(Args args) {
    extern __shared__ __attribute__((aligned(16))) unsigned char lds_raw[];
    LAS unsigned char* lds = (LAS unsigned char*)lds_raw;
    const int tid = threadIdx.x, lane = tid & 63, w = __builtin_amdgcn_readfirstlane(tid >> 6);
    const int G = gridDim.x, bid = blockIdx.x;
    const int gw = bid * NWAVES + w, NGW = G * NWAVES, gtid = bid * (NWAVES * 64) + tid, NTH = G * NWAVES * 64;
    unsigned char* ws = args.ws;
    unsigned* CTL = (unsigned*)(ws + WS_CTL);
    for (int u = tid; u < (LDS_BYTES - LDSCTL_OFF) / 4; u += NWAVES * 64) ((LAS unsigned*)(lds + LDSCTL_OFF))[u] = 0u;
    __syncthreads();
    XcdBarrier bar; bar.bar = CTL + CW_BAR; bar.x = 0; bar.st = nullptr;
    if (ONE_LAUNCH) bar = xcd_barrier_post(CTL + CW_BAR, (volatile LAS unsigned*)(lds + MISC_OFF) + 8);
    const int lo = args.ph_lo, hi = args.ph_hi < STOP_PHASE ? args.ph_hi : STOP_PHASE;
#define IN(k) (lo <= (k) && (k) < hi)
#define SEAM(k) do { if (ONE_LAUNCH && IN(k) && IN((k) + 1)) xcd_barrier(bar); } while (0)

    const float* x = (const float*)args.in[0]; const int* positions = (const int*)args.in[1];
    const float* ln_mix_e = (const float*)args.in[2]; const float* w_in_e = (const float*)args.in[3];
    const float* gla_gate_up = (const float*)args.in[4]; const float* gla_gate_bias = (const float*)args.in[5]; const float* gla_out_norm = (const float*)args.in[6];
    const float* swa_q_norm = (const float*)args.in[7]; const float* swa_k_norm = (const float*)args.in[8]; const float* swa_sinks = (const float*)args.in[9];
    const float* w_out_e = (const float*)args.in[10]; const float* ln_ffn_e = (const float*)args.in[11];
    const float* ffn_w_gate = (const float*)args.in[12]; const float* ffn_w_up = (const float*)args.in[13]; const float* ffn_w_down = (const float*)args.in[14];
    const float* ln_mix_o = (const float*)args.in[15]; const float* w_in_o = (const float*)args.in[16]; const float* ret_out_norm = (const float*)args.in[17];
    const float* nsa_q_norm = (const float*)args.in[18]; const float* nsa_kc_norm = (const float*)args.in[19]; const float* nsa_ks_norm = (const float*)args.in[20]; const float* nsa_kw_norm = (const float*)args.in[21];
    const float* cmp_pos_k = (const float*)args.in[22]; const float* cmp_w1_k = (const float*)args.in[23]; const float* cmp_b1_k = (const float*)args.in[24]; const float* cmp_w2_k = (const float*)args.in[25]; const float* cmp_b2_k = (const float*)args.in[26];
    const float* cmp_pos_v = (const float*)args.in[27]; const float* cmp_w1_v = (const float*)args.in[28]; const float* cmp_b1_v = (const float*)args.in[29]; const float* cmp_w2_v = (const float*)args.in[30]; const float* cmp_b2_v = (const float*)args.in[31];
    const float* w_out_o = (const float*)args.in[32]; const float* ln_ffn_o = (const float*)args.in[33]; const float* router_w = (const float*)args.in[34]; const float* router_b = (const float*)args.in[35];
    const float* exp_w_gate = (const float*)args.in[36]; const float* exp_w_up = (const float*)args.in[37]; const float* exp_w_down = (const float*)args.in[38];
    float* out = args.out;
    float* ROPE1 = (float*)(ws + WS_ROPE1); float* ROPE2 = (float*)(ws + WS_ROPE2);
    bf16* WIN0 = (bf16*)(ws + WS_WIN0); bf16* WOUT0 = (bf16*)(ws + WS_WOUT0); bf16* WGU = (bf16*)(ws + WS_WGU); bf16* WDN = (bf16*)(ws + WS_WDN);
    bf16* WIN1 = (bf16*)(ws + WS_WIN1); bf16* WOUT1 = (bf16*)(ws + WS_WOUT1); bf16* WCMP = (bf16*)(ws + WS_WCMP); bf16* MOEGU = (bf16*)(ws + WS_MOEGU); bf16* MOED = (bf16*)(ws + WS_MOED);
    bf16* XN = (bf16*)(ws + WS_XN); bf16* MIXED = XN; bf16* PROJ = (bf16*)(ws + WS_PROJ); bf16* ACT = PROJ;
    bf16* QS = (bf16*)(ws + WS_QS); bf16* KS = (bf16*)(ws + WS_KS); bf16* VST = (bf16*)(ws + WS_VST);
    bf16* QIN = (bf16*)(ws + WS_QIN); float* OINTRA = (float*)(ws + WS_OINTRA); float* UT = (float*)(ws + WS_UT); float* DEC = (float*)(ws + WS_DEC);
    float* ONSA = (float*)(ws + WS_ONSA); float* CMPH = (float*)(ws + WS_CMPH);
    bf16* KCR = (bf16*)(ws + WS_KCR); bf16* VCR = (bf16*)(ws + WS_VCR); bf16* KW = (bf16*)(ws + WS_KW); bf16* VWT = (bf16*)(ws + WS_VWT);
    bf16* KCB = (bf16*)(ws + WS_CMPT + CT_KCB); bf16* VCBT = (bf16*)(ws + WS_CMPT + CT_VCBT); float* B1P = (float*)(ws + WS_CMPT + CT_B1P); bf16* W2T = (bf16*)(ws + WS_CMPT + CT_W2T);
    int* TOKE = (int*)(ws + WS_TAB + TB_TOKE); float* TOKW = (float*)(ws + WS_TAB + TB_TOKW); int* TOKR = (int*)(ws + WS_TAB + TB_TOKR); int* TOKS = (int*)(ws + WS_TAB + TB_TOKS); int* TILEE = (int*)(ws + WS_TAB + TB_TILEE);
    bf16* XS = (bf16*)(ws + WS_XS); bf16* ACTH = (bf16*)(ws + WS_ACTH);
    LAS unsigned char* scr = lds + w * 16384;

    if (IN(0)) REP(0) { REPBAR();
        if (gw < 64) { const int kv = gw >> 5; cmp_bias_item(kv ? cmp_pos_v : cmp_pos_k, kv ? cmp_w1_v : cmp_w1_k, B1P + kv * 2048, (gw >> 3) & 3, gw & 7, lane); }
        conv_mat(w_in_e, D, N0, N0P, WIN0, 0, ln_mix_e, scr, gw, NGW, lane);
        conv_mat(w_out_e, D, D, D, WOUT0, 0, nullptr, scr, gw, NGW, lane);
        conv_mat(ffn_w_gate, D, FF, FF, WGU, 1, ln_ffn_e, scr, gw, NGW, lane);
        conv_mat(ffn_w_up, D, FF, FF, WGU, 2, ln_ffn_e, scr, gw, NGW, lane);
        conv_mat(ffn_w_down, FF, D, D, WDN, 0, nullptr, scr, gw, NGW, lane);
        conv_mat(w_in_o, D, N1, N1P, WIN1, 0, ln_mix_o, scr, gw, NGW, lane);
        conv_mat(w_out_o, D, D, D, WOUT1, 0, nullptr, scr, gw, NGW, lane);
        conv_mat(cmp_w1_k, 2048, 256, 256, WCMP, 0, nullptr, scr, gw, NGW, lane);
        conv_mat(cmp_w1_v, 2048, 256, 256, WCMP + 256 * 2048, 0, nullptr, scr, gw, NGW, lane);
        conv_mat(cmp_w2_k, 256, 64, 64, W2T, 0, nullptr, scr, gw, NGW, lane);
        conv_mat(cmp_w2_v, 256, 64, 64, W2T + 64 * 256, 0, nullptr, scr, gw, NGW, lane);
        rope_tables(positions, ROPE1, ROPE2, gtid, NTH);
        rms_phase(x, XN, gw, NGW, lane);
    }
    SEAM(0);
    if (IN(1)) REP(1) { REPBAR(); pg8::Gemm g{XN, WIN0, M, N0P, D, D}; pg8::StaticOrder S; S.init(M, N0P, G, bid); pg8::EpiBf16Plain E{PROJ, N0P};
        pg8::gemm_phase<pg8::EpiBf16Plain, pg8::StaticOrder, true, true>(lds, g, S, E); }
    SEAM(1);
    if (IN(2)) REP(2) { REPBAR();
        prep0_swa(PROJ, swa_q_norm, swa_k_norm, ROPE1, QS, KS, VST, lane, w, bid, G);
        chunk_phaseA<false>(lds, PROJ, N0P, C0_GQ, C0_GK, C0_GV, C0_GLOW, gla_gate_up, gla_gate_bias, nullptr, QIN, OINTRA, UT, DEC, lane, w, bid, G);
    }
    SEAM(2);
    if (IN(3)) REP(3) { REPBAR();
        if (!rep) chunk_scan(UT, DEC, gtid, NTH);
        window_attn<true, true>(QS, KS, VST, 128, swa_sinks, swa_q_norm, swa_k_norm, MIXED, nullptr, nullptr, gw, NGW, lane);
    }
    SEAM(3);
    if (IN(4)) REP(4) { REPBAR(); chunk_phaseC<false>(QIN, OINTRA, UT, PROJ, N0P, C0_GOUT, gla_out_norm, MIXED, gw, NGW, lane); }
    SEAM(4);
    if (IN(5)) REP(5) { REPBAR(); pg8::Gemm g{MIXED, WOUT0, M, D, D, D}; pg8::StaticOrder S; S.init(M, D, G, bid); pg8::EpiResF32 E{x, out, D};
        pg8::gemm_phase<pg8::EpiResF32, pg8::StaticOrder, true, true>(lds, g, S, E); }
    SEAM(5);
    if (IN(6)) REP(6) { REPBAR(); rms_phase(out, XN, gw, NGW, lane); }
    SEAM(6);
    if (IN(7)) REP(7) { REPBAR(); pg8::Gemm g{XN, WGU, M, 2 * FF, D, D}; pg8::StaticOrder S; S.init(M, 2 * FF, G, bid); pg8::EpiSwiglu E{ACT, FF};
        pg8::gemm_phase<pg8::EpiSwiglu, pg8::StaticOrder, true, true>(lds, g, S, E); }
    SEAM(7);
    if (IN(8)) REP(8) { REPBAR(); pg8::Gemm g{ACT, WDN, M, D, FF, FF}; pg8::StaticOrder S; S.init(M, D, G, bid); pg8::EpiResF32 E{out, rep ? (float*)(ws + WS_RA) : out, D};
        pg8::gemm_phase<pg8::EpiResF32, pg8::StaticOrder, true, true>(lds, g, S, E); }
    SEAM(8);
    if (IN(9)) REP(9) { REPBAR(); rms_phase(out, XN, gw, NGW, lane); }
    SEAM(9);
    if (IN(10)) REP(10) { REPBAR(); pg8::Gemm g{XN, WIN1, M, N1P, D, D}; pg8::StaticOrder S; S.init(M, N1P, G, bid); pg8::EpiBf16Plain E{PROJ, N1P};
        pg8::gemm_phase<pg8::EpiBf16Plain, pg8::StaticOrder, true, true>(lds, g, S, E); }
    SEAM(10);
    if (IN(11)) REP(11) { REPBAR();
        if (gtid < 512) { const int kv = gtid >> 8, j = gtid & 255; float bsum = (kv ? cmp_b1_v : cmp_b1_k)[j];
#pragma unroll
            for (int c = 0; c < 8; ++c) bsum += B1P[(kv * 8 + c) * 256 + j];
            B1P[4096 + gtid] = bsum; }
        prep1_nsa(PROJ, nsa_q_norm, nsa_ks_norm, nsa_kw_norm, ROPE1, QS, KS, KW, KCR, VCR, VST, VWT, lane, w, bid, G);
        chunk_phaseA<true>(lds, PROJ, N1P, C1_RQ, C1_RK, C1_RV, 0, nullptr, nullptr, ROPE2, QIN, OINTRA, UT, DEC, lane, w, bid, G);
    }
    SEAM(11);
    if (IN(12)) REP(12) { REPBAR();
        constexpr int NCW = 16;
        if (bid < NCW) { pg8::Gemm g{KCR, WCMP, 4096, 256, 2048, 1024}; pg8::CmpOrder S{NCW, bid}; pg8::EpiCmp E{CMPH, B1P + 4096};
            pg8::gemm_phase<pg8::EpiCmp, pg8::CmpOrder, true, true>(lds, g, S, E); }
        else { if (!rep) chunk_scan(UT, DEC, gtid - NCW * NWAVES * 64, NTH - NCW * NWAVES * 64);
            window_attn<false, false>(QS, KW, VWT, 512, nullptr, nsa_q_norm, nsa_kw_norm, nullptr, ONSA, PROJ, gw - NCW * NWAVES, NGW - NCW * NWAVES, lane); }
    }
    SEAM(12);
    if (IN(13)) REP(13) { REPBAR();
        cmp_layer2(CMPH, W2T, cmp_b2_k, cmp_b2_v, nsa_kc_norm, ROPE1, KCB, VCBT, gw, NGW, lane);
        chunk_phaseC<true>(QIN, OINTRA, UT, PROJ, N1P, C1_RG, ret_out_norm, MIXED, gw, NGW, lane);
    }
    SEAM(13);
    if (IN(14)) REP(14) { REPBAR(); nsa_cmp_slc(QS, KCB, VCBT, KS, VST, nsa_q_norm, nsa_kc_norm, nsa_ks_norm, PROJ, rep ? OINTRA : ONSA, rep ? (bf16*)UT : MIXED, (LAS float*)(lds + w * 16384), gw, NGW, lane); }
    SEAM(14);
    if (IN(15)) REP(15) { REPBAR(); pg8::Gemm g{MIXED, WOUT1, M, D, D, D}; pg8::StaticOrder S; S.init(M, D, G, bid); pg8::EpiResF32 E{out, rep ? (float*)(ws + WS_RA) : out, D};
        pg8::gemm_phase<pg8::EpiResF32, pg8::StaticOrder, true, true>(lds, g, S, E); }
    SEAM(15);
    if (IN(16)) REP(16) { REPBAR();
        if (!rep) moe_route(out, ln_ffn_o, router_w, router_b, XN, TOKE, TOKW, TOKR, CTL + CW_CNT, lds + 126976, tid, lane, w, bid, G);
#pragma unroll 1
        for (int e = 0; e < NEXP; ++e) {
            conv_mat(exp_w_gate + (size_t)e * D * FFE, D, FFE, FFE, MOEGU + (size_t)e * 2 * FFE * D, 1, ln_ffn_o, scr, gw, NGW, lane);
            conv_mat(exp_w_up + (size_t)e * D * FFE, D, FFE, FFE, MOEGU + (size_t)e * 2 * FFE * D, 2, ln_ffn_o, scr, gw, NGW, lane);
            conv_mat(exp_w_down + (size_t)e * FFE * D, FFE, D, D, MOED + (size_t)e * D * FFE, 0, nullptr, scr, gw, NGW, lane);
        }
    }
    SEAM(16);
    if (IN(17)) REP(17) { REPBAR(); moe_dispatch(CTL + CW_CNT, XN, TOKE, TOKR, TOKS, XS, TILEE, CTL + CW_NT, lds, tid, lane, w, bid, G); }
    SEAM(17);
#pragma unroll
    for (int hf = 0; hf < 2; ++hf) {
        if (IN(18 + 2 * hf)) REP(18) { REPBAR(); const int nt = (int)__hip_atomic_load(CTL + CW_NT, __ATOMIC_RELAXED, __HIP_MEMORY_SCOPE_AGENT);
            const int t0 = hf * HALFTILES, t1 = hf ? nt : (nt < HALFTILES ? nt : HALFTILES);
            if (t1 > t0) { pg8::Gemm g{XS, MOEGU, 0, 2 * FFE, D, D}; pg8::MoeOrder S{TILEE, t0, t1, 2 * FFE / 256, G, bid}; pg8::EpiSwiglu E{ACTH - (size_t)t0 * 256 * FFE, FFE};
                pg8::gemm_phase<pg8::EpiSwiglu, pg8::MoeOrder, true, true>(lds, g, S, E); } }
        SEAM(18 + 2 * hf);
        if (IN(19 + 2 * hf)) REP(19) { REPBAR(); const int nt = (int)__hip_atomic_load(CTL + CW_NT, __ATOMIC_RELAXED, __HIP_MEMORY_SCOPE_AGENT);
            const int t0 = hf * HALFTILES, t1 = hf ? nt : (nt < HALFTILES ? nt : HALFTILES);
            if (t1 > t0) { pg8::Gemm g{ACTH - (size_t)t0 * 256 * FFE, MOED, 0, D, FFE, FFE}; pg8::MoeOrder S{TILEE, t0, t1, D / 256, G, bid}; pg8::EpiBf16Plain E{XS, D};
                pg8::gemm_phase<pg8::EpiBf16Plain, pg8::MoeOrder, true, true>(lds, g, S, E); } }
        SEAM(19 + 2 * hf);
    }
    if (IN(22)) moe_combine(out, XS, TOKS, TOKW, gw, NGW, lane);
#undef IN
#undef SEAM
}

extern "C" void kernel_launch(void* const* d_in, const int* in_sizes, int n_in, void* d_out, int out_size, void* d_ws, size_t ws_size, hipStream_t stream) {
    static int grid = 0;
    if (grid == 0) {
        if (n_in != 39 || out_size != M * D || ws_size < WS_END) { fprintf(stderr, "kernel_launch: unexpected problem (n_in %d, out %d, ws %zu < %zu)\n", n_in, out_size, ws_size, (size_t)WS_END); grid = -1; return; }
        int dev = 0, cus = 0, per_cu = 0;
        if (hipGetDevice(&dev) != hipSuccess || hipDeviceGetAttribute(&cus, hipDeviceAttributeMultiprocessorCount, dev) != hipSuccess) { grid = -1; return; }
        if (hipFuncSetAttribute((const void*)hybrid_fwd, hipFuncAttributeMaxDynamicSharedMemorySize, LDS_BYTES) != hipSuccess) { fprintf(stderr, "kernel_launch: hipFuncSetAttribute failed\n"); grid = -1; return; }
        if (hipOccupancyMaxActiveBlocksPerMultiprocessor(&per_cu, (const void*)hybrid_fwd, NWAVES * 64, LDS_BYTES) != hipSuccess || per_cu < 1) { fprintf(stderr, "kernel_launch: occupancy query says %d\n", per_cu); }
        (void)hipGetLastError();
        grid = cus;
    }
    if (grid < 0) return;
    if (hipMemsetAsync((char*)d_ws + WS_CTL, 0, CTL_ZERO_BYTES, stream) != hipSuccess) return;
    Args a{};
    for (int i = 0; i < 39; ++i) a.in[i] = d_in[i];
    a.out = (float*)d_out; a.ws = (unsigned char*)d_ws;
#if ONE_LAUNCH
    a.ph_lo = 0; a.ph_hi = NPHASE;
    hipLaunchKernelGGL(hybrid_fwd, dim3(grid), dim3(NWAVES * 64), LDS_BYTES, stream, a);
#else
    for (int p = 0; p < NPHASE && p < STOP_PHASE; ++p) { a.ph_lo = p; a.ph_hi = p + 1; hipLaunchKernelGGL(hybrid_fwd, dim3(grid), dim3(NWAVES * 64), LDS_BYTES, stream, a); }
#endif
}
```

```cpp
#include <hip/hip_runtime.h>
#include <cstdio>
#include <cstdint>
namespace pg8 {
#define PG8_LAS __attribute__((address_space(3)))
typedef unsigned short bf16_t;
typedef short bf16x8 __attribute__((ext_vector_type(8)));
typedef float f32x4 __attribute__((ext_vector_type(4)));
typedef unsigned u32x4 __attribute__((ext_vector_type(4)));
constexpr int BM = 256, BK = 64, HALF = 128, HTB = HALF * BK * 2  , STAGE_BYTES = 8 * HTB, NXCD = 8, WGM = 8;

__host__ __device__ __forceinline__ int lds_byte(int r, int c) { const int st = (r >> 4) * 2 + (c >> 5), rr = r & 15, cc = c & 31, ob = rr * 64 + cc * 2; return st * 1024 + (ob ^ (((ob >> 9) & 1) << 5)); }
__host__ __device__ __forceinline__ void stage_rc(int b, int& R, int& C) { const int st = b / 1024, sb = b % 1024, swz = sb ^ (((sb >> 9) & 1) << 5); R = (st >> 1) * 16 + swz / 64; C = (st & 1) * 32 + (swz % 64) / 2; }
__host__ __device__ __forceinline__ int perm32(int rho) { const int n = rho >> 4, i = rho & 15; return 8 * (i >> 2) + 4 * n + (i & 3); }

struct Unit { int pm, pn, pb, ko, ks; };
struct Gemm { const bf16_t* A; const bf16_t* Bt; int M, N, K, lda, ldb; };

struct StaticOrder {
    int nM, nN, nwg, G, c;
    __host__ __device__ void init(int M, int N, int G_, int c_) { nM = M / BM; nN = N / BM; nwg = nM * nN; G = G_; c = c_; }
    __host__ __device__ bool next(int i, Unit& u) const {
        const long L = (long)i * G + c; if (L >= nwg) return false;
        int wgid = (int)L; { const int q = nwg / NXCD, r = nwg % NXCD, xcd = wgid % NXCD, off = wgid / NXCD; wgid = (xcd < r ? xcd * (q + 1) : r * (q + 1) + (xcd - r) * q) + off; }
        const int nig = WGM * nN, gid = wgid / nig, fm = gid * WGM, gsz = (nM - fm) < WGM ? (nM - fm) : WGM;
        u.pm = fm + ((wgid % nig) % gsz); u.pn = (wgid % nig) / gsz; u.pb = u.pn; u.ko = 0; u.ks = 0; return true;
    }
    __device__ __forceinline__ void a_ready(const Unit&) const {}
    __device__ __forceinline__ void done(const Unit&) const {}
};
struct MoeOrder {
    const int* tile_e; int t0, t1, nN, G, c;
    __device__ bool next(int i, Unit& u) const {
        u.ko = 0; u.ks = 0;
        if (G != 256) { const long L = (long)i * G + c; const long n = (long)(t1 - t0) * nN; if (L >= n) return false;
            u.pm = t0 + (int)(L / nN); u.pn = (int)(L % nN); u.pb = tile_e[u.pm] * nN + u.pn; return true; }
        const int ncg = nN >> 2, nsb = ((t1 - t0 + 7) >> 3) * ncg, sb = i * 8 + (c & 7), l = c >> 3;
        if (sb >= nsb) return false;
        const int rg = sb / ncg, cg = sb - rg * ncg;
        u.pm = t0 + rg * 8 + (l >> 2); if (u.pm >= t1) return false;
        u.pn = cg * 4 + (l & 3); u.pb = tile_e[u.pm] * nN + u.pn; return true;
    }
    __device__ __forceinline__ void a_ready(const Unit&) const {}
    __device__ __forceinline__ void done(const Unit&) const {}
};

__device__ __forceinline__ unsigned cvt_pk_bf16(float lo, float hi) { unsigned r; asm volatile("v_cvt_pk_bf16_f32 %0, %1, %2" : "=v"(r) : "v"(lo), "v"(hi)); return r; }

struct EpiBf16Plain {
    static constexpr bool PERM = true, AFTER_DRAIN = false;
    bf16_t* O; int ldc;
    __device__ __forceinline__ void operator()(const f32x4 (&acc)[2][2][4][2], const Unit& u, int wr, int wc, int fr, int fq) const {
        const int row0 = u.pm * BM + wr * 64 + fr, col0 = u.pn * BM + wc * 32 + 8 * fq;
#pragma unroll
        for (int ai = 0; ai < 2; ++ai)
#pragma unroll
            for (int m = 0; m < 4; ++m) { bf16_t* rowp = O + (size_t)(row0 + ai * HALF + m * 16) * ldc + col0;
#pragma unroll
                for (int bj = 0; bj < 2; ++bj) { const f32x4 v0 = acc[ai][bj][m][0], v1 = acc[ai][bj][m][1];
                    u32x4 w; w.x = cvt_pk_bf16(v0[0], v0[1]); w.y = cvt_pk_bf16(v0[2], v0[3]); w.z = cvt_pk_bf16(v1[0], v1[1]); w.w = cvt_pk_bf16(v1[2], v1[3]);
                    *(u32x4*)(rowp + bj * HALF) = w; } }
    }
};
struct MoeSplitOrder {
    const int* tile_e; int t0, t1, nN, NS, klen, G, c;
    __device__ bool next(int i, Unit& u) const {
        const long L = (long)i * G + c; const int per = nN * NS; const long n = (long)(t1 - t0) * per; if (L >= n) return false;
        const int rem = (int)(L % per); u.pm = t0 + (int)(L / per); u.pn = rem / NS; u.ks = rem % NS; u.ko = u.ks * klen * 2; u.pb = tile_e[u.pm] * nN + u.pn; return true;
    }
    __device__ __forceinline__ void a_ready(const Unit&) const {}
    __device__ __forceinline__ void done(const Unit&) const {}
};
struct EpiBf16Split {
    static constexpr bool PERM = true, AFTER_DRAIN = false;
    bf16_t* O; int ldc; size_t stride;
    __device__ __forceinline__ void operator()(const f32x4 (&acc)[2][2][4][2], const Unit& u, int wr, int wc, int fr, int fq) const {
        const int row0 = u.pm * BM + wr * 64 + fr, col0 = u.pn * BM + wc * 32 + 8 * fq; bf16_t* base = O + (size_t)u.ks * stride;
#pragma unroll
        for (int ai = 0; ai < 2; ++ai)
#pragma unroll
            for (int m = 0; m < 4; ++m) { bf16_t* rowp = base + (size_t)(row0 + ai * HALF + m * 16) * ldc + col0;
#pragma unroll
                for (int bj = 0; bj < 2; ++bj) { const f32x4 v0 = acc[ai][bj][m][0], v1 = acc[ai][bj][m][1];
                    u32x4 w; w.x = cvt_pk_bf16(v0[0], v0[1]); w.y = cvt_pk_bf16(v0[2], v0[3]); w.z = cvt_pk_bf16(v1[0], v1[1]); w.w = cvt_pk_bf16(v1[2], v1[3]);
                    *(u32x4*)(rowp + bj * HALF) = w; } }
    }
};
struct EpiResF32 {
    static constexpr bool PERM = false, AFTER_DRAIN = false;
    const float* base; float* out; int ldc;
    __device__ __forceinline__ void operator()(const f32x4 (&acc)[2][2][4][2], const Unit& u, int wr, int wc, int fr, int fq) const {
        const int row0 = u.pm * BM + wr * 64 + fr, col0 = u.pn * BM + wc * 32 + 4 * fq;
#pragma unroll
        for (int ai = 0; ai < 2; ++ai)
#pragma unroll
            for (int m = 0; m < 4; ++m) { const size_t ro = (size_t)(row0 + ai * HALF + m * 16) * ldc + col0;
#pragma unroll
                for (int bj = 0; bj < 2; ++bj)
#pragma unroll
                    for (int n = 0; n < 2; ++n) { const size_t o = ro + bj * HALF + n * 16; const f32x4 b = *(const f32x4*)(base + o); *(f32x4*)(out + o) = b + acc[ai][bj][m][n]; } }
    }
};
struct EpiSwiglu {
    static constexpr bool PERM = true, AFTER_DRAIN = false;
    bf16_t* O; int ldc;
    __device__ __forceinline__ void operator()(const f32x4 (&acc)[2][2][4][2], const Unit& u, int wr, int wc, int fr, int fq) const {
        const int row0 = u.pm * BM + wr * 64 + fr, col0 = u.pn * HALF + wc * 32 + 8 * fq;
#pragma unroll
        for (int ai = 0; ai < 2; ++ai)
#pragma unroll
            for (int m = 0; m < 4; ++m) { bf16_t* rowp = O + (size_t)(row0 + ai * HALF + m * 16) * ldc + col0;
                float r[8];
#pragma unroll
                for (int n = 0; n < 2; ++n)
#pragma unroll
                    for (int i = 0; i < 4; ++i) { const float g = acc[ai][0][m][n][i], up = acc[ai][1][m][n][i]; r[n * 4 + i] = g * __builtin_amdgcn_rcpf(1.0f + __expf(-g)) * up; }
                u32x4 w; w.x = cvt_pk_bf16(r[0], r[1]); w.y = cvt_pk_bf16(r[2], r[3]); w.z = cvt_pk_bf16(r[4], r[5]); w.w = cvt_pk_bf16(r[6], r[7]);
                *(u32x4*)rowp = w; }
    }
};

struct CmpOrder {
    int G, c;
    __device__ bool next(int i, Unit& u) const { const int L = i * G + c; if (L >= 16) return false; u.pm = L; u.pn = 0; u.pb = L >> 3; u.ko = 0; u.ks = 0; return true; }
    __device__ __forceinline__ void a_ready(const Unit&) const {}
    __device__ __forceinline__ void done(const Unit&) const {}
};
struct EpiCmp {
    static constexpr bool PERM = false, AFTER_DRAIN = false;
    float* C; const float* bias;
    __device__ __forceinline__ void operator()(const f32x4 (&acc)[2][2][4][2], const Unit& u, int wr, int wc, int fr, int fq) const {
        const int row0 = u.pm * BM + wr * 64 + fr, col0 = wc * 32 + 4 * fq; const float* bp = bias + u.pb * 256 + col0;
#pragma unroll
        for (int ai = 0; ai < 2; ++ai)
#pragma unroll
            for (int m = 0; m < 4; ++m) { float* rowp = C + (size_t)(row0 + ai * HALF + m * 16) * 256 + col0;
#pragma unroll
                for (int bj = 0; bj < 2; ++bj)
#pragma unroll
                    for (int n = 0; n < 2; ++n) *(f32x4*)(rowp + bj * HALF + n * 16) = acc[ai][bj][m][n] + *(const f32x4*)(bp + bj * HALF + n * 16); }
    }
};
template <class Epi, class Sched, bool ALIGN_EPI = false, bool SP2 = false>
__device__ __forceinline__ void gemm_phase(PG8_LAS unsigned char* lds, const Gemm g, const Sched& S, const Epi& E) {
    const int tid = threadIdx.x, wid = __builtin_amdgcn_readfirstlane(tid >> 6), lane = tid & 63, wr = wid >> 2, wc = wid & 3, fr = lane & 15, fq = lane >> 4;
    const int K = g.K, nt = K / BK;
    unsigned voffA[2], voffB[2];
#pragma unroll
    for (int i = 0; i < 2; ++i) { int R, C; stage_rc(tid * 16 + i * 8192, R, C); const int Rb = Epi::PERM ? ((R & ~31) + perm32(R & 31)) : R;
        voffA[i] = (unsigned)(R * g.lda + C) * 2u; voffB[i] = (unsigned)(Rb * g.ldb + C) * 2u; }
    const size_t kstep = (size_t)(BK * 2);
    const size_t hstep = (size_t)HALF * g.ldb * 2;
    const size_t tstep = 2 * hstep; const size_t hstepA = (size_t)HALF * g.lda * 2, tstepA = 2 * hstepA;
    const unsigned ldsw = (unsigned)wid * 1024u;
    const int aoff = lds_byte(wr * 64 + fr, fq * 8), boff = lds_byte(wc * 32 + fr, fq * 8);
#define PG8_SA(b, h) (((b) * 2 + (h)) * HTB)
#define PG8_SB(b, h) ((4 + (b) * 2 + (h)) * HTB)
#define PG8_STAGE(bufoff, gbase, voff) do { _Pragma("unroll") for (int _i = 0; _i < 2; ++_i) \
        __builtin_amdgcn_global_load_lds((const unsigned*)((const char*)(gbase) + (voff)[_i]), (PG8_LAS unsigned*)(lds + (bufoff) + ldsw + _i * 8192), 16, 0, 0); } while (0)
#define PG8_LDA(dst, b, h) do { _Pragma("unroll") for (int m = 0; m < 4; ++m) _Pragma("unroll") for (int k = 0; k < 2; ++k) dst[m][k] = *(const PG8_LAS bf16x8*)(lds + PG8_SA(b, h) + aoff + m * 2048 + k * 1024); } while (0)
#define PG8_LDB(dst, b, h) do { _Pragma("unroll") for (int n = 0; n < 2; ++n) _Pragma("unroll") for (int k = 0; k < 2; ++k) dst[n][k] = *(const PG8_LAS bf16x8*)(lds + PG8_SB(b, h) + boff + n * 2048 + k * 1024); } while (0)
#define PG8_MMA(ai, bj, At, Bt) do { __builtin_amdgcn_s_setprio(1); _Pragma("unroll") for (int m = 0; m < 4; ++m) _Pragma("unroll") for (int n = 0; n < 2; ++n) _Pragma("unroll") for (int k = 0; k < 2; ++k) \
        acc[ai][bj][m][n] = __builtin_amdgcn_mfma_f32_16x16x32_bf16(Bt[n][k], At[m][k], acc[ai][bj][m][n], 0, 0, 0); __builtin_amdgcn_s_setprio(0); } while (0)
#define PG8_WAIT_V(n) asm volatile("s_waitcnt vmcnt(" #n ")" ::: "memory")
#define PG8_WAIT_L(n) asm volatile("s_waitcnt lgkmcnt(" #n ")" ::: "memory")
#define PG8_BAR __builtin_amdgcn_s_barrier()
#define PG8_SCHED __builtin_amdgcn_sched_barrier(0)
    Unit cur, nxt; int ui = 0;
    if (!S.next(0, cur)) return;
    f32x4 acc[2][2][4][2];
#pragma unroll
    for (int a = 0; a < 2; ++a)
#pragma unroll
        for (int b = 0; b < 2; ++b)
#pragma unroll
            for (int m = 0; m < 4; ++m)
#pragma unroll
                for (int n = 0; n < 2; ++n) acc[a][b][m][n] = (f32x4){0.f, 0.f, 0.f, 0.f};
    bf16x8 At[4][2], B0[2][2], B1[2][2];
    const char* cA = (const char*)g.A + (size_t)cur.pm * tstepA + cur.ko; const char* cB = (const char*)g.Bt + (size_t)cur.pb * tstep + cur.ko;
    S.a_ready(cur);
    if constexpr (SP2) {
        PG8_STAGE(PG8_SB(0, 0), cB, voffB); PG8_STAGE(PG8_SB(0, 1), cB + hstep, voffB); PG8_STAGE(PG8_SA(0, 0), cA, voffA); PG8_STAGE(PG8_SA(0, 1), cA + hstepA, voffA);
        if (wr == 1) PG8_BAR;
        PG8_WAIT_V(2); PG8_BAR;
        PG8_STAGE(PG8_SB(1, 0), cB + kstep, voffB); PG8_STAGE(PG8_SA(1, 0), cA + kstep, voffA); PG8_STAGE(PG8_SB(1, 1), cB + hstep + kstep, voffB);
        PG8_WAIT_V(6); PG8_BAR;
    } else {
        PG8_STAGE(PG8_SB(0, 0), cB, voffB); PG8_STAGE(PG8_SA(0, 0), cA, voffA); PG8_STAGE(PG8_SB(0, 1), cB + hstep, voffB); PG8_STAGE(PG8_SA(0, 1), cA + hstepA, voffA);
        if (wr == 1) PG8_BAR;
        PG8_WAIT_V(4); PG8_BAR;
        PG8_STAGE(PG8_SB(1, 0), cB + kstep, voffB); PG8_STAGE(PG8_SA(1, 0), cA + kstep, voffA); PG8_STAGE(PG8_SB(1, 1), cB + hstep + kstep, voffB);
        PG8_WAIT_V(6); PG8_BAR;
    }
    for (;;) {
        const bool has_next = S.next(ui + 1, nxt);
        const char* nA = has_next ? (const char*)g.A + (size_t)nxt.pm * tstepA + nxt.ko : cA; const char* nB = has_next ? (const char*)g.Bt + (size_t)nxt.pb * tstep + nxt.ko : cB;
        for (int t = 0; t < nt; t += 2) {
            const bool last = (t == nt - 2);
            const char* a1 = cA + (size_t)(t + 1) * kstep;
            const char* a2 = last ? nA : cA + (size_t)(t + 2) * kstep; const char* b2 = last ? nB : cB + (size_t)(t + 2) * kstep;
            const char* a3 = a2 + kstep; const char* b3 = b2 + kstep;
            if (last && has_next) S.a_ready(nxt);
            if constexpr (SP2) {
            PG8_LDB(B0, 0, 0); PG8_LDB(B1, 0, 1); PG8_SCHED; PG8_LDA(At, 0, 0); PG8_STAGE(PG8_SA(1, 1), a1 + hstepA, voffA);
            PG8_WAIT_V(8); PG8_WAIT_L(0); PG8_BAR; PG8_MMA(0, 0, At, B0); PG8_MMA(0, 1, At, B1); PG8_BAR; PG8_SCHED;
            PG8_LDA(At, 0, 1); PG8_STAGE(PG8_SB(0, 0), b2, voffB); PG8_STAGE(PG8_SB(0, 1), b2 + hstep, voffB); PG8_STAGE(PG8_SA(0, 0), a2, voffA);
            PG8_WAIT_V(8); PG8_WAIT_L(0); PG8_BAR; PG8_MMA(1, 0, At, B0); PG8_MMA(1, 1, At, B1); PG8_BAR; PG8_SCHED;
            PG8_LDB(B0, 1, 0); PG8_LDB(B1, 1, 1); PG8_SCHED; PG8_LDA(At, 1, 0); PG8_STAGE(PG8_SA(0, 1), a2 + hstepA, voffA);
            PG8_WAIT_V(8); PG8_WAIT_L(0); PG8_BAR; PG8_MMA(0, 0, At, B0); PG8_MMA(0, 1, At, B1); PG8_BAR; PG8_SCHED;
            PG8_LDA(At, 1, 1); PG8_STAGE(PG8_SB(1, 0), b3, voffB); PG8_STAGE(PG8_SB(1, 1), b3 + hstep, voffB); PG8_STAGE(PG8_SA(1, 0), a3, voffA);
            PG8_WAIT_V(8); PG8_WAIT_L(0); PG8_BAR; PG8_MMA(1, 0, At, B0); PG8_MMA(1, 1, At, B1); PG8_BAR; PG8_SCHED;
            } else {
            PG8_LDB(B0, 0, 0); PG8_SCHED; PG8_LDA(At, 0, 0); PG8_STAGE(PG8_SA(1, 1), a1 + hstepA, voffA);
            PG8_WAIT_L(8); PG8_BAR; PG8_WAIT_L(0); PG8_MMA(0, 0, At, B0); PG8_BAR; PG8_SCHED;
            PG8_LDB(B1, 0, 1); PG8_STAGE(PG8_SB(0, 0), b2, voffB);
            PG8_BAR; PG8_WAIT_L(0); PG8_MMA(0, 1, At, B1); PG8_BAR;
            PG8_LDA(At, 0, 1); PG8_STAGE(PG8_SA(0, 0), a2, voffA);
            PG8_BAR; PG8_WAIT_L(0); PG8_MMA(1, 0, At, B0); PG8_BAR; PG8_SCHED;
            PG8_STAGE(PG8_SB(0, 1), b2 + hstep, voffB);
            PG8_WAIT_V(6); PG8_BAR; PG8_MMA(1, 1, At, B1); PG8_BAR;
            PG8_LDB(B0, 1, 0); PG8_SCHED; PG8_LDA(At, 1, 0); PG8_STAGE(PG8_SA(0, 1), a2 + hstepA, voffA);
            PG8_WAIT_L(8); PG8_BAR; PG8_WAIT_L(0); PG8_MMA(0, 0, At, B0); PG8_BAR; PG8_SCHED;
            PG8_LDB(B1, 1, 1); PG8_STAGE(PG8_SB(1, 0), b3, voffB);
            PG8_BAR; PG8_WAIT_L(0); PG8_MMA(0, 1, At, B1); PG8_BAR;
            PG8_LDA(At, 1, 1); PG8_STAGE(PG8_SA(1, 0), a3, voffA);
            PG8_BAR; PG8_WAIT_L(0); PG8_MMA(1, 0, At, B0); PG8_BAR; PG8_SCHED;
            PG8_STAGE(PG8_SB(1, 1), b3 + hstep, voffB);
            PG8_WAIT_V(6); PG8_BAR; PG8_MMA(1, 1, At, B1); PG8_BAR;
            }
        }
        if constexpr (ALIGN_EPI) { if (wr == 0) PG8_BAR; }
        if constexpr (!Epi::AFTER_DRAIN) { E(acc, cur, wr, wc, fr, fq); S.done(cur); }
        if (!has_next) break;
#pragma unroll
        for (int a = 0; a < 2; ++a)
#pragma unroll
            for (int b = 0; b < 2; ++b)
#pragma unroll
                for (int m = 0; m < 4; ++m)
#pragma unroll
                    for (int n = 0; n < 2; ++n) acc[a][b][m][n] = (f32x4){0.f, 0.f, 0.f, 0.f};
        cur = nxt; cA = nA; cB = nB; ++ui;
        if constexpr (ALIGN_EPI) { if (wr == 1) PG8_BAR; }
    }
    PG8_WAIT_V(0);
    if constexpr (!ALIGN_EPI) { if (wr == 0) PG8_BAR; }
    PG8_BAR;
    if constexpr (Epi::AFTER_DRAIN) { E.fused(acc, cur, wr, wc, fr, fq, lds, wid, lane); S.done(cur); }
#undef PG8_SA
#undef PG8_SB
#undef PG8_STAGE
#undef PG8_LDA
#undef PG8_LDB
#undef PG8_MMA
#undef PG8_WAIT_V
#undef PG8_WAIT_L
#undef PG8_BAR
#undef PG8_SCHED
}
}

constexpr int BATCH = 4, T = 4096, D = 1024, M = BATCH * T;
constexpr int N0 = 2320, N0P = 2560, N1 = 2840, N1P = 3072;
constexpr int FF = 2816, FFE = 3584, NEXP = 8;
constexpr int C0_GQ = 0, C0_GK = 256, C0_GV = 512, C0_GLOW = 1024, C0_GOUT = 1040, C0_SQ = 1552, C0_SK = 2064, C0_SV = 2192;
constexpr int C1_RQ = 0, C1_RK = 256, C1_RV = 512, C1_RG = 1024, C1_NQ = 1536, C1_KC = 2048, C1_VC = 2176, C1_KSL = 2304, C1_VSL = 2432, C1_KWN = 2560, C1_VWN = 2688, C1_NG = 2816;
constexpr float EPS = 1e-6f;
constexpr float LOG2E = 1.4426950408889634f;
constexpr int NCH = T / 64;
constexpr int NUNIT = BATCH * 4 * NCH;
constexpr int MAXTILES = 136, HALFTILES = 64, XS_ROWS = MAXTILES * 256, NSPLIT = 7;

constexpr size_t MiB = 1u << 20;
constexpr size_t WS_CTL = 0, CTL_ZERO_BYTES = 1 * MiB;
constexpr size_t WS_ROPE1 = 1 * MiB;
constexpr size_t WS_ROPE2 = 2 * MiB;
constexpr size_t WS_TAB = 6 * MiB;
constexpr size_t WS_CMPT = 7 * MiB;
constexpr size_t WS_WIN0 = 8 * MiB, WS_WOUT0 = 13 * MiB, WS_WGU = 15 * MiB, WS_WDN = 26 * MiB, WS_WIN1 = 32 * MiB, WS_WOUT1 = 38 * MiB, WS_WCMP = 40 * MiB;
constexpr size_t WS_MOEGU = 42 * MiB, WS_MOED = 154 * MiB;
constexpr size_t WS_XN = 210 * MiB;
constexpr size_t WS_PROJ = 242 * MiB;
constexpr size_t WS_RA = 338 * MiB;
constexpr size_t WS_END = 451 * MiB;
constexpr size_t WS_ONSA = 42 * MiB;
constexpr size_t WS_CMPH = 74 * MiB;
constexpr size_t WS_KCR = 80 * MiB, WS_VCR = 84 * MiB, WS_KW = 88 * MiB, WS_VWT = 92 * MiB;
constexpr size_t WS_QS = 338 * MiB;
constexpr size_t WS_KS = 354 * MiB;
constexpr size_t WS_VST = 358 * MiB;
constexpr size_t WS_QIN = 362 * MiB;
constexpr size_t WS_OINTRA = 370 * MiB;
constexpr size_t WS_UT = 402 * MiB;
constexpr size_t WS_DEC = 434 * MiB;
constexpr size_t WS_SB = 435 * MiB;
constexpr size_t WS_XS = 242 * MiB;
constexpr size_t WS_ACTH = 310 * MiB;
static_assert(WS_XS + (size_t)XS_ROWS * 1024 * 2 <= WS_ACTH && WS_ACTH + (size_t)(MAXTILES - HALFTILES) * 256 * FFE * 2 <= WS_END && (size_t)NSPLIT * 8 * 256 * 1024 * 2 <= 32 * MiB, "moe map");
static_assert(WS_DEC + (size_t)NUNIT * 64 * 4 <= WS_SB && WS_SB + (size_t)NUNIT * 8192 * 2 <= WS_END, "ws map");
constexpr size_t TB_TOKE = 0, TB_TOKW = 128 * 1024, TB_TOKR = 256 * 1024, TB_TOKS = 384 * 1024, TB_TILEE = 512 * 1024;
constexpr size_t CT_KCB = 0, CT_VCBT = 256 * 1024, CT_B1P = 512 * 1024, CT_W2T = 768 * 1024;
constexpr int CW_BAR = 4096;
constexpr int CW_CNT = 16384;
constexpr int CW_NT = 16384 + 64;

constexpr int RING_BYTES = 131072;
constexpr int LDSCTL_OFF = RING_BYTES, MISC_OFF = LDSCTL_OFF + 320;
constexpr int LDS_BYTES = 147456;
constexpr int NWAVES = 8;

#define GAS __attribute__((address_space(1)))
#define LAS __attribute__((address_space(3)))
#define DI __device__ __forceinline__
typedef unsigned short bf16;
typedef unsigned v4u __attribute__((ext_vector_type(4)));
typedef unsigned v2u __attribute__((ext_vector_type(2)));
typedef float f32x4 __attribute__((ext_vector_type(4)));
typedef short bf16x8 __attribute__((ext_vector_type(8)));
typedef float f32x2_t __attribute__((ext_vector_type(2))); typedef __bf16 bf16x2_t __attribute__((ext_vector_type(2)));
DI unsigned pk2(float lo, float hi) { f32x2_t v = {lo, hi}; bf16x2_t b = __builtin_convertvector(v, bf16x2_t); return __builtin_bit_cast(unsigned, b); }
DI unsigned f2bf(float f) { return pk2(f, 0.f) & 0xffffu; }
DI float bflo(unsigned w) { return __builtin_bit_cast(float, w << 16); }
DI float bfhi(unsigned w) { return __builtin_bit_cast(float, w & 0xffff0000u); }
DI void unpack8(const v4u v, float (&x)[8]) { x[0] = bflo(v.x); x[1] = bfhi(v.x); x[2] = bflo(v.y); x[3] = bfhi(v.y); x[4] = bflo(v.z); x[5] = bfhi(v.z); x[6] = bflo(v.w); x[7] = bfhi(v.w); }
DI v4u pack8(const float (&x)[8]) { v4u v; v.x = pk2(x[0], x[1]); v.y = pk2(x[2], x[3]); v.z = pk2(x[4], x[5]); v.w = pk2(x[6], x[7]); return v; }
DI bf16x8 ldg16(const bf16* p) { return *(const bf16x8*)p; }
DI f32x4 mfma16(bf16x8 a, bf16x8 b, f32x4 c) { return __builtin_amdgcn_mfma_f32_16x16x32_bf16(a, b, c, 0, 0, 0); }
template <int CTRL> DI float dppf(float v) { return __builtin_bit_cast(float, __builtin_amdgcn_update_dpp(0, __builtin_bit_cast(int, v), CTRL, 0xf, 0xf, true)); }
DI float rdlane(float v, int l) { return __builtin_bit_cast(float, __builtin_amdgcn_readlane(__builtin_bit_cast(int, v), l)); }
DI float sum8(float v) { v += dppf<0xB1>(v); v += dppf<0x4E>(v); v += dppf<0x141>(v); return v; }
DI float sum16(float v) { v = sum8(v); v += dppf<0x140>(v); return v; }
DI float wave_sum(float v) { v = sum16(v); return (rdlane(v, 0) + rdlane(v, 16)) + (rdlane(v, 32) + rdlane(v, 48)); }
DI float xor1(float v) { return dppf<0xB1>(v); }
DI float scan64(float v, int lane, float& total) {
    v += dppf<0x111>(v); v += dppf<0x112>(v); v += dppf<0x114>(v); v += dppf<0x118>(v);
    const float s0 = rdlane(v, 15), s1 = rdlane(v, 31), s2 = rdlane(v, 47), s3 = rdlane(v, 63); const int row = lane >> 4;
    v += (row >= 1 ? s0 : 0.f) + (row >= 2 ? s1 : 0.f) + (row >= 3 ? s2 : 0.f);
    total = (s0 + s1) + (s2 + s3); return v;
}
DI float silu_f(float g) { return g / (1.0f + __expf(-g)); }

#define XB_TMO      128
#define XB_XCNT(j)  (256  + 64 * (j))
#define XB_XSUB(j)  (1280 + 64 * (j))
#define XB_XGEN(j)  (2304 + 64 * (j))
#define XB_TOP      3328
#define XB_TOPGEN   3392
#define XCD_BAR_WORDS 3456
#define XB_SPIN_CAP (1u << 18)

__device__ __forceinline__ unsigned xb_ld(unsigned* p)              { return __hip_atomic_load(p, __ATOMIC_RELAXED, __HIP_MEMORY_SCOPE_AGENT); }
__device__ __forceinline__ unsigned xb_add(unsigned* p, unsigned v) { return __hip_atomic_fetch_add(p, v, __ATOMIC_RELAXED, __HIP_MEMORY_SCOPE_AGENT); }
__device__ __forceinline__ unsigned xb_xcc_id() { return (unsigned)__builtin_amdgcn_s_getreg((3 << 11) | 20) & 0xFu; }
#define XB_SPIN(cond, bar) do { unsigned _sp = 0; while (cond) { __builtin_amdgcn_s_sleep(1); \
    if ((++_sp & 255u) == 0u) { if (xb_ld(&(bar)[XB_TMO])) break; if (_sp > XB_SPIN_CAP) { atomicAdd(&(bar)[XB_TMO], 1u); break; } } } } while (0)

struct XcdBarrier { unsigned* bar; unsigned x; volatile LAS unsigned* st; };

__device__ __forceinline__ XcdBarrier xcd_barrier_post(unsigned* bar, volatile LAS unsigned* st) {
    XcdBarrier b; b.bar = bar; b.x = xb_xcc_id(); b.st = st;
    if (threadIdx.x == 0) (void)xb_add(&bar[XB_XCNT(b.x)], 1u);
    return b;
}
__device__ __forceinline__ void xcd_barrier_complete(unsigned* bar, unsigned x, unsigned& nloc, unsigned& nx) {
    const unsigned G = gridDim.x * gridDim.y * gridDim.z;
    unsigned sum, cnt, mine, sp = 0u;
    for (;;) {
        sum = 0u; cnt = 0u; mine = 0u;
#pragma unroll
        for (unsigned j = 0; j < 16; ++j) { const unsigned c = xb_ld(&bar[XB_XCNT(j)]); sum += c; cnt += (c > 0u) ? 1u : 0u; mine = (j == x) ? c : mine; }
        if (sum == G) break;
        __builtin_amdgcn_s_sleep(1);
        if ((++sp & 255u) == 0u) { if (xb_ld(&bar[XB_TMO])) break; if (sp > XB_SPIN_CAP) { atomicAdd(&bar[XB_TMO], 1u); break; } }
    }
    nloc = mine > 0u ? mine : 1u; nx = cnt > 0u ? cnt : 1u;
}
__device__ __forceinline__ void xcd_barrier(const XcdBarrier& b) {
    asm volatile("s_waitcnt vmcnt(0)" ::: "memory");
    __syncthreads();
    if (threadIdx.x == 0) {
        unsigned* bar = b.bar;
        __builtin_amdgcn_s_waitcnt(0);
        unsigned nloc = b.st[0], nx = b.st[1];
        if (nloc == 0u) { xcd_barrier_complete(bar, b.x, nloc, nx); b.st[0] = nloc; b.st[1] = nx; }
        const unsigned old = xb_add(&bar[XB_XSUB(b.x)], 1u);
        const unsigned gen = old / nloc;
        if (old + 1u == (gen + 1u) * nloc) {
            __builtin_amdgcn_fence(__ATOMIC_RELEASE, "agent");
            asm volatile("s_waitcnt vmcnt(0)" ::: "memory");
            const unsigned og = xb_add(&bar[XB_TOP], 1u);
            const unsigned tg = og / nx;
            if (og + 1u == (tg + 1u) * nx) xb_add(&bar[XB_TOPGEN], 1u);
            else XB_SPIN(xb_ld(&bar[XB_TOPGEN]) == tg, bar);
            __builtin_amdgcn_fence(__ATOMIC_ACQUIRE, "agent");
            xb_add(&bar[XB_XGEN(b.x)], 1u);
            asm volatile("s_waitcnt vmcnt(0)" ::: "memory");
        } else {
            XB_SPIN(xb_ld(&bar[XB_XGEN(b.x)]) == gen, bar);
            __builtin_amdgcn_fence(__ATOMIC_ACQUIRE, "agent");
            asm volatile("s_waitcnt vmcnt(0)" ::: "memory");
        }
    }
    __syncthreads();
}

#define LDS_WAIT() asm volatile("s_waitcnt lgkmcnt(0)" ::: "memory")

DI void tr_item64(const float* __restrict__ W, int N, bf16* __restrict__ WT, int kpitch, int drow0, int k0, int n0, const float* __restrict__ gain, LAS unsigned char* scr, int lane) {
    const int n4 = lane & 15, kq = lane >> 4, n = n0 + 4 * n4; const bool ok = n < N;
    f32x4 v[4][4];
#pragma unroll
    for (int g = 0; g < 4; ++g)
#pragma unroll
        for (int j = 0; j < 4; ++j) v[g][j] = ok ? __builtin_nontemporal_load((const f32x4*)(W + (size_t)(k0 + 16 * g + 4 * kq + j) * N + n)) : (f32x4){0.f, 0.f, 0.f, 0.f};
#pragma unroll
    for (int g = 0; g < 4; ++g) { float gj[4];
#pragma unroll
        for (int j = 0; j < 4; ++j) gj[j] = gain ? gain[k0 + 16 * g + 4 * kq + j] : 1.f;
        const int chunk = 2 * g + (kq >> 1), half = kq & 1;
#pragma unroll
        for (int i = 0; i < 4; ++i) { const int nn = 4 * n4 + i; v2u wv; wv.x = pk2(v[g][0][i] * gj[0], v[g][1][i] * gj[1]); wv.y = pk2(v[g][2][i] * gj[2], v[g][3][i] * gj[3]);
            *(LAS v2u*)(scr + nn * 128 + ((chunk ^ (n4 & 7)) << 4) + half * 8) = wv; } }
    LDS_WAIT(); asm volatile("" ::: "memory");
#pragma unroll
    for (int jj = 0; jj < 8; ++jj) { const int nn = (lane >> 3) + 8 * jj, c = lane & 7; const v4u o = *(const LAS v4u*)(scr + nn * 128 + ((c ^ ((nn >> 2) & 7)) << 4));
        *(v4u*)(WT + (size_t)(drow0 + nn) * kpitch + k0 + 8 * c) = o; }
    LDS_WAIT(); asm volatile("" ::: "memory");
}
DI void conv_mat(const float* W, int K, int N, int NP, bf16* WT, int mode, const float* gain, LAS unsigned char* scr, int gw, int NGW, int lane) {
    const int nblk = NP / 64, nit = nblk * (K / 64);
    for (int it = gw; it < nit; it += NGW) { const int kb = it / nblk, nb = it - kb * nblk, n0 = nb * 64;
        const int drow0 = (mode == 0) ? n0 : ((n0 >> 7) * 256 + (n0 & 127) + (mode == 2 ? 128 : 0));
        tr_item64(W, N, WT, K, drow0, kb * 64, n0, gain, scr, lane); }
}
DI void conv_tile_wg(const float* __restrict__ W, int K, int N, bf16* __restrict__ WT, int mode, const float* __restrict__ gain, LAS unsigned char* lds, int lane, int w, int k0, int n0) {
    const int col4 = lane & 31, rsub = lane >> 5;
    const int kl = 32 * w + 16 * rsub;
    const float* src = W + (size_t)(k0 + kl) * N + n0 + 4 * col4;
    f32x4 v[16];
#pragma unroll
    for (int i = 0; i < 16; ++i) v[i] = (n0 + 4 * col4 < N) ? __builtin_nontemporal_load((const f32x4*)(src + (size_t)i * N)) : (f32x4){0.f, 0.f, 0.f, 0.f};
    if (gain) {
#pragma unroll
        for (int i = 0; i < 16; ++i) v[i] = v[i] * gain[k0 + kl + i]; }
    const int c0 = 4 * w + 2 * rsub;
#pragma unroll
    for (int i = 0; i < 4; ++i) { const int nn = 4 * col4 + i;
#pragma unroll
        for (int hf = 0; hf < 2; ++hf) { v4u o; o.x = pk2(v[8 * hf + 0][i], v[8 * hf + 1][i]); o.y = pk2(v[8 * hf + 2][i], v[8 * hf + 3][i]); o.z = pk2(v[8 * hf + 4][i], v[8 * hf + 5][i]); o.w = pk2(v[8 * hf + 6][i], v[8 * hf + 7][i]);
            *(LAS v4u*)(lds + nn * 512 + (((c0 + hf) ^ (col4 & 7)) << 4)) = o; } }
    __syncthreads();
    const int drow0 = (mode == 0) ? n0 : ((n0 >> 7) * 256 + (mode == 2 ? 128 : 0));
#pragma unroll
    for (int jj = 0; jj < 8; ++jj) { const int nn = 16 * w + 2 * jj + rsub, c = lane & 31; const v4u o = *(const LAS v4u*)(lds + nn * 512 + ((c ^ ((nn >> 2) & 7)) << 4));
        *(v4u*)(WT + (size_t)(drow0 + nn) * K + k0 + 8 * c) = o; }
    __syncthreads();
}
DI void conv_mat_wg(const float* __restrict__ W, int K, int N, int NP, bf16* __restrict__ WT, int mode, const float* __restrict__ gain, LAS unsigned char* lds, int lane, int w, int bid, int G) {
    const int nsb = NP / 128, nst = nsb * (K / 256);
    __syncthreads();
    for (int st = bid; st < nst; st += G) { const int kb = st / nsb, nb = st - kb * nsb; conv_tile_wg(W, K, N, WT, mode, gain, lds, lane, w, kb * 256, nb * 128); }
}
DI void conv_moe_tiles(const float* __restrict__ wg_, const float* __restrict__ wu_, const float* __restrict__ wd_, const float* __restrict__ gain, bf16* __restrict__ MOEGU, bf16* __restrict__ MOED,
                       LAS unsigned char* lds, int lane, int w, int lo, int hi, int rank, int n) {
    __syncthreads();
    for (int t = lo + rank; t < hi; t += n) { const int mi = t / 112, st = t - mi * 112;
        if (mi < 8) { conv_tile_wg(wd_ + (size_t)mi * FFE * D, FFE, D, MOED + (size_t)mi * D * FFE, 0, nullptr, lds, lane, w, (st >> 3) * 256, (st & 7) * 128); }
        else { const int q = mi - 8, e = 7 - (q >> 1), up = q & 1; const int kb = st / 28, nb = st - kb * 28;
            conv_tile_wg((up ? wu_ : wg_) + (size_t)e * D * FFE, D, FFE, MOEGU + (size_t)e * 2 * FFE * D, up ? 2 : 1, gain, lds, lane, w, kb * 256, nb * 128); } }
}
DI void rope_tables(const int* __restrict__ pos, float* __restrict__ R1, float* __restrict__ R2, int gtid, int NT) {
    for (int idx = gtid; idx < M * 40; idx += NT) { const int m = idx / 40, i = idx - m * 40; const float p = (float)pos[m];
        float inv; if (i < 8) inv = exp2f(-(float)i * (18.931568569324174f / 8.0f)); else inv = exp2f(-(float)(i - 8) * (13.287712379549449f / 32.0f));
        double rev = (double)p * (double)inv * 0.15915494309189535; rev -= floor(rev); const float fr = (float)rev;
        const float c = __builtin_amdgcn_cosf(fr), s = __builtin_amdgcn_sinf(fr);
        if (i < 8) { R1[m * 16 + i] = c; R1[m * 16 + 8 + i] = s; } else { R2[m * 64 + (i - 8)] = c; R2[m * 64 + 32 + (i - 8)] = s; } }
}
DI void rms_row_bf16(const float* __restrict__ xrow, bf16* __restrict__ orow, int lane) {
    const f32x4* xr = (const f32x4*)xrow + lane;
    f32x4 v[4]; float s = 0.f;
#pragma unroll
    for (int j = 0; j < 4; ++j) { v[j] = xr[64 * j]; s += (v[j].x * v[j].x + v[j].y * v[j].y) + (v[j].z * v[j].z + v[j].w * v[j].w); }
    const float rstd = 1.f / sqrtf(wave_sum(s) * (1.f / D) + EPS);
    unsigned long long* o8 = (unsigned long long*)orow + lane;
#pragma unroll
    for (int j = 0; j < 4; ++j) o8[64 * j] = (unsigned long long)pk2(v[j].x * rstd, v[j].y * rstd) | ((unsigned long long)pk2(v[j].z * rstd, v[j].w * rstd) << 32);
}
DI void rms_phase(const float* src, bf16* dst, int gw, int NGW, int lane) {
    for (int m = gw; m < M; m += NGW) rms_row_bf16(src + (size_t)m * D, dst + (size_t)m * D, lane);
}
DI void cmp_bias_item(const float* __restrict__ posf, const float* __restrict__ w1, float* __restrict__ outp, int jb, int ch, int lane) {
    const int j = jb * 64 + lane; float a0 = 0.f, a1 = 0.f, a2 = 0.f, a3 = 0.f;
#pragma unroll
    for (int i = ch * 32; i < ch * 32 + 32; i += 4) {
        a0 += posf[i] * w1[(size_t)i * 256 + j]; a1 += posf[i + 1] * w1[(size_t)(i + 1) * 256 + j];
        a2 += posf[i + 2] * w1[(size_t)(i + 2) * 256 + j]; a3 += posf[i + 3] * w1[(size_t)(i + 3) * 256 + j]; }
    outp[ch * 256 + j] = (a0 + a1) + (a2 + a3);
}

DI void head_norm_rope(float (&x)[8], const float* __restrict__ gain, int sub, const float* __restrict__ cs) {
    float ss = 0.f;
#pragma unroll
    for (int i = 0; i < 8; ++i) ss += x[i] * x[i];
    ss = sum8(ss);
    const float rstd = 1.f / sqrtf(ss * (1.f / 64.f) + EPS);
#pragma unroll
    for (int i = 0; i < 8; ++i) x[i] = x[i] * rstd * gain[sub * 8 + i];
#pragma unroll
    for (int i = 0; i < 8; ++i) { const float other = xor1(x[i]); const float c = cs[i], s = cs[8 + i];
        if (sub == 0) x[i] = x[i] * c - other * s; else if (sub == 1) x[i] = x[i] * c + other * s; }
}
DI void q8_token(const bf16* __restrict__ src, const float* __restrict__ gain, const float* __restrict__ cs, bf16* __restrict__ dst, size_t hstride, int lane) {
    const int head = lane >> 3, sub = lane & 7; float x[8];
    unpack8(*(const v4u*)(src + head * 64 + sub * 8), x);
    head_norm_rope(x, gain, sub, cs);
#pragma unroll
    for (int i = 0; i < 8; ++i) x[i] *= 0.125f * LOG2E;
    *(v4u*)(dst + (size_t)head * hstride + sub * 8) = pack8(x);
}

constexpr int LP = 72;
constexpr int L_QIN = 0, L_KIN = 64 * LP * 2, L_KST = 2 * 64 * LP * 2, L_VT = 3 * 64 * LP * 2;

template <bool RET>
DI void chunk_phaseA(LAS unsigned char* lds, const bf16* __restrict__ PROJ, int ldp, int cq, int ck, int cv, int cglow,
                     const float* __restrict__ gate_up, const float* __restrict__ gate_bias, const float* __restrict__ rope2,
                     bf16* __restrict__ QIN, bf16* __restrict__ OINTRA, float* __restrict__ UT, float* __restrict__ DEC,
                     int lane, int w, int bid, int G) {
    const int r = lane & 15, quad = lane >> 4;
    for (int unit = bid; unit < NUNIT; unit += G) {
        const int b = unit >> 8, h = (unit >> 6) & 3, n = unit & 63;
        const int m = b * T + n * 64 + lane;
        const bf16* prow = PROJ + (size_t)m * ldp;
        float la[8];
        if (!RET) {
            float gl[16]; { float t8[8]; unpack8(*(const v4u*)(prow + cglow), t8);
#pragma unroll
                for (int i = 0; i < 8; ++i) gl[i] = t8[i];
                unpack8(*(const v4u*)(prow + cglow + 8), t8);
#pragma unroll
                for (int i = 0; i < 8; ++i) gl[8 + i] = t8[i]; }
#pragma unroll
            for (int cc = 0; cc < 8; ++cc) { const int c = h * 64 + 8 * w + cc; float x = gate_bias[c];
#pragma unroll
                for (int rr = 0; rr < 16; ++rr) x += gl[rr] * gate_up[rr * 256 + c];
                la[cc] = (fminf(x, 0.f) - __logf(1.f + __expf(-fabsf(x)))) * (1.f / 16.f); }
        } else {
            const float lg = logf(1.f - exp2f(-5.f - (float)h));
#pragma unroll
            for (int cc = 0; cc < 8; ++cc) la[cc] = lg;
        }
        float bl[8];
#pragma unroll
        for (int cc = 0; cc < 8; ++cc) la[cc] = scan64(la[cc], lane, bl[cc]);
        float q[8], k[8];
        if (!RET) {
            unpack8(*(const v4u*)(prow + cq + h * 64 + 8 * w), q); unpack8(*(const v4u*)(prow + ck + h * 64 + 8 * w), k);
#pragma unroll
            for (int i = 0; i < 8; ++i) q[i] *= 0.125f;
        } else {
            const int c0 = 8 * w, cp = (c0 + 32) & 63; float qp[8], kp[8];
            unpack8(*(const v4u*)(prow + cq + h * 64 + c0), q); unpack8(*(const v4u*)(prow + cq + h * 64 + cp), qp);
            unpack8(*(const v4u*)(prow + ck + h * 64 + c0), k); unpack8(*(const v4u*)(prow + ck + h * 64 + cp), kp);
            const float* cs = rope2 + (size_t)m * 64 + (c0 & 31);
#pragma unroll
            for (int i = 0; i < 8; ++i) { const float c = cs[i], s = cs[32 + i];
                if (c0 < 32) { q[i] = q[i] * c - qp[i] * s; k[i] = (k[i] * c - kp[i] * s) * 0.125f; }
                else         { q[i] = q[i] * c + qp[i] * s; k[i] = (k[i] * c + kp[i] * s) * 0.125f; } }
        }
        float qin[8], kin[8];
        LAS bf16* kst = (LAS bf16*)(lds + L_KST);
#pragma unroll
        for (int cc = 0; cc < 8; ++cc) { qin[cc] = q[cc] * __expf(la[cc]); kin[cc] = k[cc] * __expf(-la[cc]);
            kst[(8 * w + cc) * LP + lane] = (bf16)f2bf(k[cc] * __expf(bl[cc] - la[cc])); }
        const v4u qv = pack8(qin), kv = pack8(kin);
        *(LAS v4u*)(lds + L_QIN + (lane * LP + 8 * w) * 2) = qv;
        *(LAS v4u*)(lds + L_KIN + (lane * LP + 8 * w) * 2) = kv;
        *(v4u*)(QIN + (size_t)unit * 4096 + lane * 64 + 8 * w) = qv;
        if (lane == 63) {
#pragma unroll
            for (int cc = 0; cc < 8; ++cc) DEC[(size_t)unit * 64 + 8 * w + cc] = __expf(bl[cc]); }
        { float v0[8], v1[8]; unpack8(*(const v4u*)(prow + cv + h * 128 + 16 * w), v0); unpack8(*(const v4u*)(prow + cv + h * 128 + 16 * w + 8), v1);
            LAS bf16* vt = (LAS bf16*)(lds + L_VT);
#pragma unroll
            for (int i = 0; i < 8; ++i) { vt[(16 * w + i) * LP + lane] = (bf16)f2bf(v0[i]); vt[(16 * w + 8 + i) * LP + lane] = (bf16)f2bf(v1[i]); } }
        __syncthreads();
        {
            const int tt = w & 3, dh = w >> 2;
            const bf16x8 qf0 = *(const LAS bf16x8*)(lds + L_QIN + ((tt * 16 + r) * LP + quad * 8) * 2), qf1 = *(const LAS bf16x8*)(lds + L_QIN + ((tt * 16 + r) * LP + 32 + quad * 8) * 2);
            f32x4 acc[4];
#pragma unroll
            for (int d4 = 0; d4 < 4; ++d4) acc[d4] = (f32x4){0.f, 0.f, 0.f, 0.f};
            const int nks = (tt >> 1) + 1;
            for (int ks = 0; ks < nks; ++ks) { const int kb = 32 * ks, krow = kb + ((r >> 2) << 3) + (r & 3);
                const LAS unsigned char* kp = lds + L_KIN + (krow * LP + quad * 8) * 2;
                const bf16x8 k00 = *(const LAS bf16x8*)kp, k01 = *(const LAS bf16x8*)(kp + 64), k10 = *(const LAS bf16x8*)(kp + 4 * LP * 2), k11 = *(const LAS bf16x8*)(kp + 4 * LP * 2 + 64);
                f32x4 s0 = mfma16(k00, qf0, (f32x4){0.f, 0.f, 0.f, 0.f}); s0 = mfma16(k01, qf1, s0);
                f32x4 s1 = mfma16(k10, qf0, (f32x4){0.f, 0.f, 0.f, 0.f}); s1 = mfma16(k11, qf1, s1);
                const int tok = tt * 16 + r, key0 = kb + 8 * quad; float p[8];
#pragma unroll
                for (int jj = 0; jj < 4; ++jj) { p[jj] = (key0 + jj <= tok) ? s0[jj] : 0.f; p[4 + jj] = (key0 + 4 + jj <= tok) ? s1[jj] : 0.f; }
                const bf16x8 pf = __builtin_bit_cast(bf16x8, pack8(p));
#pragma unroll
                for (int d4 = 0; d4 < 4; ++d4) { const bf16x8 vf = *(const LAS bf16x8*)(lds + L_VT + ((dh * 64 + d4 * 16 + r) * LP + kb + quad * 8) * 2); acc[d4] = mfma16(vf, pf, acc[d4]); }
            }
#pragma unroll
            for (int d4 = 0; d4 < 4; ++d4) { v2u o; o.x = pk2(acc[d4][0], acc[d4][1]); o.y = pk2(acc[d4][2], acc[d4][3]); *(v2u*)(OINTRA + (size_t)unit * 8192 + (tt * 16 + r) * 128 + dh * 64 + d4 * 16 + 4 * quad) = o; }
        }
        {
#pragma unroll
            for (int dkt = 0; dkt < 4; ++dkt) { f32x4 au = (f32x4){0.f, 0.f, 0.f, 0.f};
#pragma unroll
                for (int ks = 0; ks < 2; ++ks) { const bf16x8 a = *(const LAS bf16x8*)(lds + L_VT + ((16 * w + r) * LP + 32 * ks + quad * 8) * 2);
                    const bf16x8 bq = *(const LAS bf16x8*)(lds + L_KST + ((dkt * 16 + r) * LP + 32 * ks + quad * 8) * 2); au = mfma16(a, bq, au); }
#pragma unroll
                for (int i = 0; i < 4; ++i) UT[(size_t)unit * 8192 + (16 * w + 4 * quad + i) * 64 + dkt * 16 + r] = au[i]; }
        }
        __syncthreads();
    }
}
DI void chunk_scan(const float* __restrict__ UT, const float* __restrict__ DEC, bf16* __restrict__ SB, int gtid, int NT) {
    for (int e = gtid; e < 16 * 4096; e += NT) { const int bh = e >> 12, idx2 = (e & 4095) * 2, dk = idx2 & 63; f32x2_t S = (f32x2_t){0.f, 0.f};
        const float* up = UT + (size_t)bh * 64 * 8192 + idx2; const float* dp = DEC + (size_t)bh * 64 * 64 + dk; unsigned* sp = (unsigned*)(SB + (size_t)bh * 64 * 8192 + idx2);
#pragma unroll 8
        for (int n = 0; n < 64; ++n) { const f32x2_t u = *(const f32x2_t*)(up + (size_t)n * 8192), d = *(const f32x2_t*)(dp + n * 64); sp[(size_t)n * 4096] = pk2(S.x, S.y); S = d * S + u; } }
}
template <bool RET>
DI void chunk_phaseC(const bf16* __restrict__ QIN, const bf16* __restrict__ OINTRA, const bf16* __restrict__ SB, const bf16* __restrict__ PROJ, int ldp, int cgate,
                     const float* __restrict__ gnorm, bf16* __restrict__ MIXED, int gw, int NGW, int lane) {
    const int r = lane & 15, quad = lane >> 4;
    for (int wu = gw; wu < NUNIT * 4; wu += NGW) { const int unit = wu >> 2, tt = wu & 3; const int b = unit >> 8, h = (unit >> 6) & 3, n = unit & 63;
        const bf16* qp = QIN + (size_t)unit * 4096 + (tt * 16 + r) * 64 + quad * 8; const bf16x8 qf0 = ldg16(qp), qf1 = ldg16(qp + 32);
        f32x4 acc[8];
#pragma unroll
        for (int dt = 0; dt < 8; ++dt) { const v2u oi = *(const v2u*)(OINTRA + (size_t)unit * 8192 + (tt * 16 + r) * 128 + dt * 16 + 4 * quad);
            acc[dt] = (f32x4){bflo(oi.x), bfhi(oi.x), bflo(oi.y), bfhi(oi.y)};
#pragma unroll
            for (int kk = 0; kk < 2; ++kk) acc[dt] = mfma16(ldg16(SB + (size_t)unit * 8192 + (dt * 16 + r) * 64 + kk * 32 + quad * 8), kk ? qf1 : qf0, acc[dt]); }
        const int m = b * T + n * 64 + tt * 16 + r;
        float mean = 0.f;
        if (RET) { float s = 0.f;
#pragma unroll
            for (int dt = 0; dt < 8; ++dt) s += (acc[dt][0] + acc[dt][1]) + (acc[dt][2] + acc[dt][3]);
            s += __shfl_xor(s, 16); s += __shfl_xor(s, 32); mean = s * (1.f / 128.f); }
        float ss = 0.f;
#pragma unroll
        for (int dt = 0; dt < 8; ++dt)
#pragma unroll
            for (int i = 0; i < 4; ++i) { const float d = acc[dt][i] - mean; ss += d * d; }
        ss += __shfl_xor(ss, 16); ss += __shfl_xor(ss, 32);
        const float rstd = 1.f / sqrtf(ss * (1.f / 128.f) + EPS);
#pragma unroll
        for (int dt = 0; dt < 8; ++dt) { const int dv = dt * 16 + 4 * quad;
            const v2u gv = *(const v2u*)(PROJ + (size_t)m * ldp + cgate + h * 128 + dv);
            const float g0 = bflo(gv.x), g1 = bfhi(gv.x), g2 = bflo(gv.y), g3 = bfhi(gv.y);
            const float* gn = gnorm + (RET ? h * 128 : 0) + dv;
            const float y0 = (acc[dt][0] - mean) * rstd * gn[0] * silu_f(g0), y1 = (acc[dt][1] - mean) * rstd * gn[1] * silu_f(g1);
            const float y2 = (acc[dt][2] - mean) * rstd * gn[2] * silu_f(g2), y3 = (acc[dt][3] - mean) * rstd * gn[3] * silu_f(g3);
            v2u o; o.x = pk2(y0, y1); o.y = pk2(y2, y3);
            *(v2u*)(MIXED + (size_t)m * 1024 + h * 128 + dv) = o; }
    }
}

struct KVF { bf16x8 k[4]; bf16x8 v[4]; };
DI void kv_load(KVF& f, const bf16* __restrict__ Kb, const bf16* __restrict__ VTb, int kb, int r, int quad) {
    const bf16* kp = Kb + (size_t)(kb + ((r >> 2) << 3) + (r & 3)) * 64 + quad * 8;
    f.k[0] = ldg16(kp); f.k[1] = ldg16(kp + 32); f.k[2] = ldg16(kp + 256); f.k[3] = ldg16(kp + 288);
    const bf16* vp = VTb + (size_t)(kb >> 5) * 2048 + r * 32 + quad * 8;
#pragma unroll
    for (int dt = 0; dt < 4; ++dt) f.v[dt] = ldg16(vp + dt * 512);
}
DI void k_load(KVF& f, const bf16* __restrict__ Kb, int kb, int r, int quad) {
    const bf16* kp = Kb + (size_t)(kb + ((r >> 2) << 3) + (r & 3)) * 64 + quad * 8;
    f.k[0] = ldg16(kp); f.k[1] = ldg16(kp + 32); f.k[2] = ldg16(kp + 256); f.k[3] = ldg16(kp + 288);
}
DI size_t kblk_off(int key, int d0) { const int kap = key & 31, a = kap >> 3, t = (kap >> 2) & 1, c = kap & 3, sub = d0 >> 3; return (size_t)(key >> 5) * 2048 + (t * 2 + (sub >> 2)) * 512 + ((sub & 3) * 16 + 4 * a + c) * 8; }
DI void glds16(const bf16* g, LAS unsigned char* l) { __builtin_amdgcn_global_load_lds((const unsigned*)g, (LAS unsigned*)l, 16, 0, 0); }
DI void kv_dma(LAS unsigned char* slot, const bf16* __restrict__ Kb, const bf16* __restrict__ VTb, int kb, int r, int quad) {
    const bf16* kp = Kb + (size_t)(kb >> 5) * 2048 + (quad * 16 + r) * 8;
    glds16(kp, slot); glds16(kp + 512, slot + 1024); glds16(kp + 1024, slot + 2048); glds16(kp + 1536, slot + 3072);
    const bf16* vp = VTb + (size_t)(kb >> 5) * 2048 + r * 32 + quad * 8;
#pragma unroll
    for (int dt = 0; dt < 4; ++dt) glds16(vp + dt * 512, slot + 4096 + dt * 1024);
}
DI void kv_read(KVF& f, const LAS unsigned char* slot, int lane) {
#pragma unroll
    for (int i = 0; i < 4; ++i) { f.k[i] = *(const LAS bf16x8*)(slot + i * 1024 + lane * 16); f.v[i] = *(const LAS bf16x8*)(slot + 4096 + i * 1024 + lane * 16); }
}
DI void k_dma(LAS unsigned char* slot, const bf16* __restrict__ Kb, int kb, int r, int quad) {
    const bf16* kp = Kb + (size_t)(kb >> 5) * 2048 + (quad * 16 + r) * 8;
    glds16(kp, slot); glds16(kp + 512, slot + 1024); glds16(kp + 1024, slot + 2048); glds16(kp + 1536, slot + 3072);
}
DI void k_read(KVF& f, const LAS unsigned char* slot, int lane) {
#pragma unroll
    for (int i = 0; i < 4; ++i) f.k[i] = *(const LAS bf16x8*)(slot + i * 1024 + lane * 16);
}
#define VM_WAIT(n) asm volatile("s_waitcnt vmcnt(" #n ")" ::: "memory")
DI void mask_bias(unsigned vm, float c2, f32x4& blo, f32x4& bhi) {
#pragma unroll
    for (int jj = 0; jj < 4; ++jj) { blo[jj] = ((vm >> jj) & 1u) ? -c2 : -1e30f; bhi[jj] = ((vm >> (4 + jj)) & 1u) ? -c2 : -1e30f; } }
DI void scores8(const KVF& f, const bf16x8 (&q)[2], const f32x4 blo, const f32x4 bhi, f32x4& s0, f32x4& s1) {
    s0 = mfma16(f.k[0], q[0], blo); s1 = mfma16(f.k[2], q[0], bhi); s0 = mfma16(f.k[1], q[1], s0); s1 = mfma16(f.k[3], q[1], s1); }
DI bf16x8 ones_frag() { return __builtin_bit_cast(bf16x8, (v4u){0x3f803f80u, 0x3f803f80u, 0x3f803f80u, 0x3f803f80u}); }
DI void attn_compute(const KVF& f, unsigned vm, const bf16x8 (&qf)[4][2], f32x4 (&acc)[4][4], f32x4 (&accl)[4], float c2) {
    f32x4 blo, bhi; mask_bias(vm, c2, blo, bhi);
    f32x4 s0[4], s1[4];
#pragma unroll
    for (int g = 0; g < 4; ++g) { s0[g] = mfma16(f.k[0], qf[g][0], blo); s1[g] = mfma16(f.k[2], qf[g][0], bhi); }
#pragma unroll
    for (int g = 0; g < 4; ++g) { s0[g] = mfma16(f.k[1], qf[g][1], s0[g]); s1[g] = mfma16(f.k[3], qf[g][1], s1[g]); }
    const bf16x8 ones = ones_frag();
#pragma unroll
    for (int g = 0; g < 4; ++g) { float p[8];
#pragma unroll
        for (int jj = 0; jj < 4; ++jj) { p[jj] = __builtin_amdgcn_exp2f(s0[g][jj]); p[4 + jj] = __builtin_amdgcn_exp2f(s1[g][jj]); }
        const bf16x8 pf = __builtin_bit_cast(bf16x8, pack8(p));
#pragma unroll
        for (int dt = 0; dt < 4; ++dt) acc[g][dt] = mfma16(f.v[dt], pf, acc[g][dt]);
        accl[g] = mfma16(ones, pf, accl[g]); }
}
DI unsigned win_mask(int kb, int quad, int tok, int W) { unsigned vm = 0u;
#pragma unroll
    for (int jj = 0; jj < 8; ++jj) { const int key = kb + 8 * quad + jj; if (key <= tok && key > tok - W) vm |= 1u << jj; }
    return vm; }
DI void load_q(bf16x8 (&qf)[4][2], const bf16* __restrict__ Q, int b, int hk, int t0, int r, int quad) {
#pragma unroll
    for (int g = 0; g < 4; ++g) { const bf16* qp = Q + ((size_t)(b * 8 + hk * 4 + g) * T + t0 + r) * 64 + quad * 8; qf[g][0] = ldg16(qp); qf[g][1] = ldg16(qp + 32); }
}
DI float wave_max_abs64(const float* __restrict__ g, int lane) { float v = fabsf(g[lane]);
#pragma unroll
    for (int o = 1; o < 64; o <<= 1) v = fmaxf(v, __shfl_xor(v, o));
    return v; }
DI int bal_tile(int wu) { const int u = wu & 255, w = u & 7, q = u >> 3, pair = q * 4 + (w & 3); return (w < 4) ? pair : 255 - pair; }
DI float quad_sum(float v) { v += __shfl_xor(v, 16); v += __shfl_xor(v, 32); return v; }
template <bool SINK, bool TO_MIXED>
DI void window_attn(const bf16* __restrict__ Q, const bf16* __restrict__ Kx, const bf16* __restrict__ VT, int W, const float* __restrict__ sinks, const float* __restrict__ gq, const float* __restrict__ gk,
                    bf16* __restrict__ MIXED, float* __restrict__ ONSA, const bf16* __restrict__ PROJ1, LAS unsigned char* ring, int gw, int NGW, int lane) {
    const int r = lane & 15, quad = lane >> 4; const float sc2 = 0.125f * LOG2E;
    float c2 = sc2 * 64.f * wave_max_abs64(gq, lane) * wave_max_abs64(gk, lane);
    if (SINK) { c2 = fmaxf(c2, fmaxf(fmaxf(sinks[0], sinks[1]), fmaxf(sinks[2], sinks[3])) * LOG2E); c2 = fmaxf(c2, fmaxf(fmaxf(sinks[4], sinks[5]), fmaxf(sinks[6], sinks[7])) * LOG2E); }
    for (int wu = gw; wu < BATCH * 2 * 256; wu += NGW) { const int tile = bal_tile(wu), hk = (wu >> 8) & 1, b = wu >> 9, t0 = tile * 16, tok = t0 + r;
        bf16x8 qf[4][2]; load_q(qf, Q, b, hk, t0, r, quad);
        f32x4 acc[4][4], accl[4];
#pragma unroll
        for (int g = 0; g < 4; ++g) { accl[g] = (f32x4){0.f, 0.f, 0.f, 0.f};
#pragma unroll
            for (int dt = 0; dt < 4; ++dt) acc[g][dt] = (f32x4){0.f, 0.f, 0.f, 0.f}; }
        const bf16* Kb = Kx + (size_t)(b * 2 + hk) * T * 64; const bf16* VTb = VT + (size_t)(b * 2 + hk) * 64 * T;
        int kb0 = t0 - (W - 1); kb0 = kb0 < 0 ? 0 : (kb0 & ~31);
        const int nst = ((t0 & ~31) - kb0) / 32 + 1;
        VM_WAIT(0);
        kv_dma(ring, Kb, VTb, kb0, r, quad); if (nst > 1) kv_dma(ring + 8192, Kb, VTb, kb0 + 32, r, quad);
        for (int st = 0; st < nst; ++st) { KVF cur;
            if (st + 1 < nst) VM_WAIT(8); else VM_WAIT(0);
            kv_read(cur, ring + (st & 1) * 8192, lane); LDS_WAIT();
            if (st + 2 < nst) kv_dma(ring + (st & 1) * 8192, Kb, VTb, kb0 + 32 * (st + 2), r, quad);
            attn_compute(cur, win_mask(kb0 + 32 * st, quad, tok, W), qf, acc, accl, c2); }
        const size_t m = (size_t)b * T + tok;
#pragma unroll
        for (int g = 0; g < 4; ++g) { float l = accl[g][0]; if (SINK) l += __builtin_amdgcn_exp2f(sinks[hk * 4 + g] * LOG2E - c2);
            float inv = l > 0.f ? 1.f / l : 0.f;
            if (!TO_MIXED) { const float gl = __builtin_bit_cast(float, ((unsigned)PROJ1[m * N1P + C1_NG + hk * 12 + g * 3 + 2]) << 16); inv *= 1.f / (1.f + __expf(-gl)); }
#pragma unroll
            for (int dt = 0; dt < 4; ++dt) { const f32x4 o = acc[g][dt] * inv; const int col = (hk * 4 + g) * 64 + dt * 16 + 4 * quad;
                if (TO_MIXED) { v2u w2; w2.x = pk2(o[0], o[1]); w2.y = pk2(o[2], o[3]); *(v2u*)(MIXED + m * 1024 + 512 + col) = w2; }
                else *(f32x4*)(ONSA + m * 512 + col) = o; } }
    }
}

#ifndef PROBE_A
#define PROBE_A -1
#endif
#define SUBSTAMP(k) do { if (PROBE_A >= 0 && blockIdx.x == 0 && threadIdx.x == 256) ((volatile LAS unsigned long long*)(plds - 4 * 4096 + (MISC_OFF + 128) / 4))[k] = __builtin_amdgcn_s_memrealtime(); } while (0)
DI void nsa_cmp_slc(const bf16* __restrict__ Q, const bf16* __restrict__ KCB, const bf16* __restrict__ VCBT, const bf16* __restrict__ KSL, const bf16* __restrict__ VSLT,
                    const float* __restrict__ gq, const float* __restrict__ gkc, const float* __restrict__ gks,
                    const bf16* __restrict__ PROJ1, float* __restrict__ ONSA, bf16* __restrict__ MIXED, LAS unsigned char* lds, int w, int gw, int NGW, int lane) {
    LAS float* plds = (LAS float*)(lds + w * 16384);
    const int r = lane & 15, quad = lane >> 4; const float sc2 = 0.125f * LOG2E;
    const float gqm = wave_max_abs64(gq, lane); const float c2c = sc2 * 64.f * gqm * wave_max_abs64(gkc, lane), c2s = sc2 * 64.f * gqm * wave_max_abs64(gks, lane);
    for (int wu = gw; wu < BATCH * 2 * 256; wu += NGW) { const int tile = bal_tile(wu), hk = (wu >> 8) & 1, b = wu >> 9, t0 = tile * 16, tok = t0 + r;
        bf16x8 qf[4][2]; load_q(qf, Q, b, hk, t0, r, quad);
        const size_t m = (size_t)b * T + tok;
        LAS unsigned char* ring = (LAS unsigned char*)plds; LAS float* imain = plds + 2048; LAS float* icarry = plds + 3072;
#pragma unroll
        for (int i = 0; i < 8; ++i) *(LAS f32x4*)(imain + (i * 64 + lane) * 4) = (f32x4){0.f, 0.f, 0.f, 0.f};
        const bf16* Kc = KCB + (size_t)(b * 2 + hk) * 256 * 64; const bf16* Vc = VCBT + (size_t)(b * 2 + hk) * 64 * 256;
        const int nsteps = ((t0 >> 4) + 31) >> 5;
        f32x4 accl[4];
#pragma unroll
        for (int g = 0; g < 4; ++g) accl[g] = (f32x4){0.f, 0.f, 0.f, 0.f};
        VM_WAIT(0);
        if (nsteps > 0) k_dma(ring, Kc, 0, r, quad);
        for (int st = 0; st < nsteps; ++st) { const int kb = 32 * st; KVF cur;
            VM_WAIT(0); k_read(cur, ring, lane); LDS_WAIT();
            if (st + 1 < nsteps) k_dma(ring, Kc, kb + 32, r, quad);
            unsigned vm = 0u;
#pragma unroll
            for (int jj = 0; jj < 8; ++jj) if (16 * (kb + 8 * quad + jj) + 31 <= tok) vm |= 1u << jj;
            f32x4 blo, bhi; mask_bias(vm, c2c, blo, bhi); const bf16x8 ones = ones_frag();
#pragma unroll
            for (int g = 0; g < 4; ++g) { f32x4 s0, s1; scores8(cur, qf[g], blo, bhi, s0, s1); float p[8];
#pragma unroll
                for (int jj = 0; jj < 4; ++jj) { p[jj] = __builtin_amdgcn_exp2f(s0[jj]); p[4 + jj] = __builtin_amdgcn_exp2f(s1[jj]); }
                accl[g] = mfma16(ones, __builtin_bit_cast(bf16x8, pack8(p)), accl[g]); } }
        float invl[4];
#pragma unroll
        for (int g = 0; g < 4; ++g) { const float l = accl[g][0]; invl[g] = l > 0.f ? 1.f / l : 0.f; }
        f32x4 acc[4][4];
#pragma unroll
        for (int g = 0; g < 4; ++g)
#pragma unroll
            for (int dt = 0; dt < 4; ++dt) acc[g][dt] = (f32x4){0.f, 0.f, 0.f, 0.f};
        if (nsteps > 0) kv_dma(ring, Kc, Vc, 0, r, quad);
        for (int st = 0; st < nsteps; ++st) { const int kb = 32 * st; KVF cur;
            VM_WAIT(0); kv_read(cur, ring, lane); LDS_WAIT();
            if (st + 1 < nsteps) kv_dma(ring, Kc, Vc, kb + 32, r, quad);
            unsigned vm = 0u;
#pragma unroll
            for (int jj = 0; jj < 8; ++jj) if (16 * (kb + 8 * quad + jj) + 31 <= tok) vm |= 1u << jj;
            f32x4 blo, bhi; mask_bias(vm, c2c, blo, bhi);
            float ps[8];
#pragma unroll
            for (int jj = 0; jj < 8; ++jj) ps[jj] = 0.f;
#pragma unroll
            for (int g = 0; g < 4; ++g) { f32x4 s0, s1; scores8(cur, qf[g], blo, bhi, s0, s1); float p[8];
#pragma unroll
                for (int jj = 0; jj < 4; ++jj) { p[jj] = __builtin_amdgcn_exp2f(s0[jj]) * invl[g]; p[4 + jj] = __builtin_amdgcn_exp2f(s1[jj]) * invl[g]; }
#pragma unroll
                for (int jj = 0; jj < 8; ++jj) ps[jj] += p[jj];
                const bf16x8 pf = __builtin_bit_cast(bf16x8, pack8(p));
#pragma unroll
                for (int dt = 0; dt < 4; ++dt) acc[g][dt] = mfma16(cur.v[dt], pf, acc[g][dt]); }
            const int j0 = (kb >> 2) + 2 * quad;
            f32x2_t mv; mv.x = 2.f * (ps[0] + ps[1] + ps[2]) + ps[3]; mv.y = ps[3] + 2.f * (ps[4] + ps[5] + ps[6]) + ps[7];
            *(LAS f32x2_t*)(imain + r * 64 + j0) = mv;
            if (j0 + 2 < 64) icarry[r * 64 + j0 + 2] = ps[7]; }
#pragma unroll
        for (int g = 0; g < 4; ++g) { const float gate0 = 1.f / (1.f + __expf(-__builtin_bit_cast(float, ((unsigned)PROJ1[m * N1P + C1_NG + hk * 12 + g * 3]) << 16)));
#pragma unroll
            for (int dt = 0; dt < 4; ++dt) { float* op = ONSA + m * 512 + (hk * 4 + g) * 64 + dt * 16 + 4 * quad; *(f32x4*)op = *(const f32x4*)op + acc[g][dt] * gate0; } }
        LDS_WAIT(); asm volatile("" ::: "memory"); __builtin_amdgcn_wave_barrier();
        unsigned long long mymask = 0ull, uni = 0ull;
        for (int tk = 0; tk < 16; ++tk) { const int tblk = (t0 + tk) >> 6, j = lane;
            const float imp = imain[tk * 64 + j] + icarry[tk * 64 + j];
            const bool forced = (j == 0) || (j == tblk) || (j == tblk - 1), allowed = j <= tblk;
            const float score = forced ? 1e9f : (allowed ? imp : -1e9f);
            unsigned u = __builtin_bit_cast(unsigned, score); u = (u & 0x80000000u) ? ~u : (u | 0x80000000u);
            const unsigned key = (u & ~63u) | (unsigned)(63 - j);
            unsigned prefix = 0u;
#pragma unroll
            for (int bit = 31; bit >= 0; --bit) { const unsigned cand = prefix | (1u << bit); const unsigned long long ge = __ballot(key >= cand); if (__builtin_popcountll(ge) >= 16) prefix = cand; }
            const unsigned long long mask = __ballot((key >= prefix) && allowed);
            if (r == tk) mymask = mask;
            uni |= mask; }
#pragma unroll
        for (int g = 0; g < 4; ++g) { accl[g] = (f32x4){0.f, 0.f, 0.f, 0.f};
#pragma unroll
            for (int dt = 0; dt < 4; ++dt) acc[g][dt] = (f32x4){0.f, 0.f, 0.f, 0.f}; }
        const bf16* Kb = KSL + (size_t)(b * 2 + hk) * T * 64; const bf16* VTb = VSLT + (size_t)(b * 2 + hk) * 64 * T;
        {   LAS unsigned long long* xu = (LAS unsigned long long*)(lds + LDSCTL_OFF + 2048);
            if (lane == 0) xu[w] = uni;
            VM_WAIT(0); LDS_WAIT();
            __syncthreads();
            unsigned long long wgu = 0ull;
#pragma unroll
            for (int i = 0; i < 8; ++i) wgu |= xu[i];
            constexpr int NB = 4;
            const int n = __builtin_popcountll(wgu); unsigned long long remi = wgu, remc = wgu;
            const bf16* src0 = (w < 4) ? Kb + w * 512 + lane * 8 : VTb + (w - 4) * 512 + r * 32 + quad * 8;
            auto blk_dma = [&](int bufi, int j) { LAS unsigned char* bp = lds + bufi * 16384 + w * 1024;
                glds16(src0 + (size_t)(2 * j) * 2048, bp); glds16(src0 + (size_t)(2 * j + 1) * 2048, bp + 8192); };
            for (int k = 0; k < NB - 1 && k < n; ++k) { const int j = __builtin_ctzll(remi); remi &= remi - 1ull; blk_dma(k, j); }
            for (int i = 0; i < n; ++i) { const int left = n - 1 - i;
                if (left >= 2) VM_WAIT(4); else if (left == 1) VM_WAIT(2); else VM_WAIT(0);
                __syncthreads();
                if (i + NB - 1 < n) { const int j2 = __builtin_ctzll(remi); remi &= remi - 1ull; blk_dma((i + NB - 1) % NB, j2); }
                const int j = __builtin_ctzll(remc); remc &= remc - 1ull;
                if ((uni >> j) & 1ull) { const bool sb = (mymask >> j) & 1ull; const LAS unsigned char* bp = lds + (i % NB) * 16384;
#pragma unroll
                    for (int hf = 0; hf < 2; ++hf) { KVF cur; kv_read(cur, bp + hf * 8192, lane); LDS_WAIT();
                        const int kb = 64 * j + 32 * hf; unsigned vm = 0u;
#pragma unroll
                        for (int jj = 0; jj < 8; ++jj) if (sb && (kb + 8 * quad + jj <= tok)) vm |= 1u << jj;
                        attn_compute(cur, vm, qf, acc, accl, c2s); } } }
            __syncthreads();
        }
#pragma unroll
        for (int g = 0; g < 4; ++g) { const float l = accl[g][0]; const float gate1 = 1.f / (1.f + __expf(-__builtin_bit_cast(float, ((unsigned)PROJ1[m * N1P + C1_NG + hk * 12 + g * 3 + 1]) << 16)));
            const float inv = (l > 0.f ? 1.f / l : 0.f) * gate1;
#pragma unroll
            for (int dt = 0; dt < 4; ++dt) { const int col = (hk * 4 + g) * 64 + dt * 16 + 4 * quad; const f32x4 o = *(const f32x4*)(ONSA + m * 512 + col) + acc[g][dt] * inv;
                v2u w2; w2.x = pk2(o[0], o[1]); w2.y = pk2(o[2], o[3]); *(v2u*)(MIXED + m * 1024 + 512 + col) = w2; } }
        __builtin_amdgcn_wave_barrier();
    }
}
DI float gelu_tanh(float x) { const float u = 0.7978845608028654f * (x + 0.044715f * x * x * x); const float e = __expf(2.f * u); const float th = 1.f - 2.f / (e + 1.f); return 0.5f * x * (1.f + th); }
DI void cmp_layer2(const float* __restrict__ CMPH, const bf16* __restrict__ W2T, const float* __restrict__ b2k, const float* __restrict__ b2v,
                   const float* __restrict__ kcnorm, const float* __restrict__ rope1, bf16* __restrict__ KCB, bf16* __restrict__ VCBT, int u0, int u1, int ustep, int lane) {
    const int r = lane & 15, quad = lane >> 4;
    for (int wu = u0; wu < u1; wu += ustep) { const int kv = wu >> 7, rt = wu & 127;
        const float* hp = CMPH + ((size_t)kv * 2048 + rt * 16 + r) * 256 + quad * 8; const bf16* wp = W2T + (size_t)kv * 64 * 256 + (size_t)r * 256 + quad * 8;
        f32x4 acc[4];
#pragma unroll
        for (int nt = 0; nt < 4; ++nt) acc[nt] = (f32x4){0.f, 0.f, 0.f, 0.f};
        f32x4 hv[16];
#pragma unroll
        for (int kk = 0; kk < 8; ++kk) { hv[2 * kk] = *(const f32x4*)(hp + kk * 32); hv[2 * kk + 1] = *(const f32x4*)(hp + kk * 32 + 4); }
#pragma unroll
        for (int kk = 0; kk < 8; ++kk) { bf16x8 wf[4];
#pragma unroll
            for (int nt = 0; nt < 4; ++nt) wf[nt] = ldg16(wp + (size_t)nt * 16 * 256 + kk * 32);
            float ge[8];
#pragma unroll
            for (int i = 0; i < 4; ++i) { ge[i] = gelu_tanh(hv[2 * kk][i]); ge[4 + i] = gelu_tanh(hv[2 * kk + 1][i]); }
            const bf16x8 af = __builtin_bit_cast(bf16x8, pack8(ge));
#pragma unroll
            for (int nt = 0; nt < 4; ++nt) acc[nt] = mfma16(af, wf[nt], acc[nt]); }
        const float* b2 = kv ? b2v : b2k;
#pragma unroll
        for (int nt = 0; nt < 4; ++nt) { const float bb = b2[nt * 16 + r]; acc[nt] = acc[nt] + bb; }
#pragma unroll
        for (int i = 0; i < 4; ++i) { const int row = rt * 16 + 4 * quad + i, bh = row >> 8, n = row & 255; const bool pad = (n == 255);
            if (kv == 0) { float ss = 0.f;
#pragma unroll
                for (int nt = 0; nt < 4; ++nt) ss += acc[nt][i] * acc[nt][i];
                ss = sum16(ss); const float rstd = 1.f / sqrtf(ss * (1.f / 64.f) + EPS);
                float y[4];
#pragma unroll
                for (int nt = 0; nt < 4; ++nt) y[nt] = acc[nt][i] * rstd * kcnorm[nt * 16 + r];
                const float other = dppf<0x128>(y[0]);
                const float* cs = rope1 + ((size_t)(bh >> 1) * T + (pad ? 0 : 16 * n + 31)) * 16;
                y[0] = (r < 8) ? y[0] * cs[r] - other * cs[8 + r] : y[0] * cs[r - 8] + other * cs[r];
#pragma unroll
                for (int nt = 0; nt < 4; ++nt) { const int d = nt * 16 + r; KCB[(size_t)bh * 256 * 64 + kblk_off(n, d & ~7) + (d & 7)] = pad ? (bf16)0 : (bf16)f2bf(y[nt]); }
            } else {
#pragma unroll
                for (int nt = 0; nt < 4; ++nt) VCBT[(((size_t)bh * 8 + (n >> 5)) * 64 + nt * 16 + r) * 32 + (n & 31)] = pad ? (bf16)0 : (bf16)f2bf(acc[nt][i]);
            } }
    }
}

DI void prep0_swa(const bf16* __restrict__ PROJ, const float* __restrict__ qn, const float* __restrict__ kn, const float* __restrict__ rope1,
                  bf16* __restrict__ QS, bf16* __restrict__ KS, bf16* __restrict__ VST, int lane, int w, int bid, int G) {
    for (int grp = bid; grp < M / 64; grp += G) { const int m0 = grp * 64, b = m0 / T, t0 = m0 % T;
#pragma unroll 4
        for (int i = 0; i < 8; ++i) { const int tl = 8 * w + i; const size_t m = (size_t)m0 + tl;
            q8_token(PROJ + m * N0P + C0_SQ, qn, rope1 + m * 16, QS + ((size_t)(b * 8) * T + t0 + tl) * 64, (size_t)T * 64, lane); }
        for (int p = 0; p < 2; ++p) { const int tl = 8 * w + 4 * p + (lane >> 4), head = (lane >> 3) & 1, sub = lane & 7; const size_t m = (size_t)m0 + tl; float x[8];
            unpack8(*(const v4u*)(PROJ + m * N0P + C0_SK + head * 64 + sub * 8), x); head_norm_rope(x, kn, sub, rope1 + m * 16);
            *(v4u*)(KS + (size_t)(b * 2 + head) * T * 64 + kblk_off(t0 + tl, sub * 8)) = pack8(x); }
        { const size_t m = (size_t)m0 + lane; const v4u a = *(const v4u*)(PROJ + m * N0P + C0_SV + 16 * w), c = *(const v4u*)(PROJ + m * N0P + C0_SV + 16 * w + 8);
            const unsigned wv[8] = {a.x, a.y, a.z, a.w, c.x, c.y, c.z, c.w};
#pragma unroll
            for (int i = 0; i < 16; ++i) { const int hd = 16 * w + i; VST[(((size_t)(b * 2 + (hd >> 6)) * (T / 32) + ((t0 + lane) >> 5)) * 64 + (hd & 63)) * 32 + ((t0 + lane) & 31)] = (bf16)((i & 1) ? (wv[i >> 1] >> 16) : (wv[i >> 1] & 0xffffu)); } }
    }
}
DI void prep1_nsa(const bf16* __restrict__ PROJ, const float* __restrict__ qn, const float* __restrict__ ksn, const float* __restrict__ kwn, const float* __restrict__ rope1,
                  bf16* __restrict__ QS, bf16* __restrict__ KS, bf16* __restrict__ KW, bf16* __restrict__ KCR, bf16* __restrict__ VCR, bf16* __restrict__ VST, bf16* __restrict__ VWT,
                  int lane, int w, int bid, int G) {
    for (int grp = bid; grp < M / 64; grp += G) { const int m0 = grp * 64, b = m0 / T, t0 = m0 % T;
#pragma unroll 4
        for (int i = 0; i < 8; ++i) { const int tl = 8 * w + i; const size_t m = (size_t)m0 + tl;
            q8_token(PROJ + m * N1P + C1_NQ, qn, rope1 + m * 16, QS + ((size_t)(b * 8) * T + t0 + tl) * 64, (size_t)T * 64, lane); }
        for (int p = 0; p < 2; ++p) { const int tl = 8 * w + 4 * p + (lane >> 4), head = (lane >> 3) & 1, sub = lane & 7; const size_t m = (size_t)m0 + tl; float x[8];
            const size_t dsto = ((size_t)(b * 2 + head) * T + t0 + tl) * 64 + sub * 8, dstk = (size_t)(b * 2 + head) * T * 64 + kblk_off(t0 + tl, sub * 8);
            unpack8(*(const v4u*)(PROJ + m * N1P + C1_KSL + head * 64 + sub * 8), x); head_norm_rope(x, ksn, sub, rope1 + m * 16); *(v4u*)(KS + dstk) = pack8(x);
            unpack8(*(const v4u*)(PROJ + m * N1P + C1_KWN + head * 64 + sub * 8), x); head_norm_rope(x, kwn, sub, rope1 + m * 16); *(v4u*)(KW + dstk) = pack8(x);
            *(v4u*)(KCR + dsto) = *(const v4u*)(PROJ + m * N1P + C1_KC + head * 64 + sub * 8);
            *(v4u*)(VCR + dsto) = *(const v4u*)(PROJ + m * N1P + C1_VC + head * 64 + sub * 8); }
#pragma unroll
        for (int which = 0; which < 2; ++which) { const size_t m = (size_t)m0 + lane; const int cbase = which ? C1_VWN : C1_VSL; bf16* dst = which ? VWT : VST;
            const v4u a = *(const v4u*)(PROJ + m * N1P + cbase + 16 * w), c = *(const v4u*)(PROJ + m * N1P + cbase + 16 * w + 8);
            const unsigned wv[8] = {a.x, a.y, a.z, a.w, c.x, c.y, c.z, c.w};
#pragma unroll
            for (int i = 0; i < 16; ++i) { const int hd = 16 * w + i; dst[(((size_t)(b * 2 + (hd >> 6)) * (T / 32) + ((t0 + lane) >> 5)) * 64 + (hd & 63)) * 32 + ((t0 + lane) & 31)] = (bf16)((i & 1) ? (wv[i >> 1] >> 16) : (wv[i >> 1] & 0xffffu)); } }
    }
}

DI void moe_route(const float* __restrict__ H, const float* __restrict__ gln, const float* __restrict__ rw, const float* __restrict__ rb, bf16* __restrict__ XN,
                  int* __restrict__ TOKE, float* __restrict__ TOKW, int* __restrict__ TOKR, unsigned* CNT, LAS unsigned char* lds, int tid, int lane, int w, int bid, int G) {
    LAS unsigned* lcnt = (LAS unsigned*)lds; LAS int* le = (LAS int*)(lds + 64); LAS int* lr = (LAS int*)(lds + 64 + 512);
    for (int blk = bid; blk < M / 64; blk += G) {
        if (tid < 16) lcnt[tid] = 0u;
        __syncthreads();
#pragma unroll 1
        for (int hb = 0; hb < 2; ++hb) {
        f32x4 vv[4][4];
#pragma unroll
        for (int i = 0; i < 4; ++i) { const f32x4* xr = (const f32x4*)(H + ((size_t)blk * 64 + 8 * w + 4 * hb + i) * D) + lane;
#pragma unroll
            for (int j = 0; j < 4; ++j) vv[i][j] = xr[64 * j]; }
#pragma unroll
        for (int i = 0; i < 4; ++i) { const int rl = 8 * w + 4 * hb + i; const size_t m = (size_t)blk * 64 + rl; float s = 0.f;
#pragma unroll
            for (int j = 0; j < 4; ++j) s += (vv[i][j].x * vv[i][j].x + vv[i][j].y * vv[i][j].y) + (vv[i][j].z * vv[i][j].z + vv[i][j].w * vv[i][j].w);
            const float rstd = 1.f / sqrtf(wave_sum(s) * (1.f / D) + EPS);
            unsigned long long* o8 = (unsigned long long*)(XN + m * D) + lane;
            float lg[8];
#pragma unroll
            for (int e = 0; e < 8; ++e) lg[e] = 0.f;
#pragma unroll
            for (int j = 0; j < 4; ++j) { const f32x4 v = vv[i][j]; o8[64 * j] = (unsigned long long)pk2(v.x * rstd, v.y * rstd) | ((unsigned long long)pk2(v.z * rstd, v.w * rstd) << 32);
#pragma unroll
                for (int c = 0; c < 4; ++c) { const int col = (lane + 64 * j) * 4 + c; const float x = v[c] * rstd * gln[col]; const f32x4* wr = (const f32x4*)(rw + (size_t)col * 8); const f32x4 a = wr[0], bq = wr[1];
                    lg[0] += x * a[0]; lg[1] += x * a[1]; lg[2] += x * a[2]; lg[3] += x * a[3]; lg[4] += x * bq[0]; lg[5] += x * bq[1]; lg[6] += x * bq[2]; lg[7] += x * bq[3]; } }
#pragma unroll
            for (int e = 0; e < 8; ++e) lg[e] = wave_sum(lg[e]) + rb[e];
            if (lane == 0) { float v1 = lg[0]; int e1 = 0;
#pragma unroll
                for (int e = 1; e < 8; ++e) if (lg[e] > v1) { v1 = lg[e]; e1 = e; }
                float v2 = -3.0e38f; int e2 = 0;
#pragma unroll
                for (int e = 0; e < 8; ++e) if (e != e1 && lg[e] > v2) { v2 = lg[e]; e2 = e; }
                const float w1 = 1.f / (1.f + expf(v2 - v1));
                TOKE[2 * m] = e1; TOKE[2 * m + 1] = e2; TOKW[2 * m] = w1; TOKW[2 * m + 1] = 1.f - w1;
                le[2 * rl] = e1; le[2 * rl + 1] = e2; lr[2 * rl] = (int)atomicAdd((unsigned*)&lcnt[e1], 1u); lr[2 * rl + 1] = (int)atomicAdd((unsigned*)&lcnt[e2], 1u); }
        }
        }
        __syncthreads();
        if (tid < 8) lcnt[8 + tid] = __hip_atomic_fetch_add(CNT + tid, lcnt[tid], __ATOMIC_RELAXED, __HIP_MEMORY_SCOPE_AGENT);
        __syncthreads();
        if (tid < 128) { const size_t m = (size_t)blk * 64 + (tid >> 1); TOKR[2 * m + (tid & 1)] = lr[tid] + (int)lcnt[8 + le[tid]]; }
        __syncthreads();
    }
}
DI void moe_dispatch(unsigned* CNT, const bf16* __restrict__ XN, const int* __restrict__ TOKE, const int* __restrict__ TOKR, int* __restrict__ TOKS, bf16* __restrict__ XS,
                     int* __restrict__ TILEE, unsigned* NTW, LAS unsigned char* lds, int tid, int lane, int w, int bid, int G) {
    LAS int* lbase = (LAS int*)lds;
    if (tid == 0) { int acc = 0;
        for (int e = 0; e < 8; ++e) { const int c = (int)__hip_atomic_load(CNT + e, __ATOMIC_RELAXED, __HIP_MEMORY_SCOPE_AGENT); lbase[e] = acc; lbase[16 + e] = c; acc += (c + 255) & ~255; }
        lbase[8] = acc; }
    __syncthreads();
    const int ntiles = lbase[8] >> 8;
    if (bid == 0) { for (int t = tid; t < ntiles; t += 512) { int e = 0;
#pragma unroll
            for (int k = 1; k < 8; ++k) if (t * 256 >= lbase[k]) e = k;
            TILEE[t] = e; }
        if (tid == 0) *NTW = (unsigned)ntiles; }
    const int gw = bid * NWAVES + w, NGW = G * NWAVES;
    for (int m = gw; m < M; m += NGW) {
#pragma unroll
        for (int k = 0; k < 2; ++k) { const int e = TOKE[2 * m + k], slot = lbase[e] + TOKR[2 * m + k]; if (lane == 0) TOKS[2 * m + k] = slot;
            const v4u* src = (const v4u*)(XN + (size_t)m * D) + lane; v4u* dst = (v4u*)(XS + (size_t)slot * D) + lane; dst[0] = src[0]; dst[64] = src[64]; } }
    for (int e = 0; e < 8; ++e) { const int lo = lbase[e] + lbase[16 + e], hi = lbase[e + 1];
        for (int row = lo + gw; row < hi; row += NGW) { v4u* dst = (v4u*)(XS + (size_t)row * D) + lane; dst[0] = (v4u){0u, 0u, 0u, 0u}; dst[64] = (v4u){0u, 0u, 0u, 0u}; } }
}
DI void moe_combine(float* __restrict__ OUT, const bf16* __restrict__ Y, const bf16* __restrict__ PART, const int* __restrict__ TOKS, const float* __restrict__ TOKW, int gw, int NGW, int lane) {
    constexpr int OVR = 2 * HALFTILES * 256;
    for (int m = gw; m < M; m += NGW) { const int s0 = TOKS[2 * m], s1 = TOKS[2 * m + 1]; const float w0 = TOKW[2 * m], w1 = TOKW[2 * m + 1];
#pragma unroll
        for (int j = 0; j < 4; ++j) { const int col = lane * 4 + 256 * j; f32x4* op = (f32x4*)(OUT + (size_t)m * D + col); f32x4 o = *op;
#pragma unroll
            for (int k = 0; k < 2; ++k) { const int sl = k ? s1 : s0; const float wt = k ? w1 : w0; float y0, y1, y2, y3;
                if (sl < OVR) { const v2u a = *(const v2u*)(Y + (size_t)sl * D + col); y0 = bflo(a.x); y1 = bfhi(a.x); y2 = bflo(a.y); y3 = bfhi(a.y); }
                else { y0 = y1 = y2 = y3 = 0.f;
                    for (int ks = 0; ks < NSPLIT; ++ks) { const v2u a = *(const v2u*)(PART + ((size_t)ks * 8 * 256 + (sl - OVR)) * D + col); y0 += bflo(a.x); y1 += bfhi(a.x); y2 += bflo(a.y); y3 += bfhi(a.y); } }
                o[0] += wt * y0; o[1] += wt * y1; o[2] += wt * y2; o[3] += wt * y3; }
            *op = o; } }
}

#ifndef ONE_LAUNCH
#define ONE_LAUNCH 1
#endif
#ifndef STOP_PHASE
#define STOP_PHASE 23
#endif
constexpr int NPHASE = 23;
#ifndef EARLY1
#define EARLY1 640
#endif
#ifndef EARLY2
#define EARLY2 1280
#endif
#ifndef DUP_MASK
#define DUP_MASK 0u
#endif
#define DUPN(k) (int)((DUP_MASK >> (k)) & 1u)
#define REP(k) _Pragma("unroll") for (int rep = 0; rep <= DUPN(k); ++rep)
#define REPBAR() do { if (rep) xcd_barrier(bar); } while (0)
#define REPRT(k) _Pragma("unroll 1") for (int rep = 0; rep <= DUPN(k); ++rep)
struct Args { const void* in[39]; float* out; unsigned char* ws; int ph_lo, ph_hi; };

__global__ void __launch_bounds__(NWAVES * 64, 2) hybrid_fwd(Args args) {
    extern __shared__ __attribute__((aligned(16))) unsigned char lds_raw[];
    LAS unsigned char* lds = (LAS unsigned char*)lds_raw;
    const int tid = threadIdx.x, lane = tid & 63, w = __builtin_amdgcn_readfirstlane(tid >> 6);
    const int G = gridDim.x, bid = blockIdx.x;
    const int gw = bid * NWAVES + w, NGW = G * NWAVES, gtid = bid * (NWAVES * 64) + tid, NTH = G * NWAVES * 64;
    unsigned char* ws = args.ws;
    unsigned* CTL = (unsigned*)(ws + WS_CTL);
    for (int u = tid; u < (LDS_BYTES - LDSCTL_OFF) / 4; u += NWAVES * 64) ((LAS unsigned*)(lds + LDSCTL_OFF))[u] = 0u;
    __syncthreads();
    XcdBarrier bar; bar.bar = CTL + CW_BAR; bar.x = 0; bar.st = nullptr;
    if (ONE_LAUNCH) bar = xcd_barrier_post(CTL + CW_BAR, (volatile LAS unsigned*)(lds + MISC_OFF) + 8);
    const int lo = args.ph_lo, hi = args.ph_hi < STOP_PHASE ? args.ph_hi : STOP_PHASE;
#define IN(k) (lo <= (k) && (k) < hi)
#ifndef PROBE_A
#define PROBE_A -1
#endif
#ifndef PROBE_B
#define PROBE_B -1
#endif
#ifndef PROBE_AE
#define PROBE_AE (PROBE_A + 1)
#endif
#ifndef PROBE_BE
#define PROBE_BE (PROBE_B + 1)
#endif
    volatile LAS unsigned long long* stamps = (volatile LAS unsigned long long*)(lds + MISC_OFF + 128);
#define STAMP(k) do { if (PROBE_A >= 0 && bid == 0 && tid == 0) stamps[k] = __builtin_amdgcn_s_memrealtime(); } while (0)
#define SEAM(k) do { if (ONE_LAUNCH && IN(k) && IN((k) + 1)) xcd_barrier(bar); STAMP((k) + 1); } while (0)
    STAMP(0);

    const float* x = (const float*)args.in[0]; const int* positions = (const int*)args.in[1];
    const float* ln_mix_e = (const float*)args.in[2]; const float* w_in_e = (const float*)args.in[3];
    const float* gla_gate_up = (const float*)args.in[4]; const float* gla_gate_bias = (const float*)args.in[5]; const float* gla_out_norm = (const float*)args.in[6];
    const float* swa_q_norm = (const float*)args.in[7]; const float* swa_k_norm = (const float*)args.in[8]; const float* swa_sinks = (const float*)args.in[9];
    const float* w_out_e = (const float*)args.in[10]; const float* ln_ffn_e = (const float*)args.in[11];
    const float* ffn_w_gate = (const float*)args.in[12]; const float* ffn_w_up = (const float*)args.in[13]; const float* ffn_w_down = (const float*)args.in[14];
    const float* ln_mix_o = (const float*)args.in[15]; const float* w_in_o = (const float*)args.in[16]; const float* ret_out_norm = (const float*)args.in[17];
    const float* nsa_q_norm = (const float*)args.in[18]; const float* nsa_kc_norm = (const float*)args.in[19]; const float* nsa_ks_norm = (const float*)args.in[20]; const float* nsa_kw_norm = (const float*)args.in[21];
    const float* cmp_pos_k = (const float*)args.in[22]; const float* cmp_w1_k = (const float*)args.in[23]; const float* cmp_b1_k = (const float*)args.in[24]; const float* cmp_w2_k = (const float*)args.in[25]; const float* cmp_b2_k = (const float*)args.in[26];
    const float* cmp_pos_v = (const float*)args.in[27]; const float* cmp_w1_v = (const float*)args.in[28]; const float* cmp_b1_v = (const float*)args.in[29]; const float* cmp_w2_v = (const float*)args.in[30]; const float* cmp_b2_v = (const float*)args.in[31];
    const float* w_out_o = (const float*)args.in[32]; const float* ln_ffn_o = (const float*)args.in[33]; const float* router_w = (const float*)args.in[34]; const float* router_b = (const float*)args.in[35];
    const float* exp_w_gate = (const float*)args.in[36]; const float* exp_w_up = (const float*)args.in[37]; const float* exp_w_down = (const float*)args.in[38];
    float* out = args.out;
    float* ROPE1 = (float*)(ws + WS_ROPE1); float* ROPE2 = (float*)(ws + WS_ROPE2);
    bf16* WIN0 = (bf16*)(ws + WS_WIN0); bf16* WOUT0 = (bf16*)(ws + WS_WOUT0); bf16* WGU = (bf16*)(ws + WS_WGU); bf16* WDN = (bf16*)(ws + WS_WDN);
    bf16* WIN1 = (bf16*)(ws + WS_WIN1); bf16* WOUT1 = (bf16*)(ws + WS_WOUT1); bf16* WCMP = (bf16*)(ws + WS_WCMP); bf16* MOEGU = (bf16*)(ws + WS_MOEGU); bf16* MOED = (bf16*)(ws + WS_MOED);
    bf16* XN = (bf16*)(ws + WS_XN); bf16* MIXED = XN; bf16* PROJ = (bf16*)(ws + WS_PROJ); bf16* ACT = PROJ;
    bf16* QS = (bf16*)(ws + WS_QS); bf16* KS = (bf16*)(ws + WS_KS); bf16* VST = (bf16*)(ws + WS_VST);
    bf16* QIN = (bf16*)(ws + WS_QIN); bf16* OINTRA = (bf16*)(ws + WS_OINTRA); bf16* SB = (bf16*)(ws + WS_SB); float* UT = (float*)(ws + WS_UT); float* DEC = (float*)(ws + WS_DEC);
    float* ONSA = (float*)(ws + WS_ONSA); float* CMPH = (float*)(ws + WS_CMPH);
    bf16* KCR = (bf16*)(ws + WS_KCR); bf16* VCR = (bf16*)(ws + WS_VCR); bf16* KW = (bf16*)(ws + WS_KW); bf16* VWT = (bf16*)(ws + WS_VWT);
    bf16* KCB = (bf16*)(ws + WS_CMPT + CT_KCB); bf16* VCBT = (bf16*)(ws + WS_CMPT + CT_VCBT); float* B1P = (float*)(ws + WS_CMPT + CT_B1P); bf16* W2T = (bf16*)(ws + WS_CMPT + CT_W2T);
    int* TOKE = (int*)(ws + WS_TAB + TB_TOKE); float* TOKW = (float*)(ws + WS_TAB + TB_TOKW); int* TOKR = (int*)(ws + WS_TAB + TB_TOKR); int* TOKS = (int*)(ws + WS_TAB + TB_TOKS); int* TILEE = (int*)(ws + WS_TAB + TB_TILEE);
    bf16* XS = (bf16*)(ws + WS_XS); bf16* ACTH = (bf16*)(ws + WS_ACTH); bf16* PART = (bf16*)(ws + WS_XN);
    LAS unsigned char* scr = lds + w * 16384;

    if (IN(0)) REP(0) { REPBAR();
        if (gw < 512) { const int kv = gw >> 8; cmp_bias_item(kv ? cmp_pos_v : cmp_pos_k, kv ? cmp_w1_v : cmp_w1_k, B1P + kv * 16384, (gw >> 6) & 3, gw & 63, lane); }
        conv_mat(cmp_w2_k, 256, 64, 64, W2T, 0, nullptr, scr, gw, NGW, lane);
        conv_mat(cmp_w2_v, 256, 64, 64, W2T + 64 * 256, 0, nullptr, scr, gw, NGW, lane);
        conv_mat_wg(w_in_e, D, N0, N0P, WIN0, 0, ln_mix_e, lds, lane, w, bid, G);
        conv_mat_wg(w_out_e, D, D, D, WOUT0, 0, nullptr, lds, lane, w, (bid + 80) % G, G);
        conv_mat_wg(ffn_w_gate, D, FF, FF, WGU, 1, ln_ffn_e, lds, lane, w, (bid + 112) % G, G);
        conv_mat_wg(ffn_w_up, D, FF, FF, WGU, 2, ln_ffn_e, lds, lane, w, (bid + 200) % G, G);
        conv_mat_wg(ffn_w_down, FF, D, D, WDN, 0, nullptr, lds, lane, w, (bid + 288) % G, G);
        conv_mat_wg(w_in_o, D, N1, N1P, WIN1, 0, ln_mix_o, lds, lane, w, (bid + 376) % G, G);
        conv_mat_wg(w_out_o, D, D, D, WOUT1, 0, nullptr, lds, lane, w, (bid + 472) % G, G);
        conv_mat_wg(cmp_w1_k, 2048, 256, 256, WCMP, 0, nullptr, lds, lane, w, (bid + 504) % G, G);
        conv_mat_wg(cmp_w1_v, 2048, 256, 256, WCMP + 256 * 2048, 0, nullptr, lds, lane, w, (bid + 520) % G, G);
        rope_tables(positions, ROPE1, ROPE2, gtid, NTH);
        rms_phase(x, XN, gw, NGW, lane);
    }
    SEAM(0);
    if (IN(1)) REP(1) { REPBAR(); pg8::Gemm g{XN, WIN0, M, N0P, D, D, D}; pg8::StaticOrder S; S.init(M, N0P, G, bid); pg8::EpiBf16Plain E{PROJ, N0P};
        pg8::gemm_phase<pg8::EpiBf16Plain, pg8::StaticOrder, true, true>(lds, g, S, E);
        if (!rep && G == 256 && bid >= 128) conv_moe_tiles(exp_w_gate, exp_w_up, exp_w_down, ln_ffn_o, MOEGU, MOED, lds, lane, w, 0, EARLY1, bid - 128, 128); }
    SEAM(1);
    if (IN(2)) REPRT(2) { REPBAR();
        prep0_swa(PROJ, swa_q_norm, swa_k_norm, ROPE1, QS, KS, VST, lane, w, bid, G);
        if (PROBE_A >= 0) { __syncthreads(); STAMP(29); }
        chunk_phaseA<false>(lds, PROJ, N0P, C0_GQ, C0_GK, C0_GV, C0_GLOW, gla_gate_up, gla_gate_bias, nullptr, QIN, OINTRA, UT, DEC, lane, w, bid, G);
    }
    SEAM(2);
    if (IN(3)) REPRT(3) { REPBAR();
        if (!rep) chunk_scan(UT, DEC, SB, gtid, NTH);
        window_attn<true, true>(QS, KS, VST, 128, swa_sinks, swa_q_norm, swa_k_norm, MIXED, nullptr, nullptr, lds + w * 16384, gw, NGW, lane);
    }
    SEAM(3);
    if (IN(4)) REP(4) { REPBAR(); chunk_phaseC<false>(QIN, OINTRA, SB, PROJ, N0P, C0_GOUT, gla_out_norm, MIXED, gw, NGW, lane); }
    SEAM(4);
    if (IN(5)) REP(5) { REPBAR(); pg8::Gemm g{MIXED, WOUT0, M, D, D, D, D}; pg8::StaticOrder S; S.init(M, D, G, bid); pg8::EpiResF32 E{x, out, D};
        pg8::gemm_phase<pg8::EpiResF32, pg8::StaticOrder, true, true>(lds, g, S, E); }
    SEAM(5);
    if (IN(6)) REP(6) { REPBAR(); rms_phase(out, XN, gw, NGW, lane); }
    SEAM(6);
    if (IN(7)) REP(7) { REPBAR(); pg8::Gemm g{XN, WGU, M, 2 * FF, D, D, D}; pg8::StaticOrder S; S.init(M, 2 * FF, G, bid); pg8::EpiSwiglu E{ACT, FF};
        pg8::gemm_phase<pg8::EpiSwiglu, pg8::StaticOrder, true, true>(lds, g, S, E);
        if (!rep && G == 256 && bid >= 128) conv_moe_tiles(exp_w_gate, exp_w_up, exp_w_down, ln_ffn_o, MOEGU, MOED, lds, lane, w, EARLY1, EARLY2, bid - 128, 128); }
    SEAM(7);
    if (IN(8)) REP(8) { REPBAR(); pg8::Gemm g{ACT, WDN, M, D, FF, FF, FF}; pg8::StaticOrder S; S.init(M, D, G, bid); pg8::EpiResF32 E{out, rep ? (float*)(ws + WS_RA) : out, D};
        pg8::gemm_phase<pg8::EpiResF32, pg8::StaticOrder, true, true>(lds, g, S, E); }
    SEAM(8);
    if (IN(9)) REP(9) { REPBAR(); rms_phase(out, XN, gw, NGW, lane); }
    SEAM(9);
    if (IN(10)) REP(10) { REPBAR(); pg8::Gemm g{XN, WIN1, M, N1P, D, D, D}; pg8::StaticOrder S; S.init(M, N1P, G, bid); pg8::EpiBf16Plain E{PROJ, N1P};
        pg8::gemm_phase<pg8::EpiBf16Plain, pg8::StaticOrder, true, true>(lds, g, S, E); }
    SEAM(10);
    if (IN(11)) REPRT(11) { REPBAR();
        if (gtid < 512) { const int kv = gtid >> 8, j = gtid & 255; float bsum = (kv ? cmp_b1_v : cmp_b1_k)[j];
#pragma unroll
            for (int c = 0; c < 64; ++c) bsum += B1P[(kv * 64 + c) * 256 + j];
            B1P[32768 + gtid] = bsum; }
        prep1_nsa(PROJ, nsa_q_norm, nsa_ks_norm, nsa_kw_norm, ROPE1, QS, KS, KW, KCR, VCR, VST, VWT, lane, w, bid, G);
        if (PROBE_A >= 0) { __syncthreads(); STAMP(31); }
        chunk_phaseA<true>(lds, PROJ, N1P, C1_RQ, C1_RK, C1_RV, 0, nullptr, nullptr, ROPE2, QIN, OINTRA, UT, DEC, lane, w, bid, G);
    }
    SEAM(11);
    if (IN(12)) REPRT(12) { REPBAR();
        constexpr int NCW = 16;
        if (bid < NCW) { pg8::Gemm g{KCR, WCMP, 4096, 256, 2048, 1024, 2048}; pg8::CmpOrder S{NCW, bid}; pg8::EpiCmp E{CMPH, B1P + 32768};
            pg8::gemm_phase<pg8::EpiCmp, pg8::CmpOrder, true, true>(lds, g, S, E); }
        else { if (!rep) chunk_scan(UT, DEC, SB, gtid - NCW * NWAVES * 64, NTH - NCW * NWAVES * 64);
            window_attn<false, false>(QS, KW, VWT, 512, nullptr, nsa_q_norm, nsa_kw_norm, nullptr, ONSA, PROJ, lds + w * 16384, gw - NCW * NWAVES, NGW - NCW * NWAVES, lane); }
    }
    SEAM(12);
    if (IN(13)) REP(13) { REPBAR();
        cmp_layer2(CMPH, W2T, cmp_b2_k, cmp_b2_v, nsa_kc_norm, ROPE1, KCB, VCBT, gw, 256, NGW, lane);
        chunk_phaseC<true>(QIN, OINTRA, SB, PROJ, N1P, C1_RG, ret_out_norm, MIXED, gw, NGW, lane);
    }
    SEAM(13);
    if (IN(14)) REPRT(14) { REPBAR(); nsa_cmp_slc(QS, KCB, VCBT, KS, VST, nsa_q_norm, nsa_kc_norm, nsa_ks_norm, PROJ, rep ? (float*)OINTRA : ONSA, rep ? (bf16*)UT : MIXED, lds, w, gw, NGW, lane); }
    SEAM(14);
    if (IN(15)) REP(15) { REPBAR(); pg8::Gemm g{MIXED, WOUT1, M, D, D, D, D}; pg8::StaticOrder S; S.init(M, D, G, bid); pg8::EpiResF32 E{out, rep ? (float*)(ws + WS_RA) : out, D};
        pg8::gemm_phase<pg8::EpiResF32, pg8::StaticOrder, true, true>(lds, g, S, E); }
    SEAM(15);
    if (IN(16)) REP(16) { REPBAR();
        if (!rep) moe_route(out, ln_ffn_o, router_w, router_b, XN, TOKE, TOKW, TOKR, CTL + CW_CNT, lds + 126976, tid, lane, w, bid, G);
        conv_moe_tiles(exp_w_gate, exp_w_up, exp_w_down, ln_ffn_o, MOEGU, MOED, lds, lane, w, (G == 256) ? EARLY2 : 0, 2688, bid, G);
    }
    SEAM(16);
    if (IN(17)) REP(17) { REPBAR(); moe_dispatch(CTL + CW_CNT, XN, TOKE, TOKR, TOKS, XS, TILEE, CTL + CW_NT, lds, tid, lane, w, bid, G); }
    SEAM(17);
#pragma unroll
    for (int hf = 0; hf < 2; ++hf) {
        if (IN(18 + 2 * hf)) REP(18) { REPBAR(); const int nt = (int)__hip_atomic_load(CTL + CW_NT, __ATOMIC_RELAXED, __HIP_MEMORY_SCOPE_AGENT);
            const int t0 = hf * HALFTILES, t1 = hf ? nt : (nt < HALFTILES ? nt : HALFTILES);
            if (t1 > t0) { pg8::Gemm g{XS, MOEGU, 0, 2 * FFE, D, D, D}; pg8::MoeOrder S{TILEE, t0, t1, 2 * FFE / 256, G, bid}; pg8::EpiSwiglu E{ACTH - (size_t)t0 * 256 * FFE, FFE};
                pg8::gemm_phase<pg8::EpiSwiglu, pg8::MoeOrder, true, true>(lds, g, S, E); } }
        SEAM(18 + 2 * hf);
        if (IN(19 + 2 * hf)) REP(19) { REPBAR(); const int nt = (int)__hip_atomic_load(CTL + CW_NT, __ATOMIC_RELAXED, __HIP_MEMORY_SCOPE_AGENT);
            const int t0 = hf * HALFTILES; int t1 = hf ? nt : (nt < HALFTILES ? nt : HALFTILES); if (t1 > 2 * HALFTILES) t1 = 2 * HALFTILES;
            if (t1 > t0) { pg8::Gemm g{ACTH - (size_t)t0 * 256 * FFE, MOED, 0, D, FFE, FFE, FFE}; pg8::MoeOrder S{TILEE, t0, t1, D / 256, G, bid}; pg8::EpiBf16Plain E{XS, D};
                pg8::gemm_phase<pg8::EpiBf16Plain, pg8::MoeOrder, true, true>(lds, g, S, E); }
            if (hf && nt > 2 * HALFTILES) { pg8::Gemm g{ACTH - (size_t)t0 * 256 * FFE, MOED, 0, D, FFE / NSPLIT, FFE, FFE}; pg8::MoeSplitOrder S{TILEE, 2 * HALFTILES, nt, D / 256, NSPLIT, FFE / NSPLIT, G, (bid + 128) % G};
                pg8::EpiBf16Split E{PART - (size_t)2 * HALFTILES * 256 * D, D, (size_t)8 * 256 * D};
                pg8::gemm_phase<pg8::EpiBf16Split, pg8::MoeSplitOrder, true, true>(lds, g, S, E); } }
        SEAM(19 + 2 * hf);
    }
    if (IN(22)) REPRT(22) { REPBAR(); if (!rep) moe_combine(out, XS, PART, TOKS, TOKW, gw, NGW, lane); else moe_combine((float*)(ws + WS_ACTH), XS, PART, TOKS, TOKW, gw, NGW, lane); }
    if (PROBE_A >= 0) { __syncthreads(); STAMP(23);
        if (bid == 0 && tid == 0) { const unsigned long long da = (stamps[PROBE_AE] - stamps[PROBE_A]) / 100ull, db = (PROBE_B >= 0) ? (stamps[PROBE_BE] - stamps[PROBE_B]) / 100ull : 0ull;
            const unsigned long long wait = (da + 512ull * db) * 100ull, t0 = __builtin_amdgcn_s_memrealtime();
            while (__builtin_amdgcn_s_memrealtime() - t0 < wait) __builtin_amdgcn_s_sleep(8); } }
#undef IN
#undef SEAM
}

extern "C" void kernel_launch(void* const* d_in, const int* in_sizes, int n_in, void* d_out, int out_size, void* d_ws, size_t ws_size, hipStream_t stream) {
    static int grid = 0;
    if (grid == 0) {
        if (n_in != 39 || out_size != M * D || ws_size < WS_END) { fprintf(stderr, "kernel_launch: unexpected problem (n_in %d, out %d, ws %zu < %zu)\n", n_in, out_size, ws_size, (size_t)WS_END); grid = -1; return; }
        int dev = 0, cus = 0, per_cu = 0;
        if (hipGetDevice(&dev) != hipSuccess || hipDeviceGetAttribute(&cus, hipDeviceAttributeMultiprocessorCount, dev) != hipSuccess) { grid = -1; return; }
        if (hipFuncSetAttribute((const void*)hybrid_fwd, hipFuncAttributeMaxDynamicSharedMemorySize, LDS_BYTES) != hipSuccess) { fprintf(stderr, "kernel_launch: hipFuncSetAttribute failed\n"); grid = -1; return; }
        if (hipOccupancyMaxActiveBlocksPerMultiprocessor(&per_cu, (const void*)hybrid_fwd, NWAVES * 64, LDS_BYTES) != hipSuccess || per_cu < 1) { fprintf(stderr, "kernel_launch: occupancy query says %d\n", per_cu); }
        (void)hipGetLastError();
        grid = cus;
    }
    if (grid < 0) return;
    if (hipMemsetAsync((char*)d_ws + WS_CTL, 0, CTL_ZERO_BYTES, stream) != hipSuccess) return;
    Args a{};
    for (int i = 0; i < 39; ++i) a.in[i] = d_in[i];
    a.out = (float*)d_out; a.ws = (unsigned char*)d_ws;
#if ONE_LAUNCH
    a.ph_lo = 0; a.ph_hi = NPHASE;
    hipLaunchKernelGGL(hybrid_fwd, dim3(grid), dim3(NWAVES * 64), LDS_BYTES, stream, a);
#else
    for (int p = 0; p < NPHASE && p < STOP_PHASE; ++p) { a.ph_lo = p; a.ph_hi = p + 1; hipLaunchKernelGGL(hybrid_fwd, dim3(grid), dim3(NWAVES * 64), LDS_BYTES, stream, a); }
#endif
}
```

```cpp
#include <hip/hip_runtime.h>
#include <cstdio>
#include <cstdint>
namespace pg8 {
#define PG8_LAS __attribute__((address_space(3)))
typedef unsigned short bf16_t;
typedef short bf16x8 __attribute__((ext_vector_type(8)));
typedef float f32x4 __attribute__((ext_vector_type(4)));
typedef unsigned u32x4 __attribute__((ext_vector_type(4)));
constexpr int BM = 256, BK = 64, HALF = 128, HTB = HALF * BK * 2  , STAGE_BYTES = 8 * HTB, NXCD = 8, WGM = 8;

__host__ __device__ __forceinline__ int lds_byte(int r, int c) { const int st = (r >> 4) * 2 + (c >> 5), rr = r & 15, cc = c & 31, ob = rr * 64 + cc * 2; return st * 1024 + (ob ^ (((ob >> 9) & 1) << 5)); }
__host__ __device__ __forceinline__ void stage_rc(int b, int& R, int& C) { const int st = b / 1024, sb = b % 1024, swz = sb ^ (((sb >> 9) & 1) << 5); R = (st >> 1) * 16 + swz / 64; C = (st & 1) * 32 + (swz % 64) / 2; }
__host__ __device__ __forceinline__ int perm32(int rho) { const int n = rho >> 4, i = rho & 15; return 8 * (i >> 2) + 4 * n + (i & 3); }

struct Unit { int pm, pn, pb, ko, ks; };
struct Gemm { const bf16_t* A; const bf16_t* Bt; int M, N, K, lda, ldb; };

struct StaticOrder {
    int nM, nN, nwg, G, c;
    __host__ __device__ void init(int M, int N, int G_, int c_) { nM = M / BM; nN = N / BM; nwg = nM * nN; G = G_; c = c_; }
    __host__ __device__ bool next(int i, Unit& u) const {
        const long L = (long)i * G + c; if (L >= nwg) return false;
        int wgid = (int)L; { const int q = nwg / NXCD, r = nwg % NXCD, xcd = wgid % NXCD, off = wgid / NXCD; wgid = (xcd < r ? xcd * (q + 1) : r * (q + 1) + (xcd - r) * q) + off; }
        const int nig = WGM * nN, gid = wgid / nig, fm = gid * WGM, gsz = (nM - fm) < WGM ? (nM - fm) : WGM;
        u.pm = fm + ((wgid % nig) % gsz); u.pn = (wgid % nig) / gsz; u.pb = u.pn; u.ko = 0; u.ks = 0; return true;
    }
    __device__ __forceinline__ void a_ready(const Unit&) const {}
    __device__ __forceinline__ void done(const Unit&) const {}
};
struct MoeOrder {
    const int* tile_e; int t0, t1, nN, G, c;
    __device__ bool next(int i, Unit& u) const {
        u.ko = 0; u.ks = 0;
        if (G != 256) { const long L = (long)i * G + c; const long n = (long)(t1 - t0) * nN; if (L >= n) return false;
            u.pm = t0 + (int)(L / nN); u.pn = (int)(L % nN); u.pb = tile_e[u.pm] * nN + u.pn; return true; }
        const int ncg = nN >> 2, nsb = ((t1 - t0 + 7) >> 3) * ncg, sb = i * 8 + (c & 7), l = c >> 3;
        if (sb >= nsb) return false;
        const int rg = sb / ncg, cg = sb - rg * ncg;
        u.pm = t0 + rg * 8 + (l >> 2); if (u.pm >= t1) return false;
        u.pn = cg * 4 + (l & 3); u.pb = tile_e[u.pm] * nN + u.pn; return true;
    }
    __device__ __forceinline__ void a_ready(const Unit&) const {}
    __device__ __forceinline__ void done(const Unit&) const {}
};

__device__ __forceinline__ unsigned cvt_pk_bf16(float lo, float hi) { unsigned r; asm volatile("v_cvt_pk_bf16_f32 %0, %1, %2" : "=v"(r) : "v"(lo), "v"(hi)); return r; }

struct EpiBf16Plain {
    static constexpr bool PERM = true, AFTER_DRAIN = false;
    bf16_t* O; int ldc;
    __device__ __forceinline__ void operator()(const f32x4 (&acc)[2][2][4][2], const Unit& u, int wr, int wc, int fr, int fq) const {
        const int row0 = u.pm * BM + wr * 64 + fr, col0 = u.pn * BM + wc * 32 + 8 * fq;
#pragma unroll
        for (int ai = 0; ai < 2; ++ai)
#pragma unroll
            for (int m = 0; m < 4; ++m) { bf16_t* rowp = O + (size_t)(row0 + ai * HALF + m * 16) * ldc + col0;
#pragma unroll
                for (int bj = 0; bj < 2; ++bj) { const f32x4 v0 = acc[ai][bj][m][0], v1 = acc[ai][bj][m][1];
                    u32x4 w; w.x = cvt_pk_bf16(v0[0], v0[1]); w.y = cvt_pk_bf16(v0[2], v0[3]); w.z = cvt_pk_bf16(v1[0], v1[1]); w.w = cvt_pk_bf16(v1[2], v1[3]);
                    *(u32x4*)(rowp + bj * HALF) = w; } }
    }
};
struct MoeSplitOrder {
    const int* tile_e; int t0, t1, nN, NS, klen, G, c;
    __device__ bool next(int i, Unit& u) const {
        const long L = (long)i * G + c; const int per = nN * NS; const long n = (long)(t1 - t0) * per; if (L >= n) return false;
        const int rem = (int)(L % per); u.pm = t0 + (int)(L / per); u.pn = rem / NS; u.ks = rem % NS; u.ko = u.ks * klen * 2; u.pb = tile_e[u.pm] * nN + u.pn; return true;
    }
    __device__ __forceinline__ void a_ready(const Unit&) const {}
    __device__ __forceinline__ void done(const Unit&) const {}
};
struct EpiBf16Split {
    static constexpr bool PERM = true, AFTER_DRAIN = false;
    bf16_t* O; int ldc; size_t stride;
    __device__ __forceinline__ void operator()(const f32x4 (&acc)[2][2][4][2], const Unit& u, int wr, int wc, int fr, int fq) const {
        const int row0 = u.pm * BM + wr * 64 + fr, col0 = u.pn * BM + wc * 32 + 8 * fq; bf16_t* base = O + (size_t)u.ks * stride;
#pragma unroll
        for (int ai = 0; ai < 2; ++ai)
#pragma unroll
            for (int m = 0; m < 4; ++m) { bf16_t* rowp = base + (size_t)(row0 + ai * HALF + m * 16) * ldc + col0;
#pragma unroll
                for (int bj = 0; bj < 2; ++bj) { const f32x4 v0 = acc[ai][bj][m][0], v1 = acc[ai][bj][m][1];
                    u32x4 w; w.x = cvt_pk_bf16(v0[0], v0[1]); w.y = cvt_pk_bf16(v0[2], v0[3]); w.z = cvt_pk_bf16(v1[0], v1[1]); w.w = cvt_pk_bf16(v1[2], v1[3]);
                    *(u32x4*)(rowp + bj * HALF) = w; } }
    }
};
struct EpiResF32 {
    static constexpr bool PERM = false, AFTER_DRAIN = false;
    const float* base; float* out; int ldc;
    __device__ __forceinline__ void operator()(const f32x4 (&acc)[2][2][4][2], const Unit& u, int wr, int wc, int fr, int fq) const {
        const int row0 = u.pm * BM + wr * 64 + fr, col0 = u.pn * BM + wc * 32 + 4 * fq;
#pragma unroll
        for (int ai = 0; ai < 2; ++ai)
#pragma unroll
            for (int m = 0; m < 4; ++m) { const size_t ro = (size_t)(row0 + ai * HALF + m * 16) * ldc + col0;
#pragma unroll
                for (int bj = 0; bj < 2; ++bj)
#pragma unroll
                    for (int n = 0; n < 2; ++n) { const size_t o = ro + bj * HALF + n * 16; const f32x4 b = *(const f32x4*)(base + o); *(f32x4*)(out + o) = b + acc[ai][bj][m][n]; } }
    }
};
struct EpiSwiglu {
    static constexpr bool PERM = true, AFTER_DRAIN = false;
    bf16_t* O; int ldc;
    __device__ __forceinline__ void operator()(const f32x4 (&acc)[2][2][4][2], const Unit& u, int wr, int wc, int fr, int fq) const {
        const int row0 = u.pm * BM + wr * 64 + fr, col0 = u.pn * HALF + wc * 32 + 8 * fq;
#pragma unroll
        for (int ai = 0; ai < 2; ++ai)
#pragma unroll
            for (int m = 0; m < 4; ++m) { bf16_t* rowp = O + (size_t)(row0 + ai * HALF + m * 16) * ldc + col0;
                float r[8];
#pragma unroll
                for (int n = 0; n < 2; ++n)
#pragma unroll
                    for (int i = 0; i < 4; ++i) { const float g = acc[ai][0][m][n][i], up = acc[ai][1][m][n][i]; r[n * 4 + i] = g * __builtin_amdgcn_rcpf(1.0f + __expf(-g)) * up; }
                u32x4 w; w.x = cvt_pk_bf16(r[0], r[1]); w.y = cvt_pk_bf16(r[2], r[3]); w.z = cvt_pk_bf16(r[4], r[5]); w.w = cvt_pk_bf16(r[6], r[7]);
                *(u32x4*)rowp = w; }
    }
};

struct CmpOrder {
    int G, c;
    __device__ bool next(int i, Unit& u) const { const int L = i * G + c; if (L >= 16) return false; u.pm = L; u.pn = 0; u.pb = L >> 3; u.ko = 0; u.ks = 0; return true; }
    __device__ __forceinline__ void a_ready(const Unit&) const {}
    __device__ __forceinline__ void done(const Unit&) const {}
};
struct EpiCmp {
    static constexpr bool PERM = false, AFTER_DRAIN = false;
    float* C; const float* bias;
    __device__ __forceinline__ void operator()(const f32x4 (&acc)[2][2][4][2], const Unit& u, int wr, int wc, int fr, int fq) const {
        const int row0 = u.pm * BM + wr * 64 + fr, col0 = wc * 32 + 4 * fq; const float* bp = bias + u.pb * 256 + col0;
#pragma unroll
        for (int ai = 0; ai < 2; ++ai)
#pragma unroll
            for (int m = 0; m < 4; ++m) { float* rowp = C + (size_t)(row0 + ai * HALF + m * 16) * 256 + col0;
#pragma unroll
                for (int bj = 0; bj < 2; ++bj)
#pragma unroll
                    for (int n = 0; n < 2; ++n) *(f32x4*)(rowp + bj * HALF + n * 16) = acc[ai][bj][m][n] + *(const f32x4*)(bp + bj * HALF + n * 16); }
    }
};
template <class Epi, class Sched, bool ALIGN_EPI = false, bool SP2 = false>
__device__ __forceinline__ void gemm_phase(PG8_LAS unsigned char* lds, const Gemm g, const Sched& S, const Epi& E) {
    const int tid = threadIdx.x, wid = __builtin_amdgcn_readfirstlane(tid >> 6), lane = tid & 63, wr = wid >> 2, wc = wid & 3, fr = lane & 15, fq = lane >> 4;
    const int K = g.K, nt = K / BK;
    unsigned voffA[2], voffB[2];
#pragma unroll
    for (int i = 0; i < 2; ++i) { int R, C; stage_rc(tid * 16 + i * 8192, R, C); const int Rb = Epi::PERM ? ((R & ~31) + perm32(R & 31)) : R;
        voffA[i] = (unsigned)(R * g.lda + C) * 2u; voffB[i] = (unsigned)(Rb * g.ldb + C) * 2u; }
    const size_t kstep = (size_t)(BK * 2);
    const size_t hstep = (size_t)HALF * g.ldb * 2;
    const size_t tstep = 2 * hstep; const size_t hstepA = (size_t)HALF * g.lda * 2, tstepA = 2 * hstepA;
    const unsigned ldsw = (unsigned)wid * 1024u;
    const int aoff = lds_byte(wr * 64 + fr, fq * 8), boff = lds_byte(wc * 32 + fr, fq * 8);
#define PG8_SA(b, h) (((b) * 2 + (h)) * HTB)
#define PG8_SB(b, h) ((4 + (b) * 2 + (h)) * HTB)
#define PG8_STAGE(bufoff, gbase, voff) do { _Pragma("unroll") for (int _i = 0; _i < 2; ++_i) \
        __builtin_amdgcn_global_load_lds((const unsigned*)((const char*)(gbase) + (voff)[_i]), (PG8_LAS unsigned*)(lds + (bufoff) + ldsw + _i * 8192), 16, 0, 0); } while (0)
#define PG8_LDA(dst, b, h) do { _Pragma("unroll") for (int m = 0; m < 4; ++m) _Pragma("unroll") for (int k = 0; k < 2; ++k) dst[m][k] = *(const PG8_LAS bf16x8*)(lds + PG8_SA(b, h) + aoff + m * 2048 + k * 1024); } while (0)
#define PG8_LDB(dst, b, h) do { _Pragma("unroll") for (int n = 0; n < 2; ++n) _Pragma("unroll") for (int k = 0; k < 2; ++k) dst[n][k] = *(const PG8_LAS bf16x8*)(lds + PG8_SB(b, h) + boff + n * 2048 + k * 1024); } while (0)
#define PG8_MMA(ai, bj, At, Bt) do { __builtin_amdgcn_s_setprio(1); _Pragma("unroll") for (int m = 0; m < 4; ++m) _Pragma("unroll") for (int n = 0; n < 2; ++n) _Pragma("unroll") for (int k = 0; k < 2; ++k) \
        acc[ai][bj][m][n] = __builtin_amdgcn_mfma_f32_16x16x32_bf16(Bt[n][k], At[m][k], acc[ai][bj][m][n], 0, 0, 0); __builtin_amdgcn_s_setprio(0); } while (0)
#define PG8_WAIT_V(n) asm volatile("s_waitcnt vmcnt(" #n ")" ::: "memory")
#define PG8_WAIT_L(n) asm volatile("s_waitcnt lgkmcnt(" #n ")" ::: "memory")
#define PG8_BAR __builtin_amdgcn_s_barrier()
#define PG8_SCHED __builtin_amdgcn_sched_barrier(0)
    Unit cur, nxt; int ui = 0;
    if (!S.next(0, cur)) return;
    f32x4 acc[2][2][4][2];
#pragma unroll
    for (int a = 0; a < 2; ++a)
#pragma unroll
        for (int b = 0; b < 2; ++b)
#pragma unroll
            for (int m = 0; m < 4; ++m)
#pragma unroll
                for (int n = 0; n < 2; ++n) acc[a][b][m][n] = (f32x4){0.f, 0.f, 0.f, 0.f};
    bf16x8 At[4][2], B0[2][2], B1[2][2];
    const char* cA = (const char*)g.A + (size_t)cur.pm * tstepA + cur.ko; const char* cB = (const char*)g.Bt + (size_t)cur.pb * tstep + cur.ko;
    S.a_ready(cur);
    if constexpr (SP2) {
        PG8_STAGE(PG8_SB(0, 0), cB, voffB); PG8_STAGE(PG8_SB(0, 1), cB + hstep, voffB); PG8_STAGE(PG8_SA(0, 0), cA, voffA); PG8_STAGE(PG8_SA(0, 1), cA + hstepA, voffA);
        if (wr == 1) PG8_BAR;
        PG8_WAIT_V(2); PG8_BAR;
        PG8_STAGE(PG8_SB(1, 0), cB + kstep, voffB); PG8_STAGE(PG8_SA(1, 0), cA + kstep, voffA); PG8_STAGE(PG8_SB(1, 1), cB + hstep + kstep, voffB);
        PG8_WAIT_V(6); PG8_BAR;
    } else {
        PG8_STAGE(PG8_SB(0, 0), cB, voffB); PG8_STAGE(PG8_SA(0, 0), cA, voffA); PG8_STAGE(PG8_SB(0, 1), cB + hstep, voffB); PG8_STAGE(PG8_SA(0, 1), cA + hstepA, voffA);
        if (wr == 1) PG8_BAR;
        PG8_WAIT_V(4); PG8_BAR;
        PG8_STAGE(PG8_SB(1, 0), cB + kstep, voffB); PG8_STAGE(PG8_SA(1, 0), cA + kstep, voffA); PG8_STAGE(PG8_SB(1, 1), cB + hstep + kstep, voffB);
        PG8_WAIT_V(6); PG8_BAR;
    }
    for (;;) {
        const bool has_next = S.next(ui + 1, nxt);
        const char* nA = has_next ? (const char*)g.A + (size_t)nxt.pm * tstepA + nxt.ko : cA; const char* nB = has_next ? (const char*)g.Bt + (size_t)nxt.pb * tstep + nxt.ko : cB;
        for (int t = 0; t < nt; t += 2) {
            const bool last = (t == nt - 2);
            const char* a1 = cA + (size_t)(t + 1) * kstep;
            const char* a2 = last ? nA : cA + (size_t)(t + 2) * kstep; const char* b2 = last ? nB : cB + (size_t)(t + 2) * kstep;
            const char* a3 = a2 + kstep; const char* b3 = b2 + kstep;
            if (last && has_next) S.a_ready(nxt);
            if constexpr (SP2) {
            PG8_LDB(B0, 0, 0); PG8_LDB(B1, 0, 1); PG8_SCHED; PG8_LDA(At, 0, 0); PG8_STAGE(PG8_SA(1, 1), a1 + hstepA, voffA);
            PG8_WAIT_V(8); PG8_WAIT_L(0); PG8_BAR; PG8_MMA(0, 0, At, B0); PG8_MMA(0, 1, At, B1); PG8_BAR; PG8_SCHED;
            PG8_LDA(At, 0, 1); PG8_STAGE(PG8_SB(0, 0), b2, voffB); PG8_STAGE(PG8_SB(0, 1), b2 + hstep, voffB); PG8_STAGE(PG8_SA(0, 0), a2, voffA);
            PG8_WAIT_V(8); PG8_WAIT_L(0); PG8_BAR; PG8_MMA(1, 0, At, B0); PG8_MMA(1, 1, At, B1); PG8_BAR; PG8_SCHED;
            PG8_LDB(B0, 1, 0); PG8_LDB(B1, 1, 1); PG8_SCHED; PG8_LDA(At, 1, 0); PG8_STAGE(PG8_SA(0, 1), a2 + hstepA, voffA);
            PG8_WAIT_V(8); PG8_WAIT_L(0); PG8_BAR; PG8_MMA(0, 0, At, B0); PG8_MMA(0, 1, At, B1); PG8_BAR; PG8_SCHED;
            PG8_LDA(At, 1, 1); PG8_STAGE(PG8_SB(1, 0), b3, voffB); PG8_STAGE(PG8_SB(1, 1), b3 + hstep, voffB); PG8_STAGE(PG8_SA(1, 0), a3, voffA);
            PG8_WAIT_V(8); PG8_WAIT_L(0); PG8_BAR; PG8_MMA(1, 0, At, B0); PG8_MMA(1, 1, At, B1); PG8_BAR; PG8_SCHED;
            } else {
            PG8_LDB(B0, 0, 0); PG8_SCHED; PG8_LDA(At, 0, 0); PG8_STAGE(PG8_SA(1, 1), a1 + hstepA, voffA);
            PG8_WAIT_L(8); PG8_BAR; PG8_WAIT_L(0); PG8_MMA(0, 0, At, B0); PG8_BAR; PG8_SCHED;
            PG8_LDB(B1, 0, 1); PG8_STAGE(PG8_SB(0, 0), b2, voffB);
            PG8_BAR; PG8_WAIT_L(0); PG8_MMA(0, 1, At, B1); PG8_BAR;
            PG8_LDA(At, 0, 1); PG8_STAGE(PG8_SA(0, 0), a2, voffA);
            PG8_BAR; PG8_WAIT_L(0); PG8_MMA(1, 0, At, B0); PG8_BAR; PG8_SCHED;
            PG8_STAGE(PG8_SB(0, 1), b2 + hstep, voffB);
            PG8_WAIT_V(6); PG8_BAR; PG8_MMA(1, 1, At, B1); PG8_BAR;
            PG8_LDB(B0, 1, 0); PG8_SCHED; PG8_LDA(At, 1, 0); PG8_STAGE(PG8_SA(0, 1), a2 + hstepA, voffA);
            PG8_WAIT_L(8); PG8_BAR; PG8_WAIT_L(0); PG8_MMA(0, 0, At, B0); PG8_BAR; PG8_SCHED;
            PG8_LDB(B1, 1, 1); PG8_STAGE(PG8_SB(1, 0), b3, voffB);
            PG8_BAR; PG8_WAIT_L(0); PG8_MMA(0, 1, At, B1); PG8_BAR;
            PG8_LDA(At, 1, 1); PG8_STAGE(PG8_SA(1, 0), a3, voffA);
            PG8_BAR; PG8_WAIT_L(0); PG8_MMA(1, 0, At, B0); PG8_BAR; PG8_SCHED;
            PG8_STAGE(PG8_SB(1, 1), b3 + hstep, voffB);
            PG8_WAIT_V(6); PG8_BAR; PG8_MMA(1, 1, At, B1); PG8_BAR;
            }
        }
        if constexpr (ALIGN_EPI) { if (wr == 0) PG8_BAR; }
        if constexpr (!Epi::AFTER_DRAIN) { E(acc, cur, wr, wc, fr, fq); S.done(cur); }
        if (!has_next) break;
#pragma unroll
        for (int a = 0; a < 2; ++a)
#pragma unroll
            for (int b = 0; b < 2; ++b)
#pragma unroll
                for (int m = 0; m < 4; ++m)
#pragma unroll
                    for (int n = 0; n < 2; ++n) acc[a][b][m][n] = (f32x4){0.f, 0.f, 0.f, 0.f};
        cur = nxt; cA = nA; cB = nB; ++ui;
        if constexpr (ALIGN_EPI) { if (wr == 1) PG8_BAR; }
    }
    PG8_WAIT_V(0);
    if constexpr (!ALIGN_EPI) { if (wr == 0) PG8_BAR; }
    PG8_BAR;
    if constexpr (Epi::AFTER_DRAIN) { E.fused(acc, cur, wr, wc, fr, fq, lds, wid, lane); S.done(cur); }
#undef PG8_SA
#undef PG8_SB
#undef PG8_STAGE
#undef PG8_LDA
#undef PG8_LDB
#undef PG8_MMA
#undef PG8_WAIT_V
#undef PG8_WAIT_L
#undef PG8_BAR
#undef PG8_SCHED
}
}

constexpr int BATCH = 4, T = 4096, D = 1024, M = BATCH * T;
constexpr int N0 = 2320, N0P = 2560, N1 = 2840, N1P = 3072;
constexpr int FF = 2816, FFE = 3584, NEXP = 8;
constexpr int C0_GQ = 0, C0_GK = 256, C0_GV = 512, C0_GLOW = 1024, C0_GOUT = 1040, C0_SQ = 1552, C0_SK = 2064, C0_SV = 2192;
constexpr int C1_RQ = 0, C1_RK = 256, C1_RV = 512, C1_RG = 1024, C1_NQ = 1536, C1_KC = 2048, C1_VC = 2176, C1_KSL = 2304, C1_VSL = 2432, C1_KWN = 2560, C1_VWN = 2688, C1_NG = 2816;
constexpr float EPS = 1e-6f;
constexpr float LOG2E = 1.4426950408889634f;
constexpr int NCH = T / 64;
constexpr int NUNIT = BATCH * 4 * NCH;
constexpr int MAXTILES = 136, HALFTILES = 64, XS_ROWS = MAXTILES * 256, NSPLIT = 7;

constexpr size_t MiB = 1u << 20;
constexpr size_t WS_CTL = 0, CTL_ZERO_BYTES = 1 * MiB;
constexpr size_t WS_ROPE1 = 1 * MiB;
constexpr size_t WS_ROPE2 = 2 * MiB;
constexpr size_t WS_TAB = 6 * MiB;
constexpr size_t WS_CMPT = 7 * MiB;
constexpr size_t WS_WIN0 = 8 * MiB, WS_WOUT0 = 13 * MiB, WS_WGU = 15 * MiB, WS_WDN = 26 * MiB, WS_WIN1 = 32 * MiB, WS_WOUT1 = 38 * MiB, WS_WCMP = 40 * MiB;
constexpr size_t WS_MOEGU = 42 * MiB, WS_MOED = 154 * MiB;
constexpr size_t WS_XN = 210 * MiB;
constexpr size_t WS_PROJ = 242 * MiB;
constexpr size_t WS_RA = 338 * MiB;
constexpr size_t WS_END = 451 * MiB;
constexpr size_t WS_ONSA = 42 * MiB;
constexpr size_t WS_CMPH = 74 * MiB;
constexpr size_t WS_KCR = 80 * MiB, WS_VCR = 84 * MiB, WS_KW = 88 * MiB, WS_VWT = 92 * MiB;
constexpr size_t WS_QS = 338 * MiB;
constexpr size_t WS_KS = 354 * MiB;
constexpr size_t WS_VST = 358 * MiB;
constexpr size_t WS_QIN = 362 * MiB;
constexpr size_t WS_OINTRA = 370 * MiB;
constexpr size_t WS_UT = 402 * MiB;
constexpr size_t WS_DEC = 434 * MiB;
constexpr size_t WS_SB = 435 * MiB;
constexpr size_t WS_XS = 242 * MiB;
constexpr size_t WS_ACTH = 310 * MiB;
static_assert(WS_XS + (size_t)XS_ROWS * 1024 * 2 <= WS_ACTH && WS_ACTH + (size_t)(MAXTILES - HALFTILES) * 256 * FFE * 2 <= WS_END && (size_t)NSPLIT * 8 * 256 * 1024 * 2 <= 32 * MiB, "moe map");
static_assert(WS_DEC + (size_t)NUNIT * 64 * 4 <= WS_SB && WS_SB + (size_t)NUNIT * 8192 * 2 <= WS_END, "ws map");
constexpr size_t TB_TOKE = 0, TB_TOKW = 128 * 1024, TB_TOKR = 256 * 1024, TB_TOKS = 384 * 1024, TB_TILEE = 512 * 1024;
constexpr size_t CT_KCB = 0, CT_VCBT = 256 * 1024, CT_B1P = 512 * 1024, CT_W2T = 768 * 1024;
constexpr int CW_BAR = 4096;
constexpr int CW_CNT = 16384;
constexpr int CW_NT = 16384 + 64;

constexpr int RING_BYTES = 131072;
constexpr int LDSCTL_OFF = RING_BYTES, MISC_OFF = LDSCTL_OFF + 320;
constexpr int LDS_BYTES = 147456;
constexpr int NWAVES = 8;

#define GAS __attribute__((address_space(1)))
#define LAS __attribute__((address_space(3)))
#define DI __device__ __forceinline__
typedef unsigned short bf16;
typedef unsigned v4u __attribute__((ext_vector_type(4)));
typedef unsigned v2u __attribute__((ext_vector_type(2)));
typedef float f32x4 __attribute__((ext_vector_type(4)));
typedef short bf16x8 __attribute__((ext_vector_type(8)));
typedef float f32x2_t __attribute__((ext_vector_type(2))); typedef __bf16 bf16x2_t __attribute__((ext_vector_type(2)));
DI unsigned pk2(float lo, float hi) { f32x2_t v = {lo, hi}; bf16x2_t b = __builtin_convertvector(v, bf16x2_t); return __builtin_bit_cast(unsigned, b); }
DI unsigned f2bf(float f) { return pk2(f, 0.f) & 0xffffu; }
DI float bflo(unsigned w) { return __builtin_bit_cast(float, w << 16); }
DI float bfhi(unsigned w) { return __builtin_bit_cast(float, w & 0xffff0000u); }
DI void unpack8(const v4u v, float (&x)[8]) { x[0] = bflo(v.x); x[1] = bfhi(v.x); x[2] = bflo(v.y); x[3] = bfhi(v.y); x[4] = bflo(v.z); x[5] = bfhi(v.z); x[6] = bflo(v.w); x[7] = bfhi(v.w); }
DI v4u pack8(const float (&x)[8]) { v4u v; v.x = pk2(x[0], x[1]); v.y = pk2(x[2], x[3]); v.z = pk2(x[4], x[5]); v.w = pk2(x[6], x[7]); return v; }
DI bf16x8 ldg16(const bf16* p) { return *(const bf16x8*)p; }
DI f32x4 mfma16(bf16x8 a, bf16x8 b, f32x4 c) { return __builtin_amdgcn_mfma_f32_16x16x32_bf16(a, b, c, 0, 0, 0); }
template <int CTRL> DI float dppf(float v) { return __builtin_bit_cast(float, __builtin_amdgcn_update_dpp(0, __builtin_bit_cast(int, v), CTRL, 0xf, 0xf, true)); }
DI float rdlane(float v, int l) { return __builtin_bit_cast(float, __builtin_amdgcn_readlane(__builtin_bit_cast(int, v), l)); }
DI float sum8(float v) { v += dppf<0xB1>(v); v += dppf<0x4E>(v); v += dppf<0x141>(v); return v; }
DI float sum16(float v) { v = sum8(v); v += dppf<0x140>(v); return v; }
DI float wave_sum(float v) { v = sum16(v); return (rdlane(v, 0) + rdlane(v, 16)) + (rdlane(v, 32) + rdlane(v, 48)); }
DI float xor1(float v) { return dppf<0xB1>(v); }
DI float scan64(float v, int lane, float& total) {
    v += dppf<0x111>(v); v += dppf<0x112>(v); v += dppf<0x114>(v); v += dppf<0x118>(v);
    const float s0 = rdlane(v, 15), s1 = rdlane(v, 31), s2 = rdlane(v, 47), s3 = rdlane(v, 63); const int row = lane >> 4;
    v += (row >= 1 ? s0 : 0.f) + (row >= 2 ? s1 : 0.f) + (row >= 3 ? s2 : 0.f);
    total = (s0 + s1) + (s2 + s3); return v;
}
DI float silu_f(float g) { return g / (1.0f + __expf(-g)); }

#define XB_TMO      128
#define XB_XCNT(j)  (256  + 64 * (j))
#define XB_XSUB(j)  (1280 + 64 * (j))
#define XB_XGEN(j)  (2304 + 64 * (j))
#define XB_TOP      3328
#define XB_TOPGEN   3392
#define XCD_BAR_WORDS 3456
#define XB_SPIN_CAP (1u << 18)

__device__ __forceinline__ unsigned xb_ld(unsigned* p)              { return __hip_atomic_load(p, __ATOMIC_RELAXED, __HIP_MEMORY_SCOPE_AGENT); }
__device__ __forceinline__ unsigned xb_add(unsigned* p, unsigned v) { return __hip_atomic_fetch_add(p, v, __ATOMIC_RELAXED, __HIP_MEMORY_SCOPE_AGENT); }
__device__ __forceinline__ unsigned xb_xcc_id() { return (unsigned)__builtin_amdgcn_s_getreg((3 << 11) | 20) & 0xFu; }
#define XB_SPIN(cond, bar) do { unsigned _sp = 0; while (cond) { __builtin_amdgcn_s_sleep(1); \
    if ((++_sp & 255u) == 0u) { if (xb_ld(&(bar)[XB_TMO])) break; if (_sp > XB_SPIN_CAP) { atomicAdd(&(bar)[XB_TMO], 1u); break; } } } } while (0)

struct XcdBarrier { unsigned* bar; unsigned x; volatile LAS unsigned* st; };

__device__ __forceinline__ XcdBarrier xcd_barrier_post(unsigned* bar, volatile LAS unsigned* st) {
    XcdBarrier b; b.bar = bar; b.x = xb_xcc_id(); b.st = st;
    if (threadIdx.x == 0) (void)xb_add(&bar[XB_XCNT(b.x)], 1u);
    return b;
}
__device__ __forceinline__ void xcd_barrier_complete(unsigned* bar, unsigned x, unsigned& nloc, unsigned& nx) {
    const unsigned G = gridDim.x * gridDim.y * gridDim.z;
    unsigned sum, cnt, mine, sp = 0u;
    for (;;) {
        sum = 0u; cnt = 0u; mine = 0u;
#pragma unroll
        for (unsigned j = 0; j < 16; ++j) { const unsigned c = xb_ld(&bar[XB_XCNT(j)]); sum += c; cnt += (c > 0u) ? 1u : 0u; mine = (j == x) ? c : mine; }
        if (sum == G) break;
        __builtin_amdgcn_s_sleep(1);
        if ((++sp & 255u) == 0u) { if (xb_ld(&bar[XB_TMO])) break; if (sp > XB_SPIN_CAP) { atomicAdd(&bar[XB_TMO], 1u); break; } }
    }
    nloc = mine > 0u ? mine : 1u; nx = cnt > 0u ? cnt : 1u;
}
__device__ __forceinline__ void xcd_barrier(const XcdBarrier& b) {
    asm volatile("s_waitcnt vmcnt(0)" ::: "memory");
    __syncthreads();
    if (threadIdx.x == 0) {
        unsigned* bar = b.bar;
        __builtin_amdgcn_s_waitcnt(0);
        unsigned nloc = b.st[0], nx = b.st[1];
        if (nloc == 0u) { xcd_barrier_complete(bar, b.x, nloc, nx); b.st[0] = nloc; b.st[1] = nx; }
        const unsigned old = xb_add(&bar[XB_XSUB(b.x)], 1u);
        const unsigned gen = old / nloc;
        if (old + 1u == (gen + 1u) * nloc) {
            __builtin_amdgcn_fence(__ATOMIC_RELEASE, "agent");
            asm volatile("s_waitcnt vmcnt(0)" ::: "memory");
            const unsigned og = xb_add(&bar[XB_TOP], 1u);
            const unsigned tg = og / nx;
            if (og + 1u == (tg + 1u) * nx) xb_add(&bar[XB_TOPGEN], 1u);
            else XB_SPIN(xb_ld(&bar[XB_TOPGEN]) == tg, bar);
            __builtin_amdgcn_fence(__ATOMIC_ACQUIRE, "agent");
            xb_add(&bar[XB_XGEN(b.x)], 1u);
            asm volatile("s_waitcnt vmcnt(0)" ::: "memory");
        } else {
            XB_SPIN(xb_ld(&bar[XB_XGEN(b.x)]) == gen, bar);
            __builtin_amdgcn_fence(__ATOMIC_ACQUIRE, "agent");
            asm volatile("s_waitcnt vmcnt(0)" ::: "memory");
        }
    }
    __syncthreads();
}

#define LDS_WAIT() asm volatile("s_waitcnt lgkmcnt(0)" ::: "memory")

DI void tr_item64(const float* __restrict__ W, int N, bf16* __restrict__ WT, int kpitch, int drow0, int k0, int n0, const float* __restrict__ gain, LAS unsigned char* scr, int lane) {
    const int n4 = lane & 15, kq = lane >> 4, n = n0 + 4 * n4; const bool ok = n < N;
    f32x4 v[4][4];
#pragma unroll
    for (int g = 0; g < 4; ++g)
#pragma unroll
        for (int j = 0; j < 4; ++j) v[g][j] = ok ? __builtin_nontemporal_load((const f32x4*)(W + (size_t)(k0 + 16 * g + 4 * kq + j) * N + n)) : (f32x4){0.f, 0.f, 0.f, 0.f};
#pragma unroll
    for (int g = 0; g < 4; ++g) { float gj[4];
#pragma unroll
        for (int j = 0; j < 4; ++j) gj[j] = gain ? gain[k0 + 16 * g + 4 * kq + j] : 1.f;
        const int chunk = 2 * g + (kq >> 1), half = kq & 1;
#pragma unroll
        for (int i = 0; i < 4; ++i) { const int nn = 4 * n4 + i; v2u wv; wv.x = pk2(v[g][0][i] * gj[0], v[g][1][i] * gj[1]); wv.y = pk2(v[g][2][i] * gj[2], v[g][3][i] * gj[3]);
            *(LAS v2u*)(scr + nn * 128 + ((chunk ^ (n4 & 7)) << 4) + half * 8) = wv; } }
    LDS_WAIT(); asm volatile("" ::: "memory");
#pragma unroll
    for (int jj = 0; jj < 8; ++jj) { const int nn = (lane >> 3) + 8 * jj, c = lane & 7; const v4u o = *(const LAS v4u*)(scr + nn * 128 + ((c ^ ((nn >> 2) & 7)) << 4));
        *(v4u*)(WT + (size_t)(drow0 + nn) * kpitch + k0 + 8 * c) = o; }
    LDS_WAIT(); asm volatile("" ::: "memory");
}
DI void conv_mat(const float* W, int K, int N, int NP, bf16* WT, int mode, const float* gain, LAS unsigned char* scr, int gw, int NGW, int lane) {
    const int nblk = NP / 64, nit = nblk * (K / 64);
    for (int it = gw; it < nit; it += NGW) { const int kb = it / nblk, nb = it - kb * nblk, n0 = nb * 64;
        const int drow0 = (mode == 0) ? n0 : ((n0 >> 7) * 256 + (n0 & 127) + (mode == 2 ? 128 : 0));
        tr_item64(W, N, WT, K, drow0, kb * 64, n0, gain, scr, lane); }
}
DI void conv_tile_wg(const float* __restrict__ W, int K, int N, bf16* __restrict__ WT, int mode, const float* __restrict__ gain, LAS unsigned char* lds, int lane, int w, int k0, int n0) {
    const int col4 = lane & 31, rsub = lane >> 5;
    const int kl = 32 * w + 16 * rsub;
    const float* src = W + (size_t)(k0 + kl) * N + n0 + 4 * col4;
    f32x4 v[16];
#pragma unroll
    for (int i = 0; i < 16; ++i) v[i] = (n0 + 4 * col4 < N) ? __builtin_nontemporal_load((const f32x4*)(src + (size_t)i * N)) : (f32x4){0.f, 0.f, 0.f, 0.f};
    if (gain) {
#pragma unroll
        for (int i = 0; i < 16; ++i) v[i] = v[i] * gain[k0 + kl + i]; }
    const int c0 = 4 * w + 2 * rsub;
#pragma unroll
    for (int i = 0; i < 4; ++i) { const int nn = 4 * col4 + i;
#pragma unroll
        for (int hf = 0; hf < 2; ++hf) { v4u o; o.x = pk2(v[8 * hf + 0][i], v[8 * hf + 1][i]); o.y = pk2(v[8 * hf + 2][i], v[8 * hf + 3][i]); o.z = pk2(v[8 * hf + 4][i], v[8 * hf + 5][i]); o.w = pk2(v[8 * hf + 6][i], v[8 * hf + 7][i]);
            *(LAS v4u*)(lds + nn * 512 + (((c0 + hf) ^ (col4 & 7)) << 4)) = o; } }
    __syncthreads();
    const int drow0 = (mode == 0) ? n0 : ((n0 >> 7) * 256 + (mode == 2 ? 128 : 0));
#pragma unroll
    for (int jj = 0; jj < 8; ++jj) { const int nn = 16 * w + 2 * jj + rsub, c = lane & 31; const v4u o = *(const LAS v4u*)(lds + nn * 512 + ((c ^ ((nn >> 2) & 7)) << 4));
        *(v4u*)(WT + (size_t)(drow0 + nn) * K + k0 + 8 * c) = o; }
    __syncthreads();
}
DI void conv_mat_wg(const float* __restrict__ W, int K, int N, int NP, bf16* __restrict__ WT, int mode, const float* __restrict__ gain, LAS unsigned char* lds, int lane, int w, int bid, int G) {
    const int nsb = NP / 128, nst = nsb * (K / 256);
    __syncthreads();
    for (int st = bid; st < nst; st += G) { const int kb = st / nsb, nb = st - kb * nsb; conv_tile_wg(W, K, N, WT, mode, gain, lds, lane, w, kb * 256, nb * 128); }
}
DI void conv_moe_tiles(const float* __restrict__ wg_, const float* __restrict__ wu_, const float* __restrict__ wd_, const float* __restrict__ gain, bf16* __restrict__ MOEGU, bf16* __restrict__ MOED,
                       LAS unsigned char* lds, int lane, int w, int lo, int hi, int rank, int n) {
    __syncthreads();
    for (int t = lo + rank; t < hi; t += n) { const int mi = t / 112, st = t - mi * 112;
        if (mi < 8) { conv_tile_wg(wd_ + (size_t)mi * FFE * D, FFE, D, MOED + (size_t)mi * D * FFE, 0, nullptr, lds, lane, w, (st >> 3) * 256, (st & 7) * 128); }
        else { const int q = mi - 8, e = 7 - (q >> 1), up = q & 1; const int kb = st / 28, nb = st - kb * 28;
            conv_tile_wg((up ? wu_ : wg_) + (size_t)e * D * FFE, D, FFE, MOEGU + (size_t)e * 2 * FFE * D, up ? 2 : 1, gain, lds, lane, w, kb * 256, nb * 128); } }
}
DI void rope_tables(const int* __restrict__ pos, float* __restrict__ R1, float* __restrict__ R2, int gtid, int NT) {
    for (int idx = gtid; idx < M * 40; idx += NT) { const int m = idx / 40, i = idx - m * 40; const float p = (float)pos[m];
        float inv; if (i < 8) inv = exp2f(-(float)i * (18.931568569324174f / 8.0f)); else inv = exp2f(-(float)(i - 8) * (13.287712379549449f / 32.0f));
        double rev = (double)p * (double)inv * 0.15915494309189535; rev -= floor(rev); const float fr = (float)rev;
        const float c = __builtin_amdgcn_cosf(fr), s = __builtin_amdgcn_sinf(fr);
        if (i < 8) { R1[m * 16 + i] = c; R1[m * 16 + 8 + i] = s; } else { R2[m * 64 + (i - 8)] = c; R2[m * 64 + 32 + (i - 8)] = s; } }
}
DI void rms_row_bf16(const float* __restrict__ xrow, bf16* __restrict__ orow, int lane) {
    const f32x4* xr = (const f32x4*)xrow + lane;
    f32x4 v[4]; float s = 0.f;
#pragma unroll
    for (int j = 0; j < 4; ++j) { v[j] = xr[64 * j]; s += (v[j].x * v[j].x + v[j].y * v[j].y) + (v[j].z * v[j].z + v[j].w * v[j].w); }
    const float rstd = 1.f / sqrtf(wave_sum(s) * (1.f / D) + EPS);
    unsigned long long* o8 = (unsigned long long*)orow + lane;
#pragma unroll
    for (int j = 0; j < 4; ++j) o8[64 * j] = (unsigned long long)pk2(v[j].x * rstd, v[j].y * rstd) | ((unsigned long long)pk2(v[j].z * rstd, v[j].w * rstd) << 32);
}
DI void rms_phase(const float* __restrict__ src, bf16* __restrict__ dst, int gw, int NGW, int lane) {
    int m = gw;
    for (; m + 3 * NGW < M; m += 4 * NGW) { f32x4 v[4][4];
#pragma unroll
        for (int q = 0; q < 4; ++q) { const f32x4* xr = (const f32x4*)(src + (size_t)(m + q * NGW) * D) + lane;
#pragma unroll
            for (int j = 0; j < 4; ++j) v[q][j] = xr[64 * j]; }
#pragma unroll
        for (int q = 0; q < 4; ++q) { float s = 0.f;
#pragma unroll
            for (int j = 0; j < 4; ++j) s += (v[q][j].x * v[q][j].x + v[q][j].y * v[q][j].y) + (v[q][j].z * v[q][j].z + v[q][j].w * v[q][j].w);
            const float rstd = 1.f / sqrtf(wave_sum(s) * (1.f / D) + EPS);
            unsigned long long* o8 = (unsigned long long*)(dst + (size_t)(m + q * NGW) * D) + lane;
#pragma unroll
            for (int j = 0; j < 4; ++j) o8[64 * j] = (unsigned long long)pk2(v[q][j].x * rstd, v[q][j].y * rstd) | ((unsigned long long)pk2(v[q][j].z * rstd, v[q][j].w * rstd) << 32); } }
    for (; m < M; m += NGW) rms_row_bf16(src + (size_t)m * D, dst + (size_t)m * D, lane);
}
DI void cmp_bias_item(const float* __restrict__ posf, const float* __restrict__ w1, float* __restrict__ outp, int jb, int ch, int lane) {
    const int j = jb * 64 + lane; float a0 = 0.f, a1 = 0.f, a2 = 0.f, a3 = 0.f;
#pragma unroll
    for (int i = ch * 32; i < ch * 32 + 32; i += 4) {
        a0 += posf[i] * w1[(size_t)i * 256 + j]; a1 += posf[i + 1] * w1[(size_t)(i + 1) * 256 + j];
        a2 += posf[i + 2] * w1[(size_t)(i + 2) * 256 + j]; a3 += posf[i + 3] * w1[(size_t)(i + 3) * 256 + j]; }
    outp[ch * 256 + j] = (a0 + a1) + (a2 + a3);
}

DI void head_norm_rope(float (&x)[8], const float* __restrict__ gain, int sub, const float* __restrict__ cs) {
    float ss = 0.f;
#pragma unroll
    for (int i = 0; i < 8; ++i) ss += x[i] * x[i];
    ss = sum8(ss);
    const float rstd = 1.f / sqrtf(ss * (1.f / 64.f) + EPS);
#pragma unroll
    for (int i = 0; i < 8; ++i) x[i] = x[i] * rstd * gain[sub * 8 + i];
#pragma unroll
    for (int i = 0; i < 8; ++i) { const float other = xor1(x[i]); const float c = cs[i], s = cs[8 + i];
        if (sub == 0) x[i] = x[i] * c - other * s; else if (sub == 1) x[i] = x[i] * c + other * s; }
}
DI void q8_token(const bf16* __restrict__ src, const float* __restrict__ gain, const float* __restrict__ cs, bf16* __restrict__ dst, size_t hstride, int lane) {
    const int head = lane >> 3, sub = lane & 7; float x[8];
    unpack8(*(const v4u*)(src + head * 64 + sub * 8), x);
    head_norm_rope(x, gain, sub, cs);
#pragma unroll
    for (int i = 0; i < 8; ++i) x[i] *= 0.125f * LOG2E;
    *(v4u*)(dst + (size_t)head * hstride + sub * 8) = pack8(x);
}

constexpr int LP = 72;
constexpr int L_QIN = 0, L_KIN = 64 * LP * 2, L_KST = 2 * 64 * LP * 2, L_VT = 3 * 64 * LP * 2;

template <bool RET>
DI void chunk_phaseA(LAS unsigned char* lds, const bf16* __restrict__ PROJ, int ldp, int cq, int ck, int cv, int cglow,
                     const float* __restrict__ gate_up, const float* __restrict__ gate_bias, const float* __restrict__ rope2,
                     bf16* __restrict__ QIN, bf16* __restrict__ OINTRA, float* __restrict__ UT, float* __restrict__ DEC,
                     int lane, int w, int bid, int G) {
    const int r = lane & 15, quad = lane >> 4;
    struct ARaw { v4u a[6]; f32x4 c[4]; };
    auto load_raw = [&](int unit_, ARaw& R_) { const int b_ = unit_ >> 8, h_ = (unit_ >> 6) & 3, n_ = unit_ & 63; const int m_ = b_ * T + n_ * 64 + lane; const bf16* pr = PROJ + (size_t)m_ * ldp;
        if (!RET) { R_.a[0] = *(const v4u*)(pr + cglow); R_.a[1] = *(const v4u*)(pr + cglow + 8); R_.a[2] = *(const v4u*)(pr + cq + h_ * 64 + 8 * w); R_.a[3] = *(const v4u*)(pr + ck + h_ * 64 + 8 * w); }
        else { const int c0 = 8 * w, cp = (c0 + 32) & 63; R_.a[0] = *(const v4u*)(pr + cq + h_ * 64 + c0); R_.a[1] = *(const v4u*)(pr + cq + h_ * 64 + cp); R_.a[2] = *(const v4u*)(pr + ck + h_ * 64 + c0); R_.a[3] = *(const v4u*)(pr + ck + h_ * 64 + cp);
            const float* cs = rope2 + (size_t)m_ * 64 + (c0 & 31); R_.c[0] = *(const f32x4*)cs; R_.c[1] = *(const f32x4*)(cs + 4); R_.c[2] = *(const f32x4*)(cs + 32); R_.c[3] = *(const f32x4*)(cs + 36); }
        R_.a[4] = *(const v4u*)(pr + cv + h_ * 128 + 16 * w); R_.a[5] = *(const v4u*)(pr + cv + h_ * 128 + 16 * w + 8); };
    ARaw cur; if (bid < NUNIT) load_raw(bid, cur);
    for (int unit = bid; unit < NUNIT; unit += G) {
        const int h = (unit >> 6) & 3;
        float la[8];
        if (!RET) {
            float gl[16]; { float t8[8]; unpack8(cur.a[0], t8);
#pragma unroll
                for (int i = 0; i < 8; ++i) gl[i] = t8[i];
                unpack8(cur.a[1], t8);
#pragma unroll
                for (int i = 0; i < 8; ++i) gl[8 + i] = t8[i]; }
#pragma unroll
            for (int cc = 0; cc < 8; ++cc) { const int c = h * 64 + 8 * w + cc; float x = gate_bias[c];
#pragma unroll
                for (int rr = 0; rr < 16; ++rr) x += gl[rr] * gate_up[rr * 256 + c];
                la[cc] = (fminf(x, 0.f) - __logf(1.f + __expf(-fabsf(x)))) * (1.f / 16.f); }
        } else {
            const float lg = logf(1.f - exp2f(-5.f - (float)h));
#pragma unroll
            for (int cc = 0; cc < 8; ++cc) la[cc] = lg;
        }
        float bl[8];
#pragma unroll
        for (int cc = 0; cc < 8; ++cc) la[cc] = scan64(la[cc], lane, bl[cc]);
        float q[8], k[8];
        if (!RET) {
            unpack8(cur.a[2], q); unpack8(cur.a[3], k);
#pragma unroll
            for (int i = 0; i < 8; ++i) q[i] *= 0.125f;
        } else {
            const int c0 = 8 * w; float qp[8], kp[8];
            unpack8(cur.a[0], q); unpack8(cur.a[1], qp); unpack8(cur.a[2], k); unpack8(cur.a[3], kp);
#pragma unroll
            for (int i = 0; i < 8; ++i) { const float c = cur.c[i >> 2][i & 3], s = cur.c[2 + (i >> 2)][i & 3];
                if (c0 < 32) { q[i] = q[i] * c - qp[i] * s; k[i] = (k[i] * c - kp[i] * s) * 0.125f; }
                else         { q[i] = q[i] * c + qp[i] * s; k[i] = (k[i] * c + kp[i] * s) * 0.125f; } }
        }
        float qin[8], kin[8];
        LAS bf16* kst = (LAS bf16*)(lds + L_KST);
#pragma unroll
        for (int cc = 0; cc < 8; ++cc) { qin[cc] = q[cc] * __expf(la[cc]); kin[cc] = k[cc] * __expf(-la[cc]);
            kst[(8 * w + cc) * LP + lane] = (bf16)f2bf(k[cc] * __expf(bl[cc] - la[cc])); }
        const v4u qv = pack8(qin), kv = pack8(kin);
        *(LAS v4u*)(lds + L_QIN + (lane * LP + 8 * w) * 2) = qv;
        *(LAS v4u*)(lds + L_KIN + (lane * LP + 8 * w) * 2) = kv;
        *(v4u*)(QIN + (size_t)unit * 4096 + lane * 64 + 8 * w) = qv;
        if (lane == 63) {
#pragma unroll
            for (int cc = 0; cc < 8; ++cc) DEC[(size_t)unit * 64 + 8 * w + cc] = __expf(bl[cc]); }
        { float v0[8], v1[8]; unpack8(cur.a[4], v0); unpack8(cur.a[5], v1);
            LAS bf16* vt = (LAS bf16*)(lds + L_VT);
#pragma unroll
            for (int i = 0; i < 8; ++i) { vt[(16 * w + i) * LP + lane] = (bf16)f2bf(v0[i]); vt[(16 * w + 8 + i) * LP + lane] = (bf16)f2bf(v1[i]); } }
        __syncthreads();
        ARaw nxt; if (unit + G < NUNIT) load_raw(unit + G, nxt);
        {
            const int tt = w & 3, dh = w >> 2;
            const bf16x8 qf0 = *(const LAS bf16x8*)(lds + L_QIN + ((tt * 16 + r) * LP + quad * 8) * 2), qf1 = *(const LAS bf16x8*)(lds + L_QIN + ((tt * 16 + r) * LP + 32 + quad * 8) * 2);
            f32x4 acc[4];
#pragma unroll
            for (int d4 = 0; d4 < 4; ++d4) acc[d4] = (f32x4){0.f, 0.f, 0.f, 0.f};
            const int nks = (tt >> 1) + 1;
            for (int ks = 0; ks < nks; ++ks) { const int kb = 32 * ks, krow = kb + ((r >> 2) << 3) + (r & 3);
                const LAS unsigned char* kp = lds + L_KIN + (krow * LP + quad * 8) * 2;
                const bf16x8 k00 = *(const LAS bf16x8*)kp, k01 = *(const LAS bf16x8*)(kp + 64), k10 = *(const LAS bf16x8*)(kp + 4 * LP * 2), k11 = *(const LAS bf16x8*)(kp + 4 * LP * 2 + 64);
                f32x4 s0 = mfma16(k00, qf0, (f32x4){0.f, 0.f, 0.f, 0.f}); s0 = mfma16(k01, qf1, s0);
                f32x4 s1 = mfma16(k10, qf0, (f32x4){0.f, 0.f, 0.f, 0.f}); s1 = mfma16(k11, qf1, s1);
                const int tok = tt * 16 + r, key0 = kb + 8 * quad; float p[8];
#pragma unroll
                for (int jj = 0; jj < 4; ++jj) { p[jj] = (key0 + jj <= tok) ? s0[jj] : 0.f; p[4 + jj] = (key0 + 4 + jj <= tok) ? s1[jj] : 0.f; }
                const bf16x8 pf = __builtin_bit_cast(bf16x8, pack8(p));
#pragma unroll
                for (int d4 = 0; d4 < 4; ++d4) { const bf16x8 vf = *(const LAS bf16x8*)(lds + L_VT + ((dh * 64 + d4 * 16 + r) * LP + kb + quad * 8) * 2); acc[d4] = mfma16(vf, pf, acc[d4]); }
            }
#pragma unroll
            for (int d4 = 0; d4 < 4; ++d4) { v2u o; o.x = pk2(acc[d4][0], acc[d4][1]); o.y = pk2(acc[d4][2], acc[d4][3]); *(v2u*)(OINTRA + (size_t)unit * 8192 + (tt * 16 + r) * 128 + dh * 64 + d4 * 16 + 4 * quad) = o; }
        }
        {
#pragma unroll
            for (int dkt = 0; dkt < 4; ++dkt) { f32x4 au = (f32x4){0.f, 0.f, 0.f, 0.f};
#pragma unroll
                for (int ks = 0; ks < 2; ++ks) { const bf16x8 a = *(const LAS bf16x8*)(lds + L_VT + ((16 * w + r) * LP + 32 * ks + quad * 8) * 2);
                    const bf16x8 bq = *(const LAS bf16x8*)(lds + L_KST + ((dkt * 16 + r) * LP + 32 * ks + quad * 8) * 2); au = mfma16(a, bq, au); }
#pragma unroll
                for (int i = 0; i < 4; ++i) UT[(size_t)unit * 8192 + (16 * w + 4 * quad + i) * 64 + dkt * 16 + r] = au[i]; }
        }
        __syncthreads();
        if (unit + G < NUNIT) cur = nxt;
    }
}
DI void chunk_scan(const float* __restrict__ UT, const float* __restrict__ DEC, bf16* __restrict__ SB, int gtid, int NT) {
    for (int e = gtid; e < 16 * 4096; e += NT) { const int bh = e >> 12, idx2 = (e & 4095) * 2, dk = idx2 & 63; f32x2_t S = (f32x2_t){0.f, 0.f};
        const float* up = UT + (size_t)bh * 64 * 8192 + idx2; const float* dp = DEC + (size_t)bh * 64 * 64 + dk; unsigned* sp = (unsigned*)(SB + (size_t)bh * 64 * 8192 + idx2);
#pragma unroll 8
        for (int n = 0; n < 64; ++n) { const f32x2_t u = *(const f32x2_t*)(up + (size_t)n * 8192), d = *(const f32x2_t*)(dp + n * 64); sp[(size_t)n * 4096] = pk2(S.x, S.y); S = d * S + u; } }
}
template <bool RET>
DI void chunk_phaseC(const bf16* __restrict__ QIN, const bf16* __restrict__ OINTRA, const bf16* __restrict__ SB, const bf16* __restrict__ PROJ, int ldp, int cgate,
                     const float* __restrict__ gnorm, bf16* __restrict__ MIXED, int gw, int NGW, int lane) {
    const int r = lane & 15, quad = lane >> 4;
    for (int wu0 = gw; wu0 < NUNIT * 4; wu0 += 2 * NGW) {
        int unit[2], tt[2]; bool ok[2]; bf16x8 qf[2][2]; v2u oi[2][8], gv[2][8]; size_t mrow[2]; int hh[2];
#pragma unroll
        for (int q = 0; q < 2; ++q) { const int wu = wu0 + q * NGW; ok[q] = wu < NUNIT * 4; const int wv = ok[q] ? wu : wu0; unit[q] = wv >> 2; tt[q] = wv & 3;
            const int b = unit[q] >> 8, n = unit[q] & 63; hh[q] = (unit[q] >> 6) & 3; mrow[q] = (size_t)b * T + n * 64 + tt[q] * 16 + r;
            const bf16* qp = QIN + (size_t)unit[q] * 4096 + (tt[q] * 16 + r) * 64 + quad * 8; qf[q][0] = ldg16(qp); qf[q][1] = ldg16(qp + 32);
#pragma unroll
            for (int dt = 0; dt < 8; ++dt) { oi[q][dt] = *(const v2u*)(OINTRA + (size_t)unit[q] * 8192 + (tt[q] * 16 + r) * 128 + dt * 16 + 4 * quad);
                gv[q][dt] = *(const v2u*)(PROJ + mrow[q] * ldp + cgate + hh[q] * 128 + dt * 16 + 4 * quad); } }
        f32x4 acc[2][8];
#pragma unroll
        for (int dt = 0; dt < 8; ++dt)
#pragma unroll
            for (int q = 0; q < 2; ++q) { acc[q][dt] = (f32x4){bflo(oi[q][dt].x), bfhi(oi[q][dt].x), bflo(oi[q][dt].y), bfhi(oi[q][dt].y)};
#pragma unroll
                for (int kk = 0; kk < 2; ++kk) acc[q][dt] = mfma16(ldg16(SB + (size_t)unit[q] * 8192 + (dt * 16 + r) * 64 + kk * 32 + quad * 8), qf[q][kk], acc[q][dt]); }
#pragma unroll
        for (int q = 0; q < 2; ++q) if (ok[q]) {
            float mean = 0.f;
            if (RET) { float s_ = 0.f;
#pragma unroll
                for (int dt = 0; dt < 8; ++dt) s_ += (acc[q][dt][0] + acc[q][dt][1]) + (acc[q][dt][2] + acc[q][dt][3]);
                s_ += __shfl_xor(s_, 16); s_ += __shfl_xor(s_, 32); mean = s_ * (1.f / 128.f); }
            float ss = 0.f;
#pragma unroll
            for (int dt = 0; dt < 8; ++dt)
#pragma unroll
                for (int i = 0; i < 4; ++i) { const float d = acc[q][dt][i] - mean; ss += d * d; }
            ss += __shfl_xor(ss, 16); ss += __shfl_xor(ss, 32);
            const float rstd = 1.f / sqrtf(ss * (1.f / 128.f) + EPS);
#pragma unroll
            for (int dt = 0; dt < 8; ++dt) { const int dv = dt * 16 + 4 * quad; const v2u g_ = gv[q][dt];
                const float g0 = bflo(g_.x), g1 = bfhi(g_.x), g2 = bflo(g_.y), g3 = bfhi(g_.y);
                const float* gn = gnorm + (RET ? hh[q] * 128 : 0) + dv;
                const float y0 = (acc[q][dt][0] - mean) * rstd * gn[0] * silu_f(g0), y1 = (acc[q][dt][1] - mean) * rstd * gn[1] * silu_f(g1);
                const float y2 = (acc[q][dt][2] - mean) * rstd * gn[2] * silu_f(g2), y3 = (acc[q][dt][3] - mean) * rstd * gn[3] * silu_f(g3);
                v2u o; o.x = pk2(y0, y1); o.y = pk2(y2, y3);
                *(v2u*)(MIXED + mrow[q] * 1024 + hh[q] * 128 + dv) = o; } }
    }
}

struct KVF { bf16x8 k[4]; bf16x8 v[4]; };
DI void kv_load(KVF& f, const bf16* __restrict__ Kb, const bf16* __restrict__ VTb, int kb, int r, int quad) {
    const bf16* kp = Kb + (size_t)(kb + ((r >> 2) << 3) + (r & 3)) * 64 + quad * 8;
    f.k[0] = ldg16(kp); f.k[1] = ldg16(kp + 32); f.k[2] = ldg16(kp + 256); f.k[3] = ldg16(kp + 288);
    const bf16* vp = VTb + (size_t)(kb >> 5) * 2048 + r * 32 + quad * 8;
#pragma unroll
    for (int dt = 0; dt < 4; ++dt) f.v[dt] = ldg16(vp + dt * 512);
}
DI void k_load(KVF& f, const bf16* __restrict__ Kb, int kb, int r, int quad) {
    const bf16* kp = Kb + (size_t)(kb + ((r >> 2) << 3) + (r & 3)) * 64 + quad * 8;
    f.k[0] = ldg16(kp); f.k[1] = ldg16(kp + 32); f.k[2] = ldg16(kp + 256); f.k[3] = ldg16(kp + 288);
}
DI size_t kblk_off(int key, int d0) { const int kap = key & 31, a = kap >> 3, t = (kap >> 2) & 1, c = kap & 3, sub = d0 >> 3; return (size_t)(key >> 5) * 2048 + (t * 2 + (sub >> 2)) * 512 + ((sub & 3) * 16 + 4 * a + c) * 8; }
DI void glds16(const bf16* g, LAS unsigned char* l) { __builtin_amdgcn_global_load_lds((const unsigned*)g, (LAS unsigned*)l, 16, 0, 0); }
DI void kv_dma(LAS unsigned char* slot, const bf16* __restrict__ Kb, const bf16* __restrict__ VTb, int kb, int r, int quad) {
    const bf16* kp = Kb + (size_t)(kb >> 5) * 2048 + (quad * 16 + r) * 8;
    glds16(kp, slot); glds16(kp + 512, slot + 1024); glds16(kp + 1024, slot + 2048); glds16(kp + 1536, slot + 3072);
    const bf16* vp = VTb + (size_t)(kb >> 5) * 2048 + r * 32 + quad * 8;
#pragma unroll
    for (int dt = 0; dt < 4; ++dt) glds16(vp + dt * 512, slot + 4096 + dt * 1024);
}
DI void kv_read(KVF& f, const LAS unsigned char* slot, int lane) {
#pragma unroll
    for (int i = 0; i < 4; ++i) { f.k[i] = *(const LAS bf16x8*)(slot + i * 1024 + lane * 16); f.v[i] = *(const LAS bf16x8*)(slot + 4096 + i * 1024 + lane * 16); }
}
DI void k_dma(LAS unsigned char* slot, const bf16* __restrict__ Kb, int kb, int r, int quad) {
    const bf16* kp = Kb + (size_t)(kb >> 5) * 2048 + (quad * 16 + r) * 8;
    glds16(kp, slot); glds16(kp + 512, slot + 1024); glds16(kp + 1024, slot + 2048); glds16(kp + 1536, slot + 3072);
}
DI void k_read(KVF& f, const LAS unsigned char* slot, int lane) {
#pragma unroll
    for (int i = 0; i < 4; ++i) f.k[i] = *(const LAS bf16x8*)(slot + i * 1024 + lane * 16);
}
#define VM_WAIT(n) asm volatile("s_waitcnt vmcnt(" #n ")" ::: "memory")
DI void mask_bias(unsigned vm, float c2, f32x4& blo, f32x4& bhi) {
#pragma unroll
    for (int jj = 0; jj < 4; ++jj) { blo[jj] = ((vm >> jj) & 1u) ? -c2 : -1e30f; bhi[jj] = ((vm >> (4 + jj)) & 1u) ? -c2 : -1e30f; } }
DI void scores8(const KVF& f, const bf16x8 (&q)[2], const f32x4 blo, const f32x4 bhi, f32x4& s0, f32x4& s1) {
    s0 = mfma16(f.k[0], q[0], blo); s1 = mfma16(f.k[2], q[0], bhi); s0 = mfma16(f.k[1], q[1], s0); s1 = mfma16(f.k[3], q[1], s1); }
DI bf16x8 ones_frag() { return __builtin_bit_cast(bf16x8, (v4u){0x3f803f80u, 0x3f803f80u, 0x3f803f80u, 0x3f803f80u}); }
DI void attn_compute(const KVF& f, unsigned vm, const bf16x8 (&qf)[4][2], f32x4 (&acc)[4][4], f32x4 (&accl)[4], float c2) {
    f32x4 blo, bhi; mask_bias(vm, c2, blo, bhi);
    f32x4 s0[4], s1[4];
#pragma unroll
    for (int g = 0; g < 4; ++g) { s0[g] = mfma16(f.k[0], qf[g][0], blo); s1[g] = mfma16(f.k[2], qf[g][0], bhi); }
#pragma unroll
    for (int g = 0; g < 4; ++g) { s0[g] = mfma16(f.k[1], qf[g][1], s0[g]); s1[g] = mfma16(f.k[3], qf[g][1], s1[g]); }
    const bf16x8 ones = ones_frag();
#pragma unroll
    for (int g = 0; g < 4; ++g) { float p[8];
#pragma unroll
        for (int jj = 0; jj < 4; ++jj) { p[jj] = __builtin_amdgcn_exp2f(s0[g][jj]); p[4 + jj] = __builtin_amdgcn_exp2f(s1[g][jj]); }
        const bf16x8 pf = __builtin_bit_cast(bf16x8, pack8(p));
#pragma unroll
        for (int dt = 0; dt < 4; ++dt) acc[g][dt] = mfma16(f.v[dt], pf, acc[g][dt]);
        accl[g] = mfma16(ones, pf, accl[g]); }
}
DI unsigned win_mask(int kb, int quad, int tok, int W) { unsigned vm = 0u;
#pragma unroll
    for (int jj = 0; jj < 8; ++jj) { const int key = kb + 8 * quad + jj; if (key <= tok && key > tok - W) vm |= 1u << jj; }
    return vm; }
DI void load_q(bf16x8 (&qf)[4][2], const bf16* __restrict__ Q, int b, int hk, int t0, int r, int quad) {
#pragma unroll
    for (int g = 0; g < 4; ++g) { const bf16* qp = Q + ((size_t)(b * 8 + hk * 4 + g) * T + t0 + r) * 64 + quad * 8; qf[g][0] = ldg16(qp); qf[g][1] = ldg16(qp + 32); }
}
DI float wave_max_abs64(const float* __restrict__ g, int lane) { float v = fabsf(g[lane]);
#pragma unroll
    for (int o = 1; o < 64; o <<= 1) v = fmaxf(v, __shfl_xor(v, o));
    return v; }
DI int bal_tile(int wu) { const int u = wu & 255, w = u & 7, q = u >> 3, pair = q * 4 + (w & 3); return (w < 4) ? pair : 255 - pair; }
DI float quad_sum(float v) { v += __shfl_xor(v, 16); v += __shfl_xor(v, 32); return v; }
template <bool SINK, bool TO_MIXED>
DI void window_attn(const bf16* __restrict__ Q, const bf16* __restrict__ Kx, const bf16* __restrict__ VT, int W, const float* __restrict__ sinks, const float* __restrict__ gq, const float* __restrict__ gk,
                    bf16* __restrict__ MIXED, float* __restrict__ ONSA, const bf16* __restrict__ PROJ1, LAS unsigned char* ring, int gw, int NGW, int lane) {
    const int r = lane & 15, quad = lane >> 4; const float sc2 = 0.125f * LOG2E;
    float c2 = sc2 * 64.f * wave_max_abs64(gq, lane) * wave_max_abs64(gk, lane);
    if (SINK) { c2 = fmaxf(c2, fmaxf(fmaxf(sinks[0], sinks[1]), fmaxf(sinks[2], sinks[3])) * LOG2E); c2 = fmaxf(c2, fmaxf(fmaxf(sinks[4], sinks[5]), fmaxf(sinks[6], sinks[7])) * LOG2E); }
    for (int wu = gw; wu < BATCH * 2 * 256; wu += NGW) { const int tile = bal_tile(wu), hk = (wu >> 8) & 1, b = wu >> 9, t0 = tile * 16, tok = t0 + r;
        bf16x8 qf[4][2]; load_q(qf, Q, b, hk, t0, r, quad);
        f32x4 acc[4][4], accl[4];
#pragma unroll
        for (int g = 0; g < 4; ++g) { accl[g] = (f32x4){0.f, 0.f, 0.f, 0.f};
#pragma unroll
            for (int dt = 0; dt < 4; ++dt) acc[g][dt] = (f32x4){0.f, 0.f, 0.f, 0.f}; }
        const bf16* Kb = Kx + (size_t)(b * 2 + hk) * T * 64; const bf16* VTb = VT + (size_t)(b * 2 + hk) * 64 * T;
        int kb0 = t0 - (W - 1); kb0 = kb0 < 0 ? 0 : (kb0 & ~31);
        const int nst = ((t0 & ~31) - kb0) / 32 + 1;
        VM_WAIT(0);
        kv_dma(ring, Kb, VTb, kb0, r, quad); if (nst > 1) kv_dma(ring + 8192, Kb, VTb, kb0 + 32, r, quad);
        for (int st = 0; st < nst; ++st) { KVF cur;
            if (st + 1 < nst) VM_WAIT(8); else VM_WAIT(0);
            kv_read(cur, ring + (st & 1) * 8192, lane); LDS_WAIT();
            if (st + 2 < nst) kv_dma(ring + (st & 1) * 8192, Kb, VTb, kb0 + 32 * (st + 2), r, quad);
            attn_compute(cur, win_mask(kb0 + 32 * st, quad, tok, W), qf, acc, accl, c2); }
        const size_t m = (size_t)b * T + tok;
#pragma unroll
        for (int g = 0; g < 4; ++g) { float l = accl[g][0]; if (SINK) l += __builtin_amdgcn_exp2f(sinks[hk * 4 + g] * LOG2E - c2);
            float inv = l > 0.f ? 1.f / l : 0.f;
            if (!TO_MIXED) { const float gl = __builtin_bit_cast(float, ((unsigned)PROJ1[m * N1P + C1_NG + hk * 12 + g * 3 + 2]) << 16); inv *= 1.f / (1.f + __expf(-gl)); }
#pragma unroll
            for (int dt = 0; dt < 4; ++dt) { const f32x4 o = acc[g][dt] * inv; const int col = (hk * 4 + g) * 64 + dt * 16 + 4 * quad;
                if (TO_MIXED) { v2u w2; w2.x = pk2(o[0], o[1]); w2.y = pk2(o[2], o[3]); *(v2u*)(MIXED + m * 1024 + 512 + col) = w2; }
                else *(f32x4*)(ONSA + m * 512 + col) = o; } }
    }
}

#ifndef PROBE_A
#define PROBE_A -1
#endif
#define SUBSTAMP(k) do { if (PROBE_A >= 0 && blockIdx.x == 0 && threadIdx.x == 256) ((volatile LAS unsigned long long*)(plds - 4 * 4096 + (MISC_OFF + 128) / 4))[k] = __builtin_amdgcn_s_memrealtime(); } while (0)
DI void nsa_cmp_slc(const bf16* __restrict__ Q, const bf16* __restrict__ KCB, const bf16* __restrict__ VCBT, const bf16* __restrict__ KSL, const bf16* __restrict__ VSLT,
                    const float* __restrict__ gq, const float* __restrict__ gkc, const float* __restrict__ gks,
                    const bf16* __restrict__ PROJ1, float* __restrict__ ONSA, bf16* __restrict__ MIXED, LAS unsigned char* lds, int w, int gw, int NGW, int lane) {
    LAS float* plds = (LAS float*)(lds + w * 16384);
    const int r = lane & 15, quad = lane >> 4; const float sc2 = 0.125f * LOG2E;
    const float gqm = wave_max_abs64(gq, lane); const float c2c = sc2 * 64.f * gqm * wave_max_abs64(gkc, lane), c2s = sc2 * 64.f * gqm * wave_max_abs64(gks, lane);
    for (int wu = gw; wu < BATCH * 2 * 256; wu += NGW) { const int tile = bal_tile(wu), hk = (wu >> 8) & 1, b = wu >> 9, t0 = tile * 16, tok = t0 + r;
        bf16x8 qf[4][2]; load_q(qf, Q, b, hk, t0, r, quad);
        const size_t m = (size_t)b * T + tok;
        LAS unsigned char* ring = (LAS unsigned char*)plds; LAS float* imain = plds + 2048; LAS float* icarry = plds + 3072;
#pragma unroll
        for (int i = 0; i < 8; ++i) *(LAS f32x4*)(imain + (i * 64 + lane) * 4) = (f32x4){0.f, 0.f, 0.f, 0.f};
        const bf16* Kc = KCB + (size_t)(b * 2 + hk) * 256 * 64; const bf16* Vc = VCBT + (size_t)(b * 2 + hk) * 64 * 256;
        const int nsteps = ((t0 >> 4) + 31) >> 5;
        f32x4 accl[4];
#pragma unroll
        for (int g = 0; g < 4; ++g) accl[g] = (f32x4){0.f, 0.f, 0.f, 0.f};
        VM_WAIT(0);
        if (nsteps > 0) k_dma(ring, Kc, 0, r, quad);
        for (int st = 0; st < nsteps; ++st) { const int kb = 32 * st; KVF cur;
            VM_WAIT(0); k_read(cur, ring, lane); LDS_WAIT();
            if (st + 1 < nsteps) k_dma(ring, Kc, kb + 32, r, quad);
            unsigned vm = 0u;
#pragma unroll
            for (int jj = 0; jj < 8; ++jj) if (16 * (kb + 8 * quad + jj) + 31 <= tok) vm |= 1u << jj;
            f32x4 blo, bhi; mask_bias(vm, c2c, blo, bhi); const bf16x8 ones = ones_frag();
#pragma unroll
            for (int g = 0; g < 4; ++g) { f32x4 s0, s1; scores8(cur, qf[g], blo, bhi, s0, s1); float p[8];
#pragma unroll
                for (int jj = 0; jj < 4; ++jj) { p[jj] = __builtin_amdgcn_exp2f(s0[jj]); p[4 + jj] = __builtin_amdgcn_exp2f(s1[jj]); }
                accl[g] = mfma16(ones, __builtin_bit_cast(bf16x8, pack8(p)), accl[g]); } }
        float invl[4];
#pragma unroll
        for (int g = 0; g < 4; ++g) { const float l = accl[g][0]; invl[g] = l > 0.f ? 1.f / l : 0.f; }
        f32x4 acc[4][4];
#pragma unroll
        for (int g = 0; g < 4; ++g)
#pragma unroll
            for (int dt = 0; dt < 4; ++dt) acc[g][dt] = (f32x4){0.f, 0.f, 0.f, 0.f};
        if (nsteps > 0) kv_dma(ring, Kc, Vc, 0, r, quad);
        for (int st = 0; st < nsteps; ++st) { const int kb = 32 * st; KVF cur;
            VM_WAIT(0); kv_read(cur, ring, lane); LDS_WAIT();
            if (st + 1 < nsteps) kv_dma(ring, Kc, Vc, kb + 32, r, quad);
            unsigned vm = 0u;
#pragma unroll
            for (int jj = 0; jj < 8; ++jj) if (16 * (kb + 8 * quad + jj) + 31 <= tok) vm |= 1u << jj;
            f32x4 blo, bhi; mask_bias(vm, c2c, blo, bhi);
            float ps[8];
#pragma unroll
            for (int jj = 0; jj < 8; ++jj) ps[jj] = 0.f;
#pragma unroll
            for (int g = 0; g < 4; ++g) { f32x4 s0, s1; scores8(cur, qf[g], blo, bhi, s0, s1); float p[8];
#pragma unroll
                for (int jj = 0; jj < 4; ++jj) { p[jj] = __builtin_amdgcn_exp2f(s0[jj]) * invl[g]; p[4 + jj] = __builtin_amdgcn_exp2f(s1[jj]) * invl[g]; }
#pragma unroll
                for (int jj = 0; jj < 8; ++jj) ps[jj] += p[jj];
                const bf16x8 pf = __builtin_bit_cast(bf16x8, pack8(p));
#pragma unroll
                for (int dt = 0; dt < 4; ++dt) acc[g][dt] = mfma16(cur.v[dt], pf, acc[g][dt]); }
            const int j0 = (kb >> 2) + 2 * quad;
            f32x2_t mv; mv.x = 2.f * (ps[0] + ps[1] + ps[2]) + ps[3]; mv.y = ps[3] + 2.f * (ps[4] + ps[5] + ps[6]) + ps[7];
            *(LAS f32x2_t*)(imain + r * 64 + j0) = mv;
            if (j0 + 2 < 64) icarry[r * 64 + j0 + 2] = ps[7]; }
#pragma unroll
        for (int g = 0; g < 4; ++g) { const float gate0 = 1.f / (1.f + __expf(-__builtin_bit_cast(float, ((unsigned)PROJ1[m * N1P + C1_NG + hk * 12 + g * 3]) << 16)));
#pragma unroll
            for (int dt = 0; dt < 4; ++dt) { float* op = ONSA + m * 512 + (hk * 4 + g) * 64 + dt * 16 + 4 * quad; *(f32x4*)op = *(const f32x4*)op + acc[g][dt] * gate0; } }
        LDS_WAIT(); asm volatile("" ::: "memory"); __builtin_amdgcn_wave_barrier();
        unsigned long long mymask = 0ull, uni = 0ull;
        for (int tk = 0; tk < 16; ++tk) { const int tblk = (t0 + tk) >> 6, j = lane;
            const float imp = imain[tk * 64 + j] + icarry[tk * 64 + j];
            const bool forced = (j == 0) || (j == tblk) || (j == tblk - 1), allowed = j <= tblk;
            const float score = forced ? 1e9f : (allowed ? imp : -1e9f);
            unsigned u = __builtin_bit_cast(unsigned, score); u = (u & 0x80000000u) ? ~u : (u | 0x80000000u);
            const unsigned key = (u & ~63u) | (unsigned)(63 - j);
            unsigned prefix = 0u;
#pragma unroll
            for (int bit = 31; bit >= 0; --bit) { const unsigned cand = prefix | (1u << bit); const unsigned long long ge = __ballot(key >= cand); if (__builtin_popcountll(ge) >= 16) prefix = cand; }
            const unsigned long long mask = __ballot((key >= prefix) && allowed);
            if (r == tk) mymask = mask;
            uni |= mask; }
#pragma unroll
        for (int g = 0; g < 4; ++g) { accl[g] = (f32x4){0.f, 0.f, 0.f, 0.f};
#pragma unroll
            for (int dt = 0; dt < 4; ++dt) acc[g][dt] = (f32x4){0.f, 0.f, 0.f, 0.f}; }
        const bf16* Kb = KSL + (size_t)(b * 2 + hk) * T * 64; const bf16* VTb = VSLT + (size_t)(b * 2 + hk) * 64 * T;
        {   LAS unsigned long long* xu = (LAS unsigned long long*)(lds + LDSCTL_OFF + 2048);
            if (lane == 0) xu[w] = uni;
            VM_WAIT(0); LDS_WAIT();
            __syncthreads();
            unsigned long long wgu = 0ull;
#pragma unroll
            for (int i = 0; i < 8; ++i) wgu |= xu[i];
            constexpr int NB = 4;
            const int n = __builtin_popcountll(wgu); unsigned long long remi = wgu, remc = wgu;
            const bf16* src0 = (w < 4) ? Kb + w * 512 + lane * 8 : VTb + (w - 4) * 512 + r * 32 + quad * 8;
            auto blk_dma = [&](int bufi, int j) { LAS unsigned char* bp = lds + bufi * 16384 + w * 1024;
                glds16(src0 + (size_t)(2 * j) * 2048, bp); glds16(src0 + (size_t)(2 * j + 1) * 2048, bp + 8192); };
            for (int k = 0; k < NB - 1 && k < n; ++k) { const int j = __builtin_ctzll(remi); remi &= remi - 1ull; blk_dma(k, j); }
            for (int i = 0; i < n; ++i) { const int left = n - 1 - i;
                if (left >= 2) VM_WAIT(4); else if (left == 1) VM_WAIT(2); else VM_WAIT(0);
                __syncthreads();
                if (i + NB - 1 < n) { const int j2 = __builtin_ctzll(remi); remi &= remi - 1ull; blk_dma((i + NB - 1) % NB, j2); }
                const int j = __builtin_ctzll(remc); remc &= remc - 1ull;
                if ((uni >> j) & 1ull) { const bool sb = (mymask >> j) & 1ull; const LAS unsigned char* bp = lds + (i % NB) * 16384;
#pragma unroll
                    for (int hf = 0; hf < 2; ++hf) { KVF cur; kv_read(cur, bp + hf * 8192, lane); LDS_WAIT();
                        const int kb = 64 * j + 32 * hf; unsigned vm = 0u;
#pragma unroll
                        for (int jj = 0; jj < 8; ++jj) if (sb && (kb + 8 * quad + jj <= tok)) vm |= 1u << jj;
                        attn_compute(cur, vm, qf, acc, accl, c2s); } } }
            __syncthreads();
        }
#pragma unroll
        for (int g = 0; g < 4; ++g) { const float l = accl[g][0]; const float gate1 = 1.f / (1.f + __expf(-__builtin_bit_cast(float, ((unsigned)PROJ1[m * N1P + C1_NG + hk * 12 + g * 3 + 1]) << 16)));
            const float inv = (l > 0.f ? 1.f / l : 0.f) * gate1;
#pragma unroll
            for (int dt = 0; dt < 4; ++dt) { const int col = (hk * 4 + g) * 64 + dt * 16 + 4 * quad; const f32x4 o = *(const f32x4*)(ONSA + m * 512 + col) + acc[g][dt] * inv;
                v2u w2; w2.x = pk2(o[0], o[1]); w2.y = pk2(o[2], o[3]); *(v2u*)(MIXED + m * 1024 + 512 + col) = w2; } }
        __builtin_amdgcn_wave_barrier();
    }
}
DI float gelu_tanh(float x) { const float u = 0.7978845608028654f * (x + 0.044715f * x * x * x); const float e = __expf(2.f * u); const float th = 1.f - 2.f / (e + 1.f); return 0.5f * x * (1.f + th); }
DI void cmp_layer2(const float* __restrict__ CMPH, const bf16* __restrict__ W2T, const float* __restrict__ b2k, const float* __restrict__ b2v,
                   const float* __restrict__ kcnorm, const float* __restrict__ rope1, bf16* __restrict__ KCB, bf16* __restrict__ VCBT, int u0, int u1, int ustep, int lane) {
    const int r = lane & 15, quad = lane >> 4;
    for (int wu = u0; wu < u1; wu += ustep) { const int kv = wu >> 7, rt = wu & 127;
        const float* hp = CMPH + ((size_t)kv * 2048 + rt * 16 + r) * 256 + quad * 8; const bf16* wp = W2T + (size_t)kv * 64 * 256 + (size_t)r * 256 + quad * 8;
        f32x4 acc[4];
#pragma unroll
        for (int nt = 0; nt < 4; ++nt) acc[nt] = (f32x4){0.f, 0.f, 0.f, 0.f};
        f32x4 hv[16];
#pragma unroll
        for (int kk = 0; kk < 8; ++kk) { hv[2 * kk] = *(const f32x4*)(hp + kk * 32); hv[2 * kk + 1] = *(const f32x4*)(hp + kk * 32 + 4); }
#pragma unroll
        for (int kk = 0; kk < 8; ++kk) { bf16x8 wf[4];
#pragma unroll
            for (int nt = 0; nt < 4; ++nt) wf[nt] = ldg16(wp + (size_t)nt * 16 * 256 + kk * 32);
            float ge[8];
#pragma unroll
            for (int i = 0; i < 4; ++i) { ge[i] = gelu_tanh(hv[2 * kk][i]); ge[4 + i] = gelu_tanh(hv[2 * kk + 1][i]); }
            const bf16x8 af = __builtin_bit_cast(bf16x8, pack8(ge));
#pragma unroll
            for (int nt = 0; nt < 4; ++nt) acc[nt] = mfma16(af, wf[nt], acc[nt]); }
        const float* b2 = kv ? b2v : b2k;
#pragma unroll
        for (int nt = 0; nt < 4; ++nt) { const float bb = b2[nt * 16 + r]; acc[nt] = acc[nt] + bb; }
#pragma unroll
        for (int i = 0; i < 4; ++i) { const int row = rt * 16 + 4 * quad + i, bh = row >> 8, n = row & 255; const bool pad = (n == 255);
            if (kv == 0) { float ss = 0.f;
#pragma unroll
                for (int nt = 0; nt < 4; ++nt) ss += acc[nt][i] * acc[nt][i];
                ss = sum16(ss); const float rstd = 1.f / sqrtf(ss * (1.f / 64.f) + EPS);
                float y[4];
#pragma unroll
                for (int nt = 0; nt < 4; ++nt) y[nt] = acc[nt][i] * rstd * kcnorm[nt * 16 + r];
                const float other = dppf<0x128>(y[0]);
                const float* cs = rope1 + ((size_t)(bh >> 1) * T + (pad ? 0 : 16 * n + 31)) * 16;
                y[0] = (r < 8) ? y[0] * cs[r] - other * cs[8 + r] : y[0] * cs[r - 8] + other * cs[r];
#pragma unroll
                for (int nt = 0; nt < 4; ++nt) { const int d = nt * 16 + r; KCB[(size_t)bh * 256 * 64 + kblk_off(n, d & ~7) + (d & 7)] = pad ? (bf16)0 : (bf16)f2bf(y[nt]); }
            } else {
#pragma unroll
                for (int nt = 0; nt < 4; ++nt) VCBT[(((size_t)bh * 8 + (n >> 5)) * 64 + nt * 16 + r) * 32 + (n & 31)] = pad ? (bf16)0 : (bf16)f2bf(acc[nt][i]);
            } }
    }
}

DI void prep0_swa(const bf16* __restrict__ PROJ, const float* __restrict__ qn, const float* __restrict__ kn, const float* __restrict__ rope1,
                  bf16* __restrict__ QS, bf16* __restrict__ KS, bf16* __restrict__ VST, int lane, int w, int bid, int G) {
    for (int grp = bid; grp < M / 64; grp += G) { const int m0 = grp * 64, b = m0 / T, t0 = m0 % T;
#pragma unroll
        for (int i = 0; i < 8; ++i) { const int tl = 8 * w + i; const size_t m = (size_t)m0 + tl;
            q8_token(PROJ + m * N0P + C0_SQ, qn, rope1 + m * 16, QS + ((size_t)(b * 8) * T + t0 + tl) * 64, (size_t)T * 64, lane); }
#pragma unroll
        for (int p = 0; p < 2; ++p) { const int tl = 8 * w + 4 * p + (lane >> 4), head = (lane >> 3) & 1, sub = lane & 7; const size_t m = (size_t)m0 + tl; float x[8];
            unpack8(*(const v4u*)(PROJ + m * N0P + C0_SK + head * 64 + sub * 8), x); head_norm_rope(x, kn, sub, rope1 + m * 16);
            *(v4u*)(KS + (size_t)(b * 2 + head) * T * 64 + kblk_off(t0 + tl, sub * 8)) = pack8(x); }
        { const size_t m = (size_t)m0 + lane; const v4u a = *(const v4u*)(PROJ + m * N0P + C0_SV + 16 * w), c = *(const v4u*)(PROJ + m * N0P + C0_SV + 16 * w + 8);
            const unsigned wv[8] = {a.x, a.y, a.z, a.w, c.x, c.y, c.z, c.w};
#pragma unroll
            for (int i = 0; i < 16; ++i) { const int hd = 16 * w + i; VST[(((size_t)(b * 2 + (hd >> 6)) * (T / 32) + ((t0 + lane) >> 5)) * 64 + (hd & 63)) * 32 + ((t0 + lane) & 31)] = (bf16)((i & 1) ? (wv[i >> 1] >> 16) : (wv[i >> 1] & 0xffffu)); } }
    }
}
DI void prep1_nsa(const bf16* __restrict__ PROJ, const float* __restrict__ qn, const float* __restrict__ ksn, const float* __restrict__ kwn, const float* __restrict__ rope1,
                  bf16* __restrict__ QS, bf16* __restrict__ KS, bf16* __restrict__ KW, bf16* __restrict__ KCR, bf16* __restrict__ VCR, bf16* __restrict__ VST, bf16* __restrict__ VWT,
                  int lane, int w, int bid, int G) {
    for (int grp = bid; grp < M / 64; grp += G) { const int m0 = grp * 64, b = m0 / T, t0 = m0 % T;
#pragma unroll
        for (int i = 0; i < 8; ++i) { const int tl = 8 * w + i; const size_t m = (size_t)m0 + tl;
            q8_token(PROJ + m * N1P + C1_NQ, qn, rope1 + m * 16, QS + ((size_t)(b * 8) * T + t0 + tl) * 64, (size_t)T * 64, lane); }
#pragma unroll
        for (int p = 0; p < 2; ++p) { const int tl = 8 * w + 4 * p + (lane >> 4), head = (lane >> 3) & 1, sub = lane & 7; const size_t m = (size_t)m0 + tl; float x[8];
            const size_t dsto = ((size_t)(b * 2 + head) * T + t0 + tl) * 64 + sub * 8, dstk = (size_t)(b * 2 + head) * T * 64 + kblk_off(t0 + tl, sub * 8);
            unpack8(*(const v4u*)(PROJ + m * N1P + C1_KSL + head * 64 + sub * 8), x); head_norm_rope(x, ksn, sub, rope1 + m * 16); *(v4u*)(KS + dstk) = pack8(x);
            unpack8(*(const v4u*)(PROJ + m * N1P + C1_KWN + head * 64 + sub * 8), x); head_norm_rope(x, kwn, sub, rope1 + m * 16); *(v4u*)(KW + dstk) = pack8(x);
            *(v4u*)(KCR + dsto) = *(const v4u*)(PROJ + m * N1P + C1_KC + head * 64 + sub * 8);
            *(v4u*)(VCR + dsto) = *(const v4u*)(PROJ + m * N1P + C1_VC + head * 64 + sub * 8); }
#pragma unroll
        for (int which = 0; which < 2; ++which) { const size_t m = (size_t)m0 + lane; const int cbase = which ? C1_VWN : C1_VSL; bf16* dst = which ? VWT : VST;
            const v4u a = *(const v4u*)(PROJ + m * N1P + cbase + 16 * w), c = *(const v4u*)(PROJ + m * N1P + cbase + 16 * w + 8);
            const unsigned wv[8] = {a.x, a.y, a.z, a.w, c.x, c.y, c.z, c.w};
#pragma unroll
            for (int i = 0; i < 16; ++i) { const int hd = 16 * w + i; dst[(((size_t)(b * 2 + (hd >> 6)) * (T / 32) + ((t0 + lane) >> 5)) * 64 + (hd & 63)) * 32 + ((t0 + lane) & 31)] = (bf16)((i & 1) ? (wv[i >> 1] >> 16) : (wv[i >> 1] & 0xffffu)); } }
    }
}

DI void moe_route(const float* __restrict__ H, const float* __restrict__ gln, const float* __restrict__ rw, const float* __restrict__ rb, bf16* __restrict__ XN,
                  int* __restrict__ TOKE, float* __restrict__ TOKW, int* __restrict__ TOKR, unsigned* CNT, LAS unsigned char* lds, int tid, int lane, int w, int bid, int G) {
    LAS unsigned* lcnt = (LAS unsigned*)lds; LAS int* le = (LAS int*)(lds + 64); LAS int* lr = (LAS int*)(lds + 64 + 512);
    for (int blk = bid; blk < M / 64; blk += G) {
        if (tid < 16) lcnt[tid] = 0u;
        __syncthreads();
#pragma unroll 1
        for (int hb = 0; hb < 2; ++hb) {
        f32x4 vv[4][4];
#pragma unroll
        for (int i = 0; i < 4; ++i) { const f32x4* xr = (const f32x4*)(H + ((size_t)blk * 64 + 8 * w + 4 * hb + i) * D) + lane;
#pragma unroll
            for (int j = 0; j < 4; ++j) vv[i][j] = xr[64 * j]; }
#pragma unroll
        for (int i = 0; i < 4; ++i) { const int rl = 8 * w + 4 * hb + i; const size_t m = (size_t)blk * 64 + rl; float s = 0.f;
#pragma unroll
            for (int j = 0; j < 4; ++j) s += (vv[i][j].x * vv[i][j].x + vv[i][j].y * vv[i][j].y) + (vv[i][j].z * vv[i][j].z + vv[i][j].w * vv[i][j].w);
            const float rstd = 1.f / sqrtf(wave_sum(s) * (1.f / D) + EPS);
            unsigned long long* o8 = (unsigned long long*)(XN + m * D) + lane;
            float lg[8];
#pragma unroll
            for (int e = 0; e < 8; ++e) lg[e] = 0.f;
#pragma unroll
            for (int j = 0; j < 4; ++j) { const f32x4 v = vv[i][j]; o8[64 * j] = (unsigned long long)pk2(v.x * rstd, v.y * rstd) | ((unsigned long long)pk2(v.z * rstd, v.w * rstd) << 32);
#pragma unroll
                for (int c = 0; c < 4; ++c) { const int col = (lane + 64 * j) * 4 + c; const float x = v[c] * rstd * gln[col]; const f32x4* wr = (const f32x4*)(rw + (size_t)col * 8); const f32x4 a = wr[0], bq = wr[1];
                    lg[0] += x * a[0]; lg[1] += x * a[1]; lg[2] += x * a[2]; lg[3] += x * a[3]; lg[4] += x * bq[0]; lg[5] += x * bq[1]; lg[6] += x * bq[2]; lg[7] += x * bq[3]; } }
#pragma unroll
            for (int e = 0; e < 8; ++e) lg[e] = wave_sum(lg[e]) + rb[e];
            if (lane == 0) { float v1 = lg[0]; int e1 = 0;
#pragma unroll
                for (int e = 1; e < 8; ++e) if (lg[e] > v1) { v1 = lg[e]; e1 = e; }
                float v2 = -3.0e38f; int e2 = 0;
#pragma unroll
                for (int e = 0; e < 8; ++e) if (e != e1 && lg[e] > v2) { v2 = lg[e]; e2 = e; }
                const float w1 = 1.f / (1.f + expf(v2 - v1));
                TOKE[2 * m] = e1; TOKE[2 * m + 1] = e2; TOKW[2 * m] = w1; TOKW[2 * m + 1] = 1.f - w1;
                le[2 * rl] = e1; le[2 * rl + 1] = e2; lr[2 * rl] = (int)atomicAdd((unsigned*)&lcnt[e1], 1u); lr[2 * rl + 1] = (int)atomicAdd((unsigned*)&lcnt[e2], 1u); }
        }
        }
        __syncthreads();
        if (tid < 8) lcnt[8 + tid] = __hip_atomic_fetch_add(CNT + tid, lcnt[tid], __ATOMIC_RELAXED, __HIP_MEMORY_SCOPE_AGENT);
        __syncthreads();
        if (tid < 128) { const size_t m = (size_t)blk * 64 + (tid >> 1); TOKR[2 * m + (tid & 1)] = lr[tid] + (int)lcnt[8 + le[tid]]; }
        __syncthreads();
    }
}
DI void moe_dispatch(unsigned* CNT, const bf16* __restrict__ XN, const int* __restrict__ TOKE, const int* __restrict__ TOKR, int* __restrict__ TOKS, bf16* __restrict__ XS,
                     int* __restrict__ TILEE, unsigned* NTW, LAS unsigned char* lds, int tid, int lane, int w, int bid, int G) {
    LAS int* lbase = (LAS int*)lds;
    if (tid == 0) { int acc = 0;
        for (int e = 0; e < 8; ++e) { const int c = (int)__hip_atomic_load(CNT + e, __ATOMIC_RELAXED, __HIP_MEMORY_SCOPE_AGENT); lbase[e] = acc; lbase[16 + e] = c; acc += (c + 255) & ~255; }
        lbase[8] = acc; }
    __syncthreads();
    const int ntiles = lbase[8] >> 8;
    if (bid == 0) { for (int t = tid; t < ntiles; t += 512) { int e = 0;
#pragma unroll
            for (int k = 1; k < 8; ++k) if (t * 256 >= lbase[k]) e = k;
            TILEE[t] = e; }
        if (tid == 0) *NTW = (unsigned)ntiles; }
    const int gw = bid * NWAVES + w, NGW = G * NWAVES;
    for (int m0 = gw; m0 < M; m0 += 2 * NGW) {
        int slot[2][2]; v4u va[2][2]; bool ok[2];
#pragma unroll
        for (int q = 0; q < 2; ++q) { const int m = m0 + q * NGW; ok[q] = m < M; const int mm = ok[q] ? m : m0;
            const v4u* src = (const v4u*)(XN + (size_t)mm * D) + lane; va[q][0] = src[0]; va[q][1] = src[64];
#pragma unroll
            for (int k = 0; k < 2; ++k) slot[q][k] = lbase[TOKE[2 * mm + k]] + TOKR[2 * mm + k]; }
#pragma unroll
        for (int q = 0; q < 2; ++q) if (ok[q]) { const int m = m0 + q * NGW;
#pragma unroll
            for (int k = 0; k < 2; ++k) { if (lane == 0) TOKS[2 * m + k] = slot[q][k];
                v4u* dst = (v4u*)(XS + (size_t)slot[q][k] * D) + lane; dst[0] = va[q][0]; dst[64] = va[q][1]; } } }
    for (int e = 0; e < 8; ++e) { const int lo = lbase[e] + lbase[16 + e], hi = lbase[e + 1];
        for (int row = lo + gw; row < hi; row += NGW) { v4u* dst = (v4u*)(XS + (size_t)row * D) + lane; dst[0] = (v4u){0u, 0u, 0u, 0u}; dst[64] = (v4u){0u, 0u, 0u, 0u}; } }
}
DI void moe_combine(float* __restrict__ OUT, const bf16* __restrict__ Y, const bf16* __restrict__ PART, const int* __restrict__ TOKS, const float* __restrict__ TOKW, int gw, int NGW, int lane) {
    constexpr int OVR = 2 * HALFTILES * 256;
    for (int m0 = gw; m0 < M; m0 += 2 * NGW) {
        int sl[2][2]; float wt[2][2]; bool ok[2];
#pragma unroll
        for (int q = 0; q < 2; ++q) { const int m = m0 + q * NGW; ok[q] = m < M; const int mm = ok[q] ? m : m0; sl[q][0] = TOKS[2 * mm]; sl[q][1] = TOKS[2 * mm + 1]; wt[q][0] = TOKW[2 * mm]; wt[q][1] = TOKW[2 * mm + 1]; }
        v2u ya[2][2][4]; f32x4 o[2][4];
#pragma unroll
        for (int q = 0; q < 2; ++q) { const int m = ok[q] ? m0 + q * NGW : m0;
#pragma unroll
            for (int j = 0; j < 4; ++j) { const int col = lane * 4 + 256 * j; o[q][j] = *(const f32x4*)(OUT + (size_t)m * D + col);
#pragma unroll
                for (int k = 0; k < 2; ++k) { const int s_ = sl[q][k];
                    if (s_ < OVR) ya[q][k][j] = *(const v2u*)(Y + (size_t)s_ * D + col);
                    else { float y0 = 0.f, y1 = 0.f, y2 = 0.f, y3 = 0.f;
                        for (int ks = 0; ks < NSPLIT; ++ks) { const v2u a = *(const v2u*)(PART + ((size_t)ks * 8 * 256 + (s_ - OVR)) * D + col); y0 += bflo(a.x); y1 += bfhi(a.x); y2 += bflo(a.y); y3 += bfhi(a.y); }
                        ya[q][k][j].x = pk2(y0, y1); ya[q][k][j].y = pk2(y2, y3); } } } }
#pragma unroll
        for (int q = 0; q < 2; ++q) if (ok[q]) { const int m = m0 + q * NGW;
#pragma unroll
            for (int j = 0; j < 4; ++j) { const int col = lane * 4 + 256 * j; f32x4 r_ = o[q][j];
#pragma unroll
                for (int k = 0; k < 2; ++k) { const v2u a = ya[q][k][j]; const float w_ = wt[q][k]; r_[0] += w_ * bflo(a.x); r_[1] += w_ * bfhi(a.x); r_[2] += w_ * bflo(a.y); r_[3] += w_ * bfhi(a.y); }
                *(f32x4*)(OUT + (size_t)m * D + col) = r_; } }
    }
}

#ifndef ONE_LAUNCH
#define ONE_LAUNCH 1
#endif
#ifndef STOP_PHASE
#define STOP_PHASE 23
#endif
constexpr int NPHASE = 23;
#ifndef EARLY1
#define EARLY1 640
#endif
#ifndef EARLY2
#define EARLY2 1280
#endif
#ifndef DUP_MASK
#define DUP_MASK 0u
#endif
#define DUPN(k) (int)((DUP_MASK >> (k)) & 1u)
#define REP(k) _Pragma("unroll") for (int rep = 0; rep <= DUPN(k); ++rep)
#define REPBAR() do { if (rep) xcd_barrier(bar); } while (0)
#define REPRT(k) _Pragma("unroll 1") for (int rep = 0; rep <= DUPN(k); ++rep)
struct Args { const void* in[39]; float* out; unsigned char* ws; int ph_lo, ph_hi; };

__global__ void __launch_bounds__(NWAVES * 64, 2) hybrid_fwd(Args args) {
    extern __shared__ __attribute__((aligned(16))) unsigned char lds_raw[];
    LAS unsigned char* lds = (LAS unsigned char*)lds_raw;
    const int tid = threadIdx.x, lane = tid & 63, w = __builtin_amdgcn_readfirstlane(tid >> 6);
    const int G = gridDim.x, bid = blockIdx.x;
    const int gw = bid * NWAVES + w, NGW = G * NWAVES, gtid = bid * (NWAVES * 64) + tid, NTH = G * NWAVES * 64;
    unsigned char* ws = args.ws;
    unsigned* CTL = (unsigned*)(ws + WS_CTL);
    for (int u = tid; u < (LDS_BYTES - LDSCTL_OFF) / 4; u += NWAVES * 64) ((LAS unsigned*)(lds + LDSCTL_OFF))[u] = 0u;
    __syncthreads();
    XcdBarrier bar; bar.bar = CTL + CW_BAR; bar.x = 0; bar.st = nullptr;
    if (ONE_LAUNCH) bar = xcd_barrier_post(CTL + CW_BAR, (volatile LAS unsigned*)(lds + MISC_OFF) + 8);
    const int lo = args.ph_lo, hi = args.ph_hi < STOP_PHASE ? args.ph_hi : STOP_PHASE;
#define IN(k) (lo <= (k) && (k) < hi)
#ifndef PROBE_A
#define PROBE_A -1
#endif
#ifndef PROBE_B
#define PROBE_B -1
#endif
#ifndef PROBE_AE
#define PROBE_AE (PROBE_A + 1)
#endif
#ifndef PROBE_BE
#define PROBE_BE (PROBE_B + 1)
#endif
    volatile LAS unsigned long long* stamps = (volatile LAS unsigned long long*)(lds + MISC_OFF + 128);
#define STAMP(k) do { if (PROBE_A >= 0 && bid == 0 && tid == 0) stamps[k] = __builtin_amdgcn_s_memrealtime(); } while (0)
#define SEAM(k) do { if (ONE_LAUNCH && IN(k) && IN((k) + 1)) xcd_barrier(bar); STAMP((k) + 1); } while (0)
    STAMP(0);

    const float* x = (const float*)args.in[0]; const int* positions = (const int*)args.in[1];
    const float* ln_mix_e = (const float*)args.in[2]; const float* w_in_e = (const float*)args.in[3];
    const float* gla_gate_up = (const float*)args.in[4]; const float* gla_gate_bias = (const float*)args.in[5]; const float* gla_out_norm = (const float*)args.in[6];
    const float* swa_q_norm = (const float*)args.in[7]; const float* swa_k_norm = (const float*)args.in[8]; const float* swa_sinks = (const float*)args.in[9];
    const float* w_out_e = (const float*)args.in[10]; const float* ln_ffn_e = (const float*)args.in[11];
    const float* ffn_w_gate = (const float*)args.in[12]; const float* ffn_w_up = (const float*)args.in[13]; const float* ffn_w_down = (const float*)args.in[14];
    const float* ln_mix_o = (const float*)args.in[15]; const float* w_in_o = (const float*)args.in[16]; const float* ret_out_norm = (const float*)args.in[17];
    const float* nsa_q_norm = (const float*)args.in[18]; const float* nsa_kc_norm = (const float*)args.in[19]; const float* nsa_ks_norm = (const float*)args.in[20]; const float* nsa_kw_norm = (const float*)args.in[21];
    const float* cmp_pos_k = (const float*)args.in[22]; const float* cmp_w1_k = (const float*)args.in[23]; const float* cmp_b1_k = (const float*)args.in[24]; const float* cmp_w2_k = (const float*)args.in[25]; const float* cmp_b2_k = (const float*)args.in[26];
    const float* cmp_pos_v = (const float*)args.in[27]; const float* cmp_w1_v = (const float*)args.in[28]; const float* cmp_b1_v = (const float*)args.in[29]; const float* cmp_w2_v = (const float*)args.in[30]; const float* cmp_b2_v = (const float*)args.in[31];
    const float* w_out_o = (const float*)args.in[32]; const float* ln_ffn_o = (const float*)args.in[33]; const float* router_w = (const float*)args.in[34]; const float* router_b = (const float*)args.in[35];
    const float* exp_w_gate = (const float*)args.in[36]; const float* exp_w_up = (const float*)args.in[37]; const float* exp_w_down = (const float*)args.in[38];
    float* out = args.out;
    float* ROPE1 = (float*)(ws + WS_ROPE1); float* ROPE2 = (float*)(ws + WS_ROPE2);
    bf16* WIN0 = (bf16*)(ws + WS_WIN0); bf16* WOUT0 = (bf16*)(ws + WS_WOUT0); bf16* WGU = (bf16*)(ws + WS_WGU); bf16* WDN = (bf16*)(ws + WS_WDN);
    bf16* WIN1 = (bf16*)(ws + WS_WIN1); bf16* WOUT1 = (bf16*)(ws + WS_WOUT1); bf16* WCMP = (bf16*)(ws + WS_WCMP); bf16* MOEGU = (bf16*)(ws + WS_MOEGU); bf16* MOED = (bf16*)(ws + WS_MOED);
    bf16* XN = (bf16*)(ws + WS_XN); bf16* MIXED = XN; bf16* PROJ = (bf16*)(ws + WS_PROJ); bf16* ACT = PROJ;
    bf16* QS = (bf16*)(ws + WS_QS); bf16* KS = (bf16*)(ws + WS_KS); bf16* VST = (bf16*)(ws + WS_VST);
    bf16* QIN = (bf16*)(ws + WS_QIN); bf16* OINTRA = (bf16*)(ws + WS_OINTRA); bf16* SB = (bf16*)(ws + WS_SB); float* UT = (float*)(ws + WS_UT); float* DEC = (float*)(ws + WS_DEC);
    float* ONSA = (float*)(ws + WS_ONSA); float* CMPH = (float*)(ws + WS_CMPH);
    bf16* KCR = (bf16*)(ws + WS_KCR); bf16* VCR = (bf16*)(ws + WS_VCR); bf16* KW = (bf16*)(ws + WS_KW); bf16* VWT = (bf16*)(ws + WS_VWT);
    bf16* KCB = (bf16*)(ws + WS_CMPT + CT_KCB); bf16* VCBT = (bf16*)(ws + WS_CMPT + CT_VCBT); float* B1P = (float*)(ws + WS_CMPT + CT_B1P); bf16* W2T = (bf16*)(ws + WS_CMPT + CT_W2T);
    int* TOKE = (int*)(ws + WS_TAB + TB_TOKE); float* TOKW = (float*)(ws + WS_TAB + TB_TOKW); int* TOKR = (int*)(ws + WS_TAB + TB_TOKR); int* TOKS = (int*)(ws + WS_TAB + TB_TOKS); int* TILEE = (int*)(ws + WS_TAB + TB_TILEE);
    bf16* XS = (bf16*)(ws + WS_XS); bf16* ACTH = (bf16*)(ws + WS_ACTH); bf16* PART = (bf16*)(ws + WS_XN);
    LAS unsigned char* scr = lds + w * 16384;

    if (IN(0)) REP(0) { REPBAR();
        if (gw < 512) { const int kv = gw >> 8; cmp_bias_item(kv ? cmp_pos_v : cmp_pos_k, kv ? cmp_w1_v : cmp_w1_k, B1P + kv * 16384, (gw >> 6) & 3, gw & 63, lane); }
        conv_mat(cmp_w2_k, 256, 64, 64, W2T, 0, nullptr, scr, gw, NGW, lane);
        conv_mat(cmp_w2_v, 256, 64, 64, W2T + 64 * 256, 0, nullptr, scr, gw, NGW, lane);
        conv_mat_wg(w_in_e, D, N0, N0P, WIN0, 0, ln_mix_e, lds, lane, w, bid, G);
        conv_mat_wg(w_out_e, D, D, D, WOUT0, 0, nullptr, lds, lane, w, (bid + 80) % G, G);
        conv_mat_wg(ffn_w_gate, D, FF, FF, WGU, 1, ln_ffn_e, lds, lane, w, (bid + 112) % G, G);
        conv_mat_wg(ffn_w_up, D, FF, FF, WGU, 2, ln_ffn_e, lds, lane, w, (bid + 200) % G, G);
        conv_mat_wg(ffn_w_down, FF, D, D, WDN, 0, nullptr, lds, lane, w, (bid + 288) % G, G);
        conv_mat_wg(w_in_o, D, N1, N1P, WIN1, 0, ln_mix_o, lds, lane, w, (bid + 376) % G, G);
        conv_mat_wg(w_out_o, D, D, D, WOUT1, 0, nullptr, lds, lane, w, (bid + 472) % G, G);
        conv_mat_wg(cmp_w1_k, 2048, 256, 256, WCMP, 0, nullptr, lds, lane, w, (bid + 504) % G, G);
        conv_mat_wg(cmp_w1_v, 2048, 256, 256, WCMP + 256 * 2048, 0, nullptr, lds, lane, w, (bid + 520) % G, G);
        rope_tables(positions, ROPE1, ROPE2, gtid, NTH);
        rms_phase(x, XN, gw, NGW, lane);
    }
    SEAM(0);
    if (IN(1)) REP(1) { REPBAR(); pg8::Gemm g{XN, WIN0, M, N0P, D, D, D}; pg8::StaticOrder S; S.init(M, N0P, G, bid); pg8::EpiBf16Plain E{PROJ, N0P};
        pg8::gemm_phase<pg8::EpiBf16Plain, pg8::StaticOrder, true, true>(lds, g, S, E);
        if (!rep && G == 256 && bid >= 128) conv_moe_tiles(exp_w_gate, exp_w_up, exp_w_down, ln_ffn_o, MOEGU, MOED, lds, lane, w, 0, EARLY1, bid - 128, 128); }
    SEAM(1);
    if (IN(2)) REPRT(2) { REPBAR();
        prep0_swa(PROJ, swa_q_norm, swa_k_norm, ROPE1, QS, KS, VST, lane, w, bid, G);
        if (PROBE_A >= 0) { __syncthreads(); STAMP(29); }
        chunk_phaseA<false>(lds, PROJ, N0P, C0_GQ, C0_GK, C0_GV, C0_GLOW, gla_gate_up, gla_gate_bias, nullptr, QIN, OINTRA, UT, DEC, lane, w, bid, G);
    }
    SEAM(2);
    if (IN(3)) REPRT(3) { REPBAR();
        if (!rep) chunk_scan(UT, DEC, SB, gtid, NTH);
        window_attn<true, true>(QS, KS, VST, 128, swa_sinks, swa_q_norm, swa_k_norm, MIXED, nullptr, nullptr, lds + w * 16384, gw, NGW, lane);
    }
    SEAM(3);
    if (IN(4)) REP(4) { REPBAR(); chunk_phaseC<false>(QIN, OINTRA, SB, PROJ, N0P, C0_GOUT, gla_out_norm, MIXED, gw, NGW, lane); }
    SEAM(4);
    if (IN(5)) REP(5) { REPBAR(); pg8::Gemm g{MIXED, WOUT0, M, D, D, D, D}; pg8::StaticOrder S; S.init(M, D, G, bid); pg8::EpiResF32 E{x, out, D};
        pg8::gemm_phase<pg8::EpiResF32, pg8::StaticOrder, true, true>(lds, g, S, E); }
    SEAM(5);
    if (IN(6)) REP(6) { REPBAR(); rms_phase(out, XN, gw, NGW, lane); }
    SEAM(6);
    if (IN(7)) REP(7) { REPBAR(); pg8::Gemm g{XN, WGU, M, 2 * FF, D, D, D}; pg8::StaticOrder S; S.init(M, 2 * FF, G, bid); pg8::EpiSwiglu E{ACT, FF};
        pg8::gemm_phase<pg8::EpiSwiglu, pg8::StaticOrder, true, true>(lds, g, S, E);
        if (!rep && G == 256 && bid >= 128) conv_moe_tiles(exp_w_gate, exp_w_up, exp_w_down, ln_ffn_o, MOEGU, MOED, lds, lane, w, EARLY1, EARLY2, bid - 128, 128); }
    SEAM(7);
    if (IN(8)) REP(8) { REPBAR(); pg8::Gemm g{ACT, WDN, M, D, FF, FF, FF}; pg8::StaticOrder S; S.init(M, D, G, bid); pg8::EpiResF32 E{out, rep ? (float*)(ws + WS_RA) : out, D};
        pg8::gemm_phase<pg8::EpiResF32, pg8::StaticOrder, true, true>(lds, g, S, E); }
    SEAM(8);
    if (IN(9)) REP(9) { REPBAR(); rms_phase(out, XN, gw, NGW, lane); }
    SEAM(9);
    if (IN(10)) REP(10) { REPBAR(); pg8::Gemm g{XN, WIN1, M, N1P, D, D, D}; pg8::StaticOrder S; S.init(M, N1P, G, bid); pg8::EpiBf16Plain E{PROJ, N1P};
        pg8::gemm_phase<pg8::EpiBf16Plain, pg8::StaticOrder, true, true>(lds, g, S, E); }
    SEAM(10);
    if (IN(11)) REPRT(11) { REPBAR();
        if (gtid < 512) { const int kv = gtid >> 8, j = gtid & 255; float bsum = (kv ? cmp_b1_v : cmp_b1_k)[j];
#pragma unroll
            for (int c = 0; c < 64; ++c) bsum += B1P[(kv * 64 + c) * 256 + j];
            B1P[32768 + gtid] = bsum; }
        prep1_nsa(PROJ, nsa_q_norm, nsa_ks_norm, nsa_kw_norm, ROPE1, QS, KS, KW, KCR, VCR, VST, VWT, lane, w, bid, G);
        if (PROBE_A >= 0) { __syncthreads(); STAMP(31); }
        chunk_phaseA<true>(lds, PROJ, N1P, C1_RQ, C1_RK, C1_RV, 0, nullptr, nullptr, ROPE2, QIN, OINTRA, UT, DEC, lane, w, bid, G);
    }
    SEAM(11);
    if (IN(12)) REPRT(12) { REPBAR();
        constexpr int NCW = 16;
        if (bid < NCW) { pg8::Gemm g{KCR, WCMP, 4096, 256, 2048, 1024, 2048}; pg8::CmpOrder S{NCW, bid}; pg8::EpiCmp E{CMPH, B1P + 32768};
            pg8::gemm_phase<pg8::EpiCmp, pg8::CmpOrder, true, true>(lds, g, S, E); }
        else { if (!rep) chunk_scan(UT, DEC, SB, gtid - NCW * NWAVES * 64, NTH - NCW * NWAVES * 64);
            window_attn<false, false>(QS, KW, VWT, 512, nullptr, nsa_q_norm, nsa_kw_norm, nullptr, ONSA, PROJ, lds + w * 16384, gw - NCW * NWAVES, NGW - NCW * NWAVES, lane); }
    }
    SEAM(12);
    if (IN(13)) REP(13) { REPBAR();
        cmp_layer2(CMPH, W2T, cmp_b2_k, cmp_b2_v, nsa_kc_norm, ROPE1, KCB, VCBT, gw, 256, NGW, lane);
        chunk_phaseC<true>(QIN, OINTRA, SB, PROJ, N1P, C1_RG, ret_out_norm, MIXED, gw, NGW, lane);
    }
    SEAM(13);
    if (IN(14)) REPRT(14) { REPBAR(); nsa_cmp_slc(QS, KCB, VCBT, KS, VST, nsa_q_norm, nsa_kc_norm, nsa_ks_norm, PROJ, rep ? (float*)OINTRA : ONSA, rep ? (bf16*)UT : MIXED, lds, w, gw, NGW, lane); }
    SEAM(14);
    if (IN(15)) REP(15) { REPBAR(); pg8::Gemm g{MIXED, WOUT1, M, D, D, D, D}; pg8::StaticOrder S; S.init(M, D, G, bid); pg8::EpiResF32 E{out, rep ? (float*)(ws + WS_RA) : out, D};
        pg8::gemm_phase<pg8::EpiResF32, pg8::StaticOrder, true, true>(lds, g, S, E); }
    SEAM(15);
    if (IN(16)) REP(16) { REPBAR();
        if (!rep) moe_route(out, ln_ffn_o, router_w, router_b, XN, TOKE, TOKW, TOKR, CTL + CW_CNT, lds + 126976, tid, lane, w, bid, G);
        conv_moe_tiles(exp_w_gate, exp_w_up, exp_w_down, ln_ffn_o, MOEGU, MOED, lds, lane, w, (G == 256) ? EARLY2 : 0, 2688, bid, G);
    }
    SEAM(16);
    if (IN(17)) REP(17) { REPBAR(); moe_dispatch(CTL + CW_CNT, XN, TOKE, TOKR, TOKS, XS, TILEE, CTL + CW_NT, lds, tid, lane, w, bid, G); }
    SEAM(17);
#pragma unroll
    for (int hf = 0; hf < 2; ++hf) {
        if (IN(18 + 2 * hf)) REP(18) { REPBAR(); const int nt = (int)__hip_atomic_load(CTL + CW_NT, __ATOMIC_RELAXED, __HIP_MEMORY_SCOPE_AGENT);
            const int t0 = hf * HALFTILES, t1 = hf ? nt : (nt < HALFTILES ? nt : HALFTILES);
            if (t1 > t0) { pg8::Gemm g{XS, MOEGU, 0, 2 * FFE, D, D, D}; pg8::MoeOrder S{TILEE, t0, t1, 2 * FFE / 256, G, bid}; pg8::EpiSwiglu E{ACTH - (size_t)t0 * 256 * FFE, FFE};
                pg8::gemm_phase<pg8::EpiSwiglu, pg8::MoeOrder, true, true>(lds, g, S, E); } }
        SEAM(18 + 2 * hf);
        if (IN(19 + 2 * hf)) REP(19) { REPBAR(); const int nt = (int)__hip_atomic_load(CTL + CW_NT, __ATOMIC_RELAXED, __HIP_MEMORY_SCOPE_AGENT);
            const int t0 = hf * HALFTILES; int t1 = hf ? nt : (nt < HALFTILES ? nt : HALFTILES); if (t1 > 2 * HALFTILES) t1 = 2 * HALFTILES;
            if (t1 > t0) { pg8::Gemm g{ACTH - (size_t)t0 * 256 * FFE, MOED, 0, D, FFE, FFE, FFE}; pg8::MoeOrder S{TILEE, t0, t1, D / 256, G, bid}; pg8::EpiBf16Plain E{XS, D};
                pg8::gemm_phase<pg8::EpiBf16Plain, pg8::MoeOrder, true, true>(lds, g, S, E); }
            if (hf && nt > 2 * HALFTILES) { pg8::Gemm g{ACTH - (size_t)t0 * 256 * FFE, MOED, 0, D, FFE / NSPLIT, FFE, FFE}; pg8::MoeSplitOrder S{TILEE, 2 * HALFTILES, nt, D / 256, NSPLIT, FFE / NSPLIT, G, (bid + 128) % G};
                pg8::EpiBf16Split E{PART - (size_t)2 * HALFTILES * 256 * D, D, (size_t)8 * 256 * D};
                pg8::gemm_phase<pg8::EpiBf16Split, pg8::MoeSplitOrder, true, true>(lds, g, S, E); } }
        SEAM(19 + 2 * hf);
    }
    if (IN(22)) REPRT(22) { REPBAR(); if (!rep) moe_combine(out, XS, PART, TOKS, TOKW, gw, NGW, lane); else moe_combine((float*)(ws + WS_ACTH), XS, PART, TOKS, TOKW, gw, NGW, lane); }
    if (PROBE_A >= 0) { __syncthreads(); STAMP(23);
        if (bid == 0 && tid == 0) { const unsigned long long da = (stamps[PROBE_AE] - stamps[PROBE_A]) / 100ull, db = (PROBE_B >= 0) ? (stamps[PROBE_BE] - stamps[PROBE_B]) / 100ull : 0ull;
            const unsigned long long wait = (da + 512ull * db) * 100ull, t0 = __builtin_amdgcn_s_memrealtime();
            while (__builtin_amdgcn_s_memrealtime() - t0 < wait) __builtin_amdgcn_s_sleep(8); } }
#undef IN
#undef SEAM
}

extern "C" void kernel_launch(void* const* d_in, const int* in_sizes, int n_in, void* d_out, int out_size, void* d_ws, size_t ws_size, hipStream_t stream) {
    static int grid = 0;
    if (grid == 0) {
        if (n_in != 39 || out_size != M * D || ws_size < WS_END) { fprintf(stderr, "kernel_launch: unexpected problem (n_in %d, out %d, ws %zu < %zu)\n", n_in, out_size, ws_size, (size_t)WS_END); grid = -1; return; }
        int dev = 0, cus = 0, per_cu = 0;
        if (hipGetDevice(&dev) != hipSuccess || hipDeviceGetAttribute(&cus, hipDeviceAttributeMultiprocessorCount, dev) != hipSuccess) { grid = -1; return; }
        if (hipFuncSetAttribute((const void*)hybrid_fwd, hipFuncAttributeMaxDynamicSharedMemorySize, LDS_BYTES) != hipSuccess) { fprintf(stderr, "kernel_launch: hipFuncSetAttribute failed\n"); grid = -1; return; }
        if (hipOccupancyMaxActiveBlocksPerMultiprocessor(&per_cu, (const void*)hybrid_fwd, NWAVES * 64, LDS_BYTES) != hipSuccess || per_cu < 1) { fprintf(stderr, "kernel_launch: occupancy query says %d\n", per_cu); }
        (void)hipGetLastError();
        grid = cus;
    }
    if (grid < 0) return;
    if (hipMemsetAsync((char*)d_ws + WS_CTL, 0, CTL_ZERO_BYTES, stream) != hipSuccess) return;
    Args a{};
    for (int i = 0; i < 39; ++i) a.in[i] = d_in[i];
    a.out = (float*)d_out; a.ws = (unsigned char*)d_ws;
#if ONE_LAUNCH
    a.ph_lo = 0; a.ph_hi = NPHASE;
    hipLaunchKernelGGL(hybrid_fwd, dim3(grid), dim3(NWAVES * 64), LDS_BYTES, stream, a);
#else
    for (int p = 0; p < NPHASE && p < STOP_PHASE; ++p) { a.ph_lo = p; a.ph_hi = p + 1; hipLaunchKernelGGL(hybrid_fwd, dim3(grid), dim3(NWAVES * 64), LDS_BYTES, stream, a); }
#endif
}
```

```cpp
#include <hip/hip_runtime.h>
#include <cstdio>
#include <cstdint>
namespace pg8 {
#define PG8_LAS __attribute__((address_space(3)))
typedef unsigned short bf16_t;
typedef short bf16x8 __attribute__((ext_vector_type(8)));
typedef float f32x4 __attribute__((ext_vector_type(4)));
typedef unsigned u32x4 __attribute__((ext_vector_type(4)));
constexpr int BM = 256, BK = 64, HALF = 128, HTB = HALF * BK * 2  , STAGE_BYTES = 8 * HTB, NXCD = 8, WGM = 8;

__host__ __device__ __forceinline__ int lds_byte(int r, int c) { const int st = (r >> 4) * 2 + (c >> 5), rr = r & 15, cc = c & 31, ob = rr * 64 + cc * 2; return st * 1024 + (ob ^ (((ob >> 9) & 1) << 5)); }
__host__ __device__ __forceinline__ void stage_rc(int b, int& R, int& C) { const int st = b / 1024, sb = b % 1024, swz = sb ^ (((sb >> 9) & 1) << 5); R = (st >> 1) * 16 + swz / 64; C = (st & 1) * 32 + (swz % 64) / 2; }
__host__ __device__ __forceinline__ int perm32(int rho) { const int n = rho >> 4, i = rho & 15; return 8 * (i >> 2) + 4 * n + (i & 3); }

struct Unit { int pm, pn, pb, ko, ks; };
struct Gemm { const bf16_t* A; const bf16_t* Bt; int M, N, K, lda, ldb; };

struct StaticOrder {
    int nM, nN, nwg, G, c;
    __host__ __device__ void init(int M, int N, int G_, int c_) { nM = M / BM; nN = N / BM; nwg = nM * nN; G = G_; c = c_; }
    __host__ __device__ bool next(int i, Unit& u) const {
        const long L = (long)i * G + c; if (L >= nwg) return false;
        int wgid = (int)L; { const int q = nwg / NXCD, r = nwg % NXCD, xcd = wgid % NXCD, off = wgid / NXCD; wgid = (xcd < r ? xcd * (q + 1) : r * (q + 1) + (xcd - r) * q) + off; }
        const int nig = WGM * nN, gid = wgid / nig, fm = gid * WGM, gsz = (nM - fm) < WGM ? (nM - fm) : WGM;
        u.pm = fm + ((wgid % nig) % gsz); u.pn = (wgid % nig) / gsz; u.pb = u.pn; u.ko = 0; u.ks = 0; return true;
    }
    __device__ __forceinline__ void a_ready(const Unit&) const {}
    __device__ __forceinline__ void done(const Unit&) const {}
};
struct MoeOrder {
    const int* tile_e; int t0, t1, nN, G, c;
    __device__ bool next(int i, Unit& u) const {
        u.ko = 0; u.ks = 0;
        if (G != 256) { const long L = (long)i * G + c; const long n = (long)(t1 - t0) * nN; if (L >= n) return false;
            u.pm = t0 + (int)(L / nN); u.pn = (int)(L % nN); u.pb = tile_e[u.pm] * nN + u.pn; return true; }
        const int ncg = nN >> 2, nsb = ((t1 - t0 + 7) >> 3) * ncg, sb = i * 8 + (c & 7), l = c >> 3;
        if (sb >= nsb) return false;
        const int rg = sb / ncg, cg = sb - rg * ncg;
        u.pm = t0 + rg * 8 + (l >> 2); if (u.pm >= t1) return false;
        u.pn = cg * 4 + (l & 3); u.pb = tile_e[u.pm] * nN + u.pn; return true;
    }
    __device__ __forceinline__ void a_ready(const Unit&) const {}
    __device__ __forceinline__ void done(const Unit&) const {}
};

__device__ __forceinline__ unsigned cvt_pk_bf16(float lo, float hi) { unsigned r; asm volatile("v_cvt_pk_bf16_f32 %0, %1, %2" : "=v"(r) : "v"(lo), "v"(hi)); return r; }

struct EpiBf16Plain {
    static constexpr bool PERM = true, AFTER_DRAIN = false;
    bf16_t* O; int ldc;
    __device__ __forceinline__ void operator()(const f32x4 (&acc)[2][2][4][2], const Unit& u, int wr, int wc, int fr, int fq) const {
        const int row0 = u.pm * BM + wr * 64 + fr, col0 = u.pn * BM + wc * 32 + 8 * fq;
#pragma unroll
        for (int ai = 0; ai < 2; ++ai)
#pragma unroll
            for (int m = 0; m < 4; ++m) { bf16_t* rowp = O + (size_t)(row0 + ai * HALF + m * 16) * ldc + col0;
#pragma unroll
                for (int bj = 0; bj < 2; ++bj) { const f32x4 v0 = acc[ai][bj][m][0], v1 = acc[ai][bj][m][1];
                    u32x4 w; w.x = cvt_pk_bf16(v0[0], v0[1]); w.y = cvt_pk_bf16(v0[2], v0[3]); w.z = cvt_pk_bf16(v1[0], v1[1]); w.w = cvt_pk_bf16(v1[2], v1[3]);
                    *(u32x4*)(rowp + bj * HALF) = w; } }
    }
};
struct MoeSplitOrder {
    const int* tile_e; int t0, t1, nN, NS, klen, G, c;
    __device__ bool next(int i, Unit& u) const {
        const long L = (long)i * G + c; const int per = nN * NS; const long n = (long)(t1 - t0) * per; if (L >= n) return false;
        const int rem = (int)(L % per); u.pm = t0 + (int)(L / per); u.pn = rem / NS; u.ks = rem % NS; u.ko = u.ks * klen * 2; u.pb = tile_e[u.pm] * nN + u.pn; return true;
    }
    __device__ __forceinline__ void a_ready(const Unit&) const {}
    __device__ __forceinline__ void done(const Unit&) const {}
};
struct EpiBf16Split {
    static constexpr bool PERM = true, AFTER_DRAIN = false;
    bf16_t* O; int ldc; size_t stride;
    __device__ __forceinline__ void operator()(const f32x4 (&acc)[2][2][4][2], const Unit& u, int wr, int wc, int fr, int fq) const {
        const int row0 = u.pm * BM + wr * 64 + fr, col0 = u.pn * BM + wc * 32 + 8 * fq; bf16_t* base = O + (size_t)u.ks * stride;
#pragma unroll
        for (int ai = 0; ai < 2; ++ai)
#pragma unroll
            for (int m = 0; m < 4; ++m) { bf16_t* rowp = base + (size_t)(row0 + ai * HALF + m * 16) * ldc + col0;
#pragma unroll
                for (int bj = 0; bj < 2; ++bj) { const f32x4 v0 = acc[ai][bj][m][0], v1 = acc[ai][bj][m][1];
                    u32x4 w; w.x = cvt_pk_bf16(v0[0], v0[1]); w.y = cvt_pk_bf16(v0[2], v0[3]); w.z = cvt_pk_bf16(v1[0], v1[1]); w.w = cvt_pk_bf16(v1[2], v1[3]);
                    *(u32x4*)(rowp + bj * HALF) = w; } }
    }
};
struct EpiResF32 {
    static constexpr bool PERM = false, AFTER_DRAIN = false;
    const float* base; float* out; int ldc;
    __device__ __forceinline__ void operator()(const f32x4 (&acc)[2][2][4][2], const Unit& u, int wr, int wc, int fr, int fq) const {
        const int row0 = u.pm * BM + wr * 64 + fr, col0 = u.pn * BM + wc * 32 + 4 * fq;
#pragma unroll
        for (int ai = 0; ai < 2; ++ai)
#pragma unroll
            for (int m = 0; m < 4; ++m) { const size_t ro = (size_t)(row0 + ai * HALF + m * 16) * ldc + col0;
#pragma unroll
                for (int bj = 0; bj < 2; ++bj)
#pragma unroll
                    for (int n = 0; n < 2; ++n) { const size_t o = ro + bj * HALF + n * 16; const f32x4 b = *(const f32x4*)(base + o); *(f32x4*)(out + o) = b + acc[ai][bj][m][n]; } }
    }
};
struct EpiResB {
    static constexpr bool PERM = true, AFTER_DRAIN = false;
    const float* basef; const bf16_t* baseb; bf16_t* out; int ldc;
    __device__ __forceinline__ void operator()(const f32x4 (&acc)[2][2][4][2], const Unit& u, int wr, int wc, int fr, int fq) const {
        const int row0 = u.pm * BM + wr * 64 + fr, col0 = u.pn * BM + wc * 32 + 8 * fq;
#pragma unroll
        for (int ai = 0; ai < 2; ++ai)
#pragma unroll
            for (int m = 0; m < 4; ++m) { const size_t ro = (size_t)(row0 + ai * HALF + m * 16) * ldc + col0;
#pragma unroll
                for (int bj = 0; bj < 2; ++bj) { f32x4 b0, b1;
                    if (basef) { b0 = *(const f32x4*)(basef + ro + bj * HALF); b1 = *(const f32x4*)(basef + ro + bj * HALF + 4); }
                    else { const u32x4 w = *(const u32x4*)(baseb + ro + bj * HALF);
                        b0 = (f32x4){__builtin_bit_cast(float, w.x << 16), __builtin_bit_cast(float, w.x & 0xffff0000u), __builtin_bit_cast(float, w.y << 16), __builtin_bit_cast(float, w.y & 0xffff0000u)};
                        b1 = (f32x4){__builtin_bit_cast(float, w.z << 16), __builtin_bit_cast(float, w.z & 0xffff0000u), __builtin_bit_cast(float, w.w << 16), __builtin_bit_cast(float, w.w & 0xffff0000u)}; }
                    const f32x4 v0 = b0 + acc[ai][bj][m][0], v1 = b1 + acc[ai][bj][m][1];
                    u32x4 o; o.x = cvt_pk_bf16(v0[0], v0[1]); o.y = cvt_pk_bf16(v0[2], v0[3]); o.z = cvt_pk_bf16(v1[0], v1[1]); o.w = cvt_pk_bf16(v1[2], v1[3]);
                    *(u32x4*)(out + ro + bj * HALF) = o; } }
    }
};
struct EpiSwiglu {
    static constexpr bool PERM = true, AFTER_DRAIN = false;
    bf16_t* O; int ldc;
    __device__ __forceinline__ void operator()(const f32x4 (&acc)[2][2][4][2], const Unit& u, int wr, int wc, int fr, int fq) const {
        const int row0 = u.pm * BM + wr * 64 + fr, col0 = u.pn * HALF + wc * 32 + 8 * fq;
#pragma unroll
        for (int ai = 0; ai < 2; ++ai)
#pragma unroll
            for (int m = 0; m < 4; ++m) { bf16_t* rowp = O + (size_t)(row0 + ai * HALF + m * 16) * ldc + col0;
                float r[8];
#pragma unroll
                for (int n = 0; n < 2; ++n)
#pragma unroll
                    for (int i = 0; i < 4; ++i) { const float g = acc[ai][0][m][n][i], up = acc[ai][1][m][n][i]; r[n * 4 + i] = g * __builtin_amdgcn_rcpf(1.0f + __expf(-g)) * up; }
                u32x4 w; w.x = cvt_pk_bf16(r[0], r[1]); w.y = cvt_pk_bf16(r[2], r[3]); w.z = cvt_pk_bf16(r[4], r[5]); w.w = cvt_pk_bf16(r[6], r[7]);
                *(u32x4*)rowp = w; }
    }
};

struct CmpOrder {
    int G, c;
    __device__ bool next(int i, Unit& u) const { const int L = i * G + c; if (L >= 16) return false; u.pm = L; u.pn = 0; u.pb = L >> 3; u.ko = 0; u.ks = 0; return true; }
    __device__ __forceinline__ void a_ready(const Unit&) const {}
    __device__ __forceinline__ void done(const Unit&) const {}
};
struct EpiCmp {
    static constexpr bool PERM = false, AFTER_DRAIN = false;
    float* C; const float* bias;
    __device__ __forceinline__ void operator()(const f32x4 (&acc)[2][2][4][2], const Unit& u, int wr, int wc, int fr, int fq) const {
        const int row0 = u.pm * BM + wr * 64 + fr, col0 = wc * 32 + 4 * fq; const float* bp = bias + u.pb * 256 + col0;
#pragma unroll
        for (int ai = 0; ai < 2; ++ai)
#pragma unroll
            for (int m = 0; m < 4; ++m) { float* rowp = C + (size_t)(row0 + ai * HALF + m * 16) * 256 + col0;
#pragma unroll
                for (int bj = 0; bj < 2; ++bj)
#pragma unroll
                    for (int n = 0; n < 2; ++n) *(f32x4*)(rowp + bj * HALF + n * 16) = acc[ai][bj][m][n] + *(const f32x4*)(bp + bj * HALF + n * 16); }
    }
};
template <class Epi, class Sched, bool ALIGN_EPI = false, bool SP2 = false>
__device__ __forceinline__ void gemm_phase(PG8_LAS unsigned char* lds, const Gemm g, const Sched& S, const Epi& E) {
    const int tid = threadIdx.x, wid = __builtin_amdgcn_readfirstlane(tid >> 6), lane = tid & 63, wr = wid >> 2, wc = wid & 3, fr = lane & 15, fq = lane >> 4;
    const int K = g.K, nt = K / BK;
    unsigned voffA[2], voffB[2];
#pragma unroll
    for (int i = 0; i < 2; ++i) { int R, C; stage_rc(tid * 16 + i * 8192, R, C); const int Rb = Epi::PERM ? ((R & ~31) + perm32(R & 31)) : R;
        voffA[i] = (unsigned)(R * g.lda + C) * 2u; voffB[i] = (unsigned)(Rb * g.ldb + C) * 2u; }
    const size_t kstep = (size_t)(BK * 2);
    const size_t hstep = (size_t)HALF * g.ldb * 2;
    const size_t tstep = 2 * hstep; const size_t hstepA = (size_t)HALF * g.lda * 2, tstepA = 2 * hstepA;
    const unsigned ldsw = (unsigned)wid * 1024u;
    const int aoff = lds_byte(wr * 64 + fr, fq * 8), boff = lds_byte(wc * 32 + fr, fq * 8);
#define PG8_SA(b, h) (((b) * 2 + (h)) * HTB)
#define PG8_SB(b, h) ((4 + (b) * 2 + (h)) * HTB)
#define PG8_STAGE(bufoff, gbase, voff) do { _Pragma("unroll") for (int _i = 0; _i < 2; ++_i) \
        __builtin_amdgcn_global_load_lds((const unsigned*)((const char*)(gbase) + (voff)[_i]), (PG8_LAS unsigned*)(lds + (bufoff) + ldsw + _i * 8192), 16, 0, 0); } while (0)
#define PG8_LDA(dst, b, h) do { _Pragma("unroll") for (int m = 0; m < 4; ++m) _Pragma("unroll") for (int k = 0; k < 2; ++k) dst[m][k] = *(const PG8_LAS bf16x8*)(lds + PG8_SA(b, h) + aoff + m * 2048 + k * 1024); } while (0)
#define PG8_LDB(dst, b, h) do { _Pragma("unroll") for (int n = 0; n < 2; ++n) _Pragma("unroll") for (int k = 0; k < 2; ++k) dst[n][k] = *(const PG8_LAS bf16x8*)(lds + PG8_SB(b, h) + boff + n * 2048 + k * 1024); } while (0)
#define PG8_MMA(ai, bj, At, Bt) do { __builtin_amdgcn_s_setprio(1); _Pragma("unroll") for (int m = 0; m < 4; ++m) _Pragma("unroll") for (int n = 0; n < 2; ++n) _Pragma("unroll") for (int k = 0; k < 2; ++k) \
        acc[ai][bj][m][n] = __builtin_amdgcn_mfma_f32_16x16x32_bf16(Bt[n][k], At[m][k], acc[ai][bj][m][n], 0, 0, 0); __builtin_amdgcn_s_setprio(0); } while (0)
#define PG8_WAIT_V(n) asm volatile("s_waitcnt vmcnt(" #n ")" ::: "memory")
#define PG8_WAIT_L(n) asm volatile("s_waitcnt lgkmcnt(" #n ")" ::: "memory")
#define PG8_BAR __builtin_amdgcn_s_barrier()
#define PG8_SCHED __builtin_amdgcn_sched_barrier(0)
    Unit cur, nxt; int ui = 0;
    if (!S.next(0, cur)) return;
    f32x4 acc[2][2][4][2];
#pragma unroll
    for (int a = 0; a < 2; ++a)
#pragma unroll
        for (int b = 0; b < 2; ++b)
#pragma unroll
            for (int m = 0; m < 4; ++m)
#pragma unroll
                for (int n = 0; n < 2; ++n) acc[a][b][m][n] = (f32x4){0.f, 0.f, 0.f, 0.f};
    bf16x8 At[4][2], B0[2][2], B1[2][2];
    const char* cA = (const char*)g.A + (size_t)cur.pm * tstepA + cur.ko; const char* cB = (const char*)g.Bt + (size_t)cur.pb * tstep + cur.ko;
    S.a_ready(cur);
    if constexpr (SP2) {
        PG8_STAGE(PG8_SB(0, 0), cB, voffB); PG8_STAGE(PG8_SB(0, 1), cB + hstep, voffB); PG8_STAGE(PG8_SA(0, 0), cA, voffA); PG8_STAGE(PG8_SA(0, 1), cA + hstepA, voffA);
        if (wr == 1) PG8_BAR;
        PG8_WAIT_V(2); PG8_BAR;
        PG8_STAGE(PG8_SB(1, 0), cB + kstep, voffB); PG8_STAGE(PG8_SA(1, 0), cA + kstep, voffA); PG8_STAGE(PG8_SB(1, 1), cB + hstep + kstep, voffB);
        PG8_WAIT_V(6); PG8_BAR;
    } else {
        PG8_STAGE(PG8_SB(0, 0), cB, voffB); PG8_STAGE(PG8_SA(0, 0), cA, voffA); PG8_STAGE(PG8_SB(0, 1), cB + hstep, voffB); PG8_STAGE(PG8_SA(0, 1), cA + hstepA, voffA);
        if (wr == 1) PG8_BAR;
        PG8_WAIT_V(4); PG8_BAR;
        PG8_STAGE(PG8_SB(1, 0), cB + kstep, voffB); PG8_STAGE(PG8_SA(1, 0), cA + kstep, voffA); PG8_STAGE(PG8_SB(1, 1), cB + hstep + kstep, voffB);
        PG8_WAIT_V(6); PG8_BAR;
    }
    for (;;) {
        const bool has_next = S.next(ui + 1, nxt);
        const char* nA = has_next ? (const char*)g.A + (size_t)nxt.pm * tstepA + nxt.ko : cA; const char* nB = has_next ? (const char*)g.Bt + (size_t)nxt.pb * tstep + nxt.ko : cB;
        for (int t = 0; t < nt; t += 2) {
            const bool last = (t == nt - 2);
            const char* a1 = cA + (size_t)(t + 1) * kstep;
            const char* a2 = last ? nA : cA + (size_t)(t + 2) * kstep; const char* b2 = last ? nB : cB + (size_t)(t + 2) * kstep;
            const char* a3 = a2 + kstep; const char* b3 = b2 + kstep;
            if (last && has_next) S.a_ready(nxt);
            if constexpr (SP2) {
            PG8_LDB(B0, 0, 0); PG8_LDB(B1, 0, 1); PG8_SCHED; PG8_LDA(At, 0, 0); PG8_STAGE(PG8_SA(1, 1), a1 + hstepA, voffA);
            PG8_WAIT_V(8); PG8_WAIT_L(0); PG8_BAR; PG8_MMA(0, 0, At, B0); PG8_MMA(0, 1, At, B1); PG8_BAR; PG8_SCHED;
            PG8_LDA(At, 0, 1); PG8_STAGE(PG8_SB(0, 0), b2, voffB); PG8_STAGE(PG8_SB(0, 1), b2 + hstep, voffB); PG8_STAGE(PG8_SA(0, 0), a2, voffA);
            PG8_WAIT_V(8); PG8_WAIT_L(0); PG8_BAR; PG8_MMA(1, 0, At, B0); PG8_MMA(1, 1, At, B1); PG8_BAR; PG8_SCHED;
            PG8_LDB(B0, 1, 0); PG8_LDB(B1, 1, 1); PG8_SCHED; PG8_LDA(At, 1, 0); PG8_STAGE(PG8_SA(0, 1), a2 + hstepA, voffA);
            PG8_WAIT_V(8); PG8_WAIT_L(0); PG8_BAR; PG8_MMA(0, 0, At, B0); PG8_MMA(0, 1, At, B1); PG8_BAR; PG8_SCHED;
            PG8_LDA(At, 1, 1); PG8_STAGE(PG8_SB(1, 0), b3, voffB); PG8_STAGE(PG8_SB(1, 1), b3 + hstep, voffB); PG8_STAGE(PG8_SA(1, 0), a3, voffA);
            PG8_WAIT_V(8); PG8_WAIT_L(0); PG8_BAR; PG8_MMA(1, 0, At, B0); PG8_MMA(1, 1, At, B1); PG8_BAR; PG8_SCHED;
            } else {
            PG8_LDB(B0, 0, 0); PG8_SCHED; PG8_LDA(At, 0, 0); PG8_STAGE(PG8_SA(1, 1), a1 + hstepA, voffA);
            PG8_WAIT_L(8); PG8_BAR; PG8_WAIT_L(0); PG8_MMA(0, 0, At, B0); PG8_BAR; PG8_SCHED;
            PG8_LDB(B1, 0, 1); PG8_STAGE(PG8_SB(0, 0), b2, voffB);
            PG8_BAR; PG8_WAIT_L(0); PG8_MMA(0, 1, At, B1); PG8_BAR;
            PG8_LDA(At, 0, 1); PG8_STAGE(PG8_SA(0, 0), a2, voffA);
            PG8_BAR; PG8_WAIT_L(0); PG8_MMA(1, 0, At, B0); PG8_BAR; PG8_SCHED;
            PG8_STAGE(PG8_SB(0, 1), b2 + hstep, voffB);
            PG8_WAIT_V(6); PG8_BAR; PG8_MMA(1, 1, At, B1); PG8_BAR;
            PG8_LDB(B0, 1, 0); PG8_SCHED; PG8_LDA(At, 1, 0); PG8_STAGE(PG8_SA(0, 1), a2 + hstepA, voffA);
            PG8_WAIT_L(8); PG8_BAR; PG8_WAIT_L(0); PG8_MMA(0, 0, At, B0); PG8_BAR; PG8_SCHED;
            PG8_LDB(B1, 1, 1); PG8_STAGE(PG8_SB(1, 0), b3, voffB);
            PG8_BAR; PG8_WAIT_L(0); PG8_MMA(0, 1, At, B1); PG8_BAR;
            PG8_LDA(At, 1, 1); PG8_STAGE(PG8_SA(1, 0), a3, voffA);
            PG8_BAR; PG8_WAIT_L(0); PG8_MMA(1, 0, At, B0); PG8_BAR; PG8_SCHED;
            PG8_STAGE(PG8_SB(1, 1), b3 + hstep, voffB);
            PG8_WAIT_V(6); PG8_BAR; PG8_MMA(1, 1, At, B1); PG8_BAR;
            }
        }
        if constexpr (ALIGN_EPI) { if (wr == 0) PG8_BAR; }
        if constexpr (!Epi::AFTER_DRAIN) { E(acc, cur, wr, wc, fr, fq); S.done(cur); }
        if (!has_next) break;
#pragma unroll
        for (int a = 0; a < 2; ++a)
#pragma unroll
            for (int b = 0; b < 2; ++b)
#pragma unroll
                for (int m = 0; m < 4; ++m)
#pragma unroll
                    for (int n = 0; n < 2; ++n) acc[a][b][m][n] = (f32x4){0.f, 0.f, 0.f, 0.f};
        cur = nxt; cA = nA; cB = nB; ++ui;
        if constexpr (ALIGN_EPI) { if (wr == 1) PG8_BAR; }
    }
    PG8_WAIT_V(0);
    if constexpr (!ALIGN_EPI) { if (wr == 0) PG8_BAR; }
    PG8_BAR;
    if constexpr (Epi::AFTER_DRAIN) { E.fused(acc, cur, wr, wc, fr, fq, lds, wid, lane); S.done(cur); }
#undef PG8_SA
#undef PG8_SB
#undef PG8_STAGE
#undef PG8_LDA
#undef PG8_LDB
#undef PG8_MMA
#undef PG8_WAIT_V
#undef PG8_WAIT_L
#undef PG8_BAR
#undef PG8_SCHED
}
}

constexpr int BATCH = 4, T = 4096, D = 1024, M = BATCH * T;
constexpr int N0 = 2320, N0P = 2560, N1 = 2840, N1P = 3072;
constexpr int FF = 2816, FFE = 3584, NEXP = 8;
constexpr int C0_GQ = 0, C0_GK = 256, C0_GV = 512, C0_GLOW = 1024, C0_GOUT = 1040, C0_SQ = 1552, C0_SK = 2064, C0_SV = 2192;
constexpr int C1_RQ = 0, C1_RK = 256, C1_RV = 512, C1_RG = 1024, C1_NQ = 1536, C1_KC = 2048, C1_VC = 2176, C1_KSL = 2304, C1_VSL = 2432, C1_KWN = 2560, C1_VWN = 2688, C1_NG = 2816;
constexpr float EPS = 1e-6f;
constexpr float LOG2E = 1.4426950408889634f;
constexpr int NCH = T / 64;
constexpr int NUNIT = BATCH * 4 * NCH;
constexpr int MAXTILES = 136, HALFTILES = 64, XS_ROWS = MAXTILES * 256, NSPLIT = 7;

constexpr size_t MiB = 1u << 20;
constexpr size_t WS_CTL = 0, CTL_ZERO_BYTES = 1 * MiB;
constexpr size_t WS_ROPE1 = 1 * MiB;
constexpr size_t WS_ROPE2 = 2 * MiB;
constexpr size_t WS_TAB = 6 * MiB;
constexpr size_t WS_CMPT = 7 * MiB;
constexpr size_t WS_WIN0 = 8 * MiB, WS_WOUT0 = 13 * MiB, WS_WGU = 15 * MiB, WS_WDN = 26 * MiB, WS_WIN1 = 32 * MiB, WS_WOUT1 = 38 * MiB, WS_WCMP = 40 * MiB;
constexpr size_t WS_MOEGU = 42 * MiB, WS_MOED = 154 * MiB;
constexpr size_t WS_XN = 210 * MiB;
constexpr size_t WS_PROJ = 242 * MiB;
constexpr size_t WS_RA = 338 * MiB;
constexpr size_t WS_END = 451 * MiB;
constexpr size_t WS_ONSA = 42 * MiB;
constexpr size_t WS_CMPH = 74 * MiB;
constexpr size_t WS_KCR = 80 * MiB, WS_VCR = 84 * MiB, WS_KW = 88 * MiB, WS_VWT = 92 * MiB;
constexpr size_t WS_QS = 338 * MiB;
constexpr size_t WS_KS = 354 * MiB;
constexpr size_t WS_VST = 358 * MiB;
constexpr size_t WS_QIN = 362 * MiB;
constexpr size_t WS_OINTRA = 370 * MiB;
constexpr size_t WS_UT = 402 * MiB;
constexpr size_t WS_DEC = 434 * MiB;
constexpr size_t WS_SB = 435 * MiB;
constexpr size_t WS_XS = 242 * MiB;
constexpr size_t WS_ACTH = 310 * MiB;
static_assert(WS_XS + (size_t)XS_ROWS * 1024 * 2 <= WS_ACTH && WS_ACTH + (size_t)(MAXTILES - HALFTILES) * 256 * FFE * 2 <= WS_END && (size_t)NSPLIT * 8 * 256 * 1024 * 2 <= 32 * MiB, "moe map");
static_assert(WS_DEC + (size_t)NUNIT * 64 * 4 <= WS_SB && WS_SB + (size_t)NUNIT * 8192 * 2 <= WS_END, "ws map");
constexpr size_t TB_TOKE = 0, TB_TOKW = 128 * 1024, TB_TOKR = 256 * 1024, TB_TOKS = 384 * 1024, TB_TILEE = 512 * 1024;
constexpr size_t CT_KCB = 0, CT_VCBT = 256 * 1024, CT_B1P = 512 * 1024, CT_W2T = 768 * 1024;
constexpr int CW_BAR = 4096;
constexpr int CW_CNT = 16384;
constexpr int CW_NT = 16384 + 64;

constexpr int RING_BYTES = 131072;
constexpr int LDSCTL_OFF = RING_BYTES, MISC_OFF = LDSCTL_OFF + 320;
constexpr int LDS_BYTES = 147456;
constexpr int NWAVES = 8;

#define GAS __attribute__((address_space(1)))
#define LAS __attribute__((address_space(3)))
#define DI __device__ __forceinline__
typedef unsigned short bf16;
typedef unsigned v4u __attribute__((ext_vector_type(4)));
typedef unsigned v2u __attribute__((ext_vector_type(2)));
typedef float f32x4 __attribute__((ext_vector_type(4)));
typedef short bf16x8 __attribute__((ext_vector_type(8)));
typedef float f32x2_t __attribute__((ext_vector_type(2))); typedef __bf16 bf16x2_t __attribute__((ext_vector_type(2)));
DI unsigned pk2(float lo, float hi) { f32x2_t v = {lo, hi}; bf16x2_t b = __builtin_convertvector(v, bf16x2_t); return __builtin_bit_cast(unsigned, b); }
DI unsigned f2bf(float f) { return pk2(f, 0.f) & 0xffffu; }
DI float bflo(unsigned w) { return __builtin_bit_cast(float, w << 16); }
DI float bfhi(unsigned w) { return __builtin_bit_cast(float, w & 0xffff0000u); }
DI void unpack8(const v4u v, float (&x)[8]) { x[0] = bflo(v.x); x[1] = bfhi(v.x); x[2] = bflo(v.y); x[3] = bfhi(v.y); x[4] = bflo(v.z); x[5] = bfhi(v.z); x[6] = bflo(v.w); x[7] = bfhi(v.w); }
DI v4u pack8(const float (&x)[8]) { v4u v; v.x = pk2(x[0], x[1]); v.y = pk2(x[2], x[3]); v.z = pk2(x[4], x[5]); v.w = pk2(x[6], x[7]); return v; }
DI bf16x8 ldg16(const bf16* p) { return *(const bf16x8*)p; }
DI f32x4 mfma16(bf16x8 a, bf16x8 b, f32x4 c) { return __builtin_amdgcn_mfma_f32_16x16x32_bf16(a, b, c, 0, 0, 0); }
template <int CTRL> DI float dppf(float v) { return __builtin_bit_cast(float, __builtin_amdgcn_update_dpp(0, __builtin_bit_cast(int, v), CTRL, 0xf, 0xf, true)); }
DI float rdlane(float v, int l) { return __builtin_bit_cast(float, __builtin_amdgcn_readlane(__builtin_bit_cast(int, v), l)); }
DI float sum8(float v) { v += dppf<0xB1>(v); v += dppf<0x4E>(v); v += dppf<0x141>(v); return v; }
DI float sum16(float v) { v = sum8(v); v += dppf<0x140>(v); return v; }
DI float wave_sum(float v) { v = sum16(v); return (rdlane(v, 0) + rdlane(v, 16)) + (rdlane(v, 32) + rdlane(v, 48)); }
DI float xor1(float v) { return dppf<0xB1>(v); }
DI float scan64(float v, int lane, float& total) {
    v += dppf<0x111>(v); v += dppf<0x112>(v); v += dppf<0x114>(v); v += dppf<0x118>(v);
    const float s0 = rdlane(v, 15), s1 = rdlane(v, 31), s2 = rdlane(v, 47), s3 = rdlane(v, 63); const int row = lane >> 4;
    v += (row >= 1 ? s0 : 0.f) + (row >= 2 ? s1 : 0.f) + (row >= 3 ? s2 : 0.f);
    total = (s0 + s1) + (s2 + s3); return v;
}
DI float silu_f(float g) { return g / (1.0f + __expf(-g)); }

#define XB_TMO      128
#define XB_XCNT(j)  (256  + 64 * (j))
#define XB_XSUB(j)  (1280 + 64 * (j))
#define XB_XGEN(j)  (2304 + 64 * (j))
#define XB_TOP      3328
#define XB_TOPGEN   3392
#define XCD_BAR_WORDS 3456
#define XB_SPIN_CAP (1u << 18)

__device__ __forceinline__ unsigned xb_ld(unsigned* p)              { return __hip_atomic_load(p, __ATOMIC_RELAXED, __HIP_MEMORY_SCOPE_AGENT); }
__device__ __forceinline__ unsigned xb_add(unsigned* p, unsigned v) { return __hip_atomic_fetch_add(p, v, __ATOMIC_RELAXED, __HIP_MEMORY_SCOPE_AGENT); }
__device__ __forceinline__ unsigned xb_xcc_id() { return (unsigned)__builtin_amdgcn_s_getreg((3 << 11) | 20) & 0xFu; }
#define XB_SPIN(cond, bar) do { unsigned _sp = 0; while (cond) { __builtin_amdgcn_s_sleep(1); \
    if ((++_sp & 255u) == 0u) { if (xb_ld(&(bar)[XB_TMO])) break; if (_sp > XB_SPIN_CAP) { atomicAdd(&(bar)[XB_TMO], 1u); break; } } } } while (0)

struct XcdBarrier { unsigned* bar; unsigned x; volatile LAS unsigned* st; };

__device__ __forceinline__ XcdBarrier xcd_barrier_post(unsigned* bar, volatile LAS unsigned* st) {
    XcdBarrier b; b.bar = bar; b.x = xb_xcc_id(); b.st = st;
    if (threadIdx.x == 0) (void)xb_add(&bar[XB_XCNT(b.x)], 1u);
    return b;
}
__device__ __forceinline__ void xcd_barrier_complete(unsigned* bar, unsigned x, unsigned& nloc, unsigned& nx) {
    const unsigned G = gridDim.x * gridDim.y * gridDim.z;
    unsigned sum, cnt, mine, sp = 0u;
    for (;;) {
        sum = 0u; cnt = 0u; mine = 0u;
#pragma unroll
        for (unsigned j = 0; j < 16; ++j) { const unsigned c = xb_ld(&bar[XB_XCNT(j)]); sum += c; cnt += (c > 0u) ? 1u : 0u; mine = (j == x) ? c : mine; }
        if (sum == G) break;
        __builtin_amdgcn_s_sleep(1);
        if ((++sp & 255u) == 0u) { if (xb_ld(&bar[XB_TMO])) break; if (sp > XB_SPIN_CAP) { atomicAdd(&bar[XB_TMO], 1u); break; } }
    }
    nloc = mine > 0u ? mine : 1u; nx = cnt > 0u ? cnt : 1u;
}
__device__ __forceinline__ void xcd_barrier(const XcdBarrier& b) {
    asm volatile("s_waitcnt vmcnt(0)" ::: "memory");
    __syncthreads();
    if (threadIdx.x == 0) {
        unsigned* bar = b.bar;
        __builtin_amdgcn_s_waitcnt(0);
        unsigned nloc = b.st[0], nx = b.st[1];
        if (nloc == 0u) { xcd_barrier_complete(bar, b.x, nloc, nx); b.st[0] = nloc; b.st[1] = nx; }
        const unsigned old = xb_add(&bar[XB_XSUB(b.x)], 1u);
        const unsigned gen = old / nloc;
        if (old + 1u == (gen + 1u) * nloc) {
            __builtin_amdgcn_fence(__ATOMIC_RELEASE, "agent");
            asm volatile("s_waitcnt vmcnt(0)" ::: "memory");
            const unsigned og = xb_add(&bar[XB_TOP], 1u);
            const unsigned tg = og / nx;
            if (og + 1u == (tg + 1u) * nx) xb_add(&bar[XB_TOPGEN], 1u);
            else XB_SPIN(xb_ld(&bar[XB_TOPGEN]) == tg, bar);
            __builtin_amdgcn_fence(__ATOMIC_ACQUIRE, "agent");
            xb_add(&bar[XB_XGEN(b.x)], 1u);
            asm volatile("s_waitcnt vmcnt(0)" ::: "memory");
        } else {
            XB_SPIN(xb_ld(&bar[XB_XGEN(b.x)]) == gen, bar);
            __builtin_amdgcn_fence(__ATOMIC_ACQUIRE, "agent");
            asm volatile("s_waitcnt vmcnt(0)" ::: "memory");
        }
    }
    __syncthreads();
}

#define LDS_WAIT() asm volatile("s_waitcnt lgkmcnt(0)" ::: "memory")

DI void tr_item64(const float* __restrict__ W, int N, bf16* __restrict__ WT, int kpitch, int drow0, int k0, int n0, const float* __restrict__ gain, LAS unsigned char* scr, int lane) {
    const int n4 = lane & 15, kq = lane >> 4, n = n0 + 4 * n4; const bool ok = n < N;
    f32x4 v[4][4];
#pragma unroll
    for (int g = 0; g < 4; ++g)
#pragma unroll
        for (int j = 0; j < 4; ++j) v[g][j] = ok ? __builtin_nontemporal_load((const f32x4*)(W + (size_t)(k0 + 16 * g + 4 * kq + j) * N + n)) : (f32x4){0.f, 0.f, 0.f, 0.f};
#pragma unroll
    for (int g = 0; g < 4; ++g) { float gj[4];
#pragma unroll
        for (int j = 0; j < 4; ++j) gj[j] = gain ? gain[k0 + 16 * g + 4 * kq + j] : 1.f;
        const int chunk = 2 * g + (kq >> 1), half = kq & 1;
#pragma unroll
        for (int i = 0; i < 4; ++i) { const int nn = 4 * n4 + i; v2u wv; wv.x = pk2(v[g][0][i] * gj[0], v[g][1][i] * gj[1]); wv.y = pk2(v[g][2][i] * gj[2], v[g][3][i] * gj[3]);
            *(LAS v2u*)(scr + nn * 128 + ((chunk ^ (n4 & 7)) << 4) + half * 8) = wv; } }
    LDS_WAIT(); asm volatile("" ::: "memory");
#pragma unroll
    for (int jj = 0; jj < 8; ++jj) { const int nn = (lane >> 3) + 8 * jj, c = lane & 7; const v4u o = *(const LAS v4u*)(scr + nn * 128 + ((c ^ ((nn >> 2) & 7)) << 4));
        *(v4u*)(WT + (size_t)(drow0 + nn) * kpitch + k0 + 8 * c) = o; }
    LDS_WAIT(); asm volatile("" ::: "memory");
}
DI void conv_mat(const float* W, int K, int N, int NP, bf16* WT, int mode, const float* gain, LAS unsigned char* scr, int gw, int NGW, int lane) {
    const int nblk = NP / 64, nit = nblk * (K / 64);
    for (int it = gw; it < nit; it += NGW) { const int kb = it / nblk, nb = it - kb * nblk, n0 = nb * 64;
        const int drow0 = (mode == 0) ? n0 : ((n0 >> 7) * 256 + (n0 & 127) + (mode == 2 ? 128 : 0));
        tr_item64(W, N, WT, K, drow0, kb * 64, n0, gain, scr, lane); }
}
DI void conv_tile_wg(const float* __restrict__ W, int K, int N, bf16* __restrict__ WT, int mode, const float* __restrict__ gain, LAS unsigned char* lds, int lane, int w, int k0, int n0) {
    const int col4 = lane & 31, rsub = lane >> 5;
    const int kl = 32 * w + 16 * rsub;
    const float* src = W + (size_t)(k0 + kl) * N + n0 + 4 * col4;
    f32x4 v[16];
#pragma unroll
    for (int i = 0; i < 16; ++i) v[i] = (n0 + 4 * col4 < N) ? __builtin_nontemporal_load((const f32x4*)(src + (size_t)i * N)) : (f32x4){0.f, 0.f, 0.f, 0.f};
    if (gain) {
#pragma unroll
        for (int i = 0; i < 16; ++i) v[i] = v[i] * gain[k0 + kl + i]; }
    const int c0 = 4 * w + 2 * rsub;
#pragma unroll
    for (int i = 0; i < 4; ++i) { const int nn = 4 * col4 + i;
#pragma unroll
        for (int hf = 0; hf < 2; ++hf) { v4u o; o.x = pk2(v[8 * hf + 0][i], v[8 * hf + 1][i]); o.y = pk2(v[8 * hf + 2][i], v[8 * hf + 3][i]); o.z = pk2(v[8 * hf + 4][i], v[8 * hf + 5][i]); o.w = pk2(v[8 * hf + 6][i], v[8 * hf + 7][i]);
            *(LAS v4u*)(lds + nn * 512 + (((c0 + hf) ^ (col4 & 7)) << 4)) = o; } }
    __syncthreads();
    const int drow0 = (mode == 0) ? n0 : ((n0 >> 7) * 256 + (mode == 2 ? 128 : 0));
#pragma unroll
    for (int jj = 0; jj < 8; ++jj) { const int nn = 16 * w + 2 * jj + rsub, c = lane & 31; const v4u o = *(const LAS v4u*)(lds + nn * 512 + ((c ^ ((nn >> 2) & 7)) << 4));
        *(v4u*)(WT + (size_t)(drow0 + nn) * K + k0 + 8 * c) = o; }
    __syncthreads();
}
DI void conv_mat_wg(const float* __restrict__ W, int K, int N, int NP, bf16* __restrict__ WT, int mode, const float* __restrict__ gain, LAS unsigned char* lds, int lane, int w, int bid, int G) {
    const int nsb = NP / 128, nst = nsb * (K / 256);
    __syncthreads();
    for (int st = bid; st < nst; st += G) { const int kb = st / nsb, nb = st - kb * nsb; conv_tile_wg(W, K, N, WT, mode, gain, lds, lane, w, kb * 256, nb * 128); }
}
DI void conv_moe_tiles(const float* __restrict__ wg_, const float* __restrict__ wu_, const float* __restrict__ wd_, const float* __restrict__ gain, bf16* __restrict__ MOEGU, bf16* __restrict__ MOED,
                       LAS unsigned char* lds, int lane, int w, int lo, int hi, int rank, int n) {
    __syncthreads();
    for (int t = lo + rank; t < hi; t += n) { const int mi = t / 112, st = t - mi * 112;
        if (mi < 8) { conv_tile_wg(wd_ + (size_t)mi * FFE * D, FFE, D, MOED + (size_t)mi * D * FFE, 0, nullptr, lds, lane, w, (st >> 3) * 256, (st & 7) * 128); }
        else { const int q = mi - 8, e = 7 - (q >> 1), up = q & 1; const int kb = st / 28, nb = st - kb * 28;
            conv_tile_wg((up ? wu_ : wg_) + (size_t)e * D * FFE, D, FFE, MOEGU + (size_t)e * 2 * FFE * D, up ? 2 : 1, gain, lds, lane, w, kb * 256, nb * 128); } }
}
DI void rope_tables(const int* __restrict__ pos, float* __restrict__ R1, float* __restrict__ R2, int gtid, int NT) {
    for (int idx = gtid; idx < M * 40; idx += NT) { const int m = idx / 40, i = idx - m * 40; const float p = (float)pos[m];
        float inv; if (i < 8) inv = exp2f(-(float)i * (18.931568569324174f / 8.0f)); else inv = exp2f(-(float)(i - 8) * (13.287712379549449f / 32.0f));
        double rev = (double)p * (double)inv * 0.15915494309189535; rev -= floor(rev); const float fr = (float)rev;
        const float c = __builtin_amdgcn_cosf(fr), s = __builtin_amdgcn_sinf(fr);
        if (i < 8) { R1[m * 16 + i] = c; R1[m * 16 + 8 + i] = s; } else { R2[m * 64 + (i - 8)] = c; R2[m * 64 + 32 + (i - 8)] = s; } }
}
DI void rms_row_bf16(const float* __restrict__ xrow, bf16* __restrict__ orow, int lane) {
    const f32x4* xr = (const f32x4*)xrow + lane;
    f32x4 v[4]; float s = 0.f;
#pragma unroll
    for (int j = 0; j < 4; ++j) { v[j] = xr[64 * j]; s += (v[j].x * v[j].x + v[j].y * v[j].y) + (v[j].z * v[j].z + v[j].w * v[j].w); }
    const float rstd = 1.f / sqrtf(wave_sum(s) * (1.f / D) + EPS);
    unsigned long long* o8 = (unsigned long long*)orow + lane;
#pragma unroll
    for (int j = 0; j < 4; ++j) o8[64 * j] = (unsigned long long)pk2(v[j].x * rstd, v[j].y * rstd) | ((unsigned long long)pk2(v[j].z * rstd, v[j].w * rstd) << 32);
}
DI void rms_phase(const float* __restrict__ src, bf16* __restrict__ dst, int gw, int NGW, int lane) {
    int m = gw;
    for (; m + 3 * NGW < M; m += 4 * NGW) { f32x4 v[4][4];
#pragma unroll
        for (int q = 0; q < 4; ++q) { const f32x4* xr = (const f32x4*)(src + (size_t)(m + q * NGW) * D) + lane;
#pragma unroll
            for (int j = 0; j < 4; ++j) v[q][j] = xr[64 * j]; }
#pragma unroll
        for (int q = 0; q < 4; ++q) { float s = 0.f;
#pragma unroll
            for (int j = 0; j < 4; ++j) s += (v[q][j].x * v[q][j].x + v[q][j].y * v[q][j].y) + (v[q][j].z * v[q][j].z + v[q][j].w * v[q][j].w);
            const float rstd = 1.f / sqrtf(wave_sum(s) * (1.f / D) + EPS);
            unsigned long long* o8 = (unsigned long long*)(dst + (size_t)(m + q * NGW) * D) + lane;
#pragma unroll
            for (int j = 0; j < 4; ++j) o8[64 * j] = (unsigned long long)pk2(v[q][j].x * rstd, v[q][j].y * rstd) | ((unsigned long long)pk2(v[q][j].z * rstd, v[q][j].w * rstd) << 32); } }
    for (; m < M; m += NGW) rms_row_bf16(src + (size_t)m * D, dst + (size_t)m * D, lane);
}
DI void rms_phase_b(const bf16* __restrict__ src, bf16* __restrict__ dst, int gw, int NGW, int lane) {
    constexpr int RB = 4; int m = gw;
    for (; m < M; m += RB * NGW) { v4u v[RB][2];
#pragma unroll
        for (int q = 0; q < RB; ++q) { const int mm = (m + q * NGW < M) ? m + q * NGW : m; const v4u* xr = (const v4u*)(src + (size_t)mm * D) + lane; v[q][0] = xr[0]; v[q][1] = xr[64]; }
#pragma unroll
        for (int q = 0; q < RB; ++q) if (m + q * NGW < M) { float x[16]; { float t8[8]; unpack8(v[q][0], t8);
#pragma unroll
                for (int i = 0; i < 8; ++i) x[i] = t8[i];
                unpack8(v[q][1], t8);
#pragma unroll
                for (int i = 0; i < 8; ++i) x[8 + i] = t8[i]; }
            float s_ = 0.f;
#pragma unroll
            for (int i = 0; i < 16; ++i) s_ += x[i] * x[i];
            const float rstd = 1.f / sqrtf(wave_sum(s_) * (1.f / D) + EPS);
            v4u o0, o1; o0.x = pk2(x[0] * rstd, x[1] * rstd); o0.y = pk2(x[2] * rstd, x[3] * rstd); o0.z = pk2(x[4] * rstd, x[5] * rstd); o0.w = pk2(x[6] * rstd, x[7] * rstd);
            o1.x = pk2(x[8] * rstd, x[9] * rstd); o1.y = pk2(x[10] * rstd, x[11] * rstd); o1.z = pk2(x[12] * rstd, x[13] * rstd); o1.w = pk2(x[14] * rstd, x[15] * rstd);
            v4u* orow = (v4u*)(dst + (size_t)(m + q * NGW) * D) + lane; orow[0] = o0; orow[64] = o1; } }
}
DI void cmp_bias_item(const float* __restrict__ posf, const float* __restrict__ w1, float* __restrict__ outp, int jb, int ch, int lane) {
    const int j = jb * 64 + lane; float a0 = 0.f, a1 = 0.f, a2 = 0.f, a3 = 0.f;
#pragma unroll
    for (int i = ch * 32; i < ch * 32 + 32; i += 4) {
        a0 += posf[i] * w1[(size_t)i * 256 + j]; a1 += posf[i + 1] * w1[(size_t)(i + 1) * 256 + j];
        a2 += posf[i + 2] * w1[(size_t)(i + 2) * 256 + j]; a3 += posf[i + 3] * w1[(size_t)(i + 3) * 256 + j]; }
    outp[ch * 256 + j] = (a0 + a1) + (a2 + a3);
}

DI void head_norm_rope(float (&x)[8], const float* __restrict__ gain, int sub, const float* __restrict__ cs) {
    float ss = 0.f;
#pragma unroll
    for (int i = 0; i < 8; ++i) ss += x[i] * x[i];
    ss = sum8(ss);
    const float rstd = 1.f / sqrtf(ss * (1.f / 64.f) + EPS);
#pragma unroll
    for (int i = 0; i < 8; ++i) x[i] = x[i] * rstd * gain[sub * 8 + i];
#pragma unroll
    for (int i = 0; i < 8; ++i) { const float other = xor1(x[i]); const float c = cs[i], s = cs[8 + i];
        if (sub == 0) x[i] = x[i] * c - other * s; else if (sub == 1) x[i] = x[i] * c + other * s; }
}
DI void q8_token(const bf16* __restrict__ src, const float* __restrict__ gain, const float* __restrict__ cs, bf16* __restrict__ dst, size_t hstride, int lane) {
    const int head = lane >> 3, sub = lane & 7; float x[8];
    unpack8(*(const v4u*)(src + head * 64 + sub * 8), x);
    head_norm_rope(x, gain, sub, cs);
#pragma unroll
    for (int i = 0; i < 8; ++i) x[i] *= 0.125f * LOG2E;
    *(v4u*)(dst + (size_t)head * hstride + sub * 8) = pack8(x);
}

constexpr int LP = 72;
constexpr int L_QIN = 0, L_KIN = 64 * LP * 2, L_KST = 2 * 64 * LP * 2, L_VT = 3 * 64 * LP * 2;

template <bool RET>
DI void chunk_phaseA(LAS unsigned char* lds, const bf16* __restrict__ PROJ, int ldp, int cq, int ck, int cv, int cglow,
                     const float* __restrict__ gate_up, const float* __restrict__ gate_bias, const float* __restrict__ rope2,
                     bf16* __restrict__ QIN, bf16* __restrict__ OINTRA, float* __restrict__ UT, float* __restrict__ DEC,
                     int lane, int w, int bid, int G) {
    const int r = lane & 15, quad = lane >> 4;
    struct ARaw { v4u a[6]; f32x4 c[4]; };
    auto load_raw = [&](int unit_, ARaw& R_) { const int b_ = unit_ >> 8, h_ = (unit_ >> 6) & 3, n_ = unit_ & 63; const int m_ = b_ * T + n_ * 64 + lane; const bf16* pr = PROJ + (size_t)m_ * ldp;
        if (!RET) { R_.a[0] = *(const v4u*)(pr + cglow); R_.a[1] = *(const v4u*)(pr + cglow + 8); R_.a[2] = *(const v4u*)(pr + cq + h_ * 64 + 8 * w); R_.a[3] = *(const v4u*)(pr + ck + h_ * 64 + 8 * w); }
        else { const int c0 = 8 * w, cp = (c0 + 32) & 63; R_.a[0] = *(const v4u*)(pr + cq + h_ * 64 + c0); R_.a[1] = *(const v4u*)(pr + cq + h_ * 64 + cp); R_.a[2] = *(const v4u*)(pr + ck + h_ * 64 + c0); R_.a[3] = *(const v4u*)(pr + ck + h_ * 64 + cp);
            const float* cs = rope2 + (size_t)m_ * 64 + (c0 & 31); R_.c[0] = *(const f32x4*)cs; R_.c[1] = *(const f32x4*)(cs + 4); R_.c[2] = *(const f32x4*)(cs + 32); R_.c[3] = *(const f32x4*)(cs + 36); }
        R_.a[4] = *(const v4u*)(pr + cv + h_ * 128 + 16 * w); R_.a[5] = *(const v4u*)(pr + cv + h_ * 128 + 16 * w + 8); };
    ARaw cur; if (bid < NUNIT) load_raw(bid, cur);
    LAS float* lgu = (LAS float*)(lds + 49152);
    if (!RET) { const int t_ = (int)threadIdx.x;
#pragma unroll
        for (int i = 0; i < 2; ++i) *(LAS f32x4*)(lgu + (t_ + 512 * i) * 4) = *(const f32x4*)(gate_up + (t_ + 512 * i) * 4);
        if (t_ < 64) *(LAS f32x4*)(lgu + 4096 + t_ * 4) = *(const f32x4*)(gate_bias + t_ * 4);
        __syncthreads(); }
    for (int unit = bid; unit < NUNIT; unit += G) {
        const int h = (unit >> 6) & 3;
        float la[8];
        if (!RET) {
            float gl[16]; { float t8[8]; unpack8(cur.a[0], t8);
#pragma unroll
                for (int i = 0; i < 8; ++i) gl[i] = t8[i];
                unpack8(cur.a[1], t8);
#pragma unroll
                for (int i = 0; i < 8; ++i) gl[8 + i] = t8[i]; }
            const int c0_ = h * 64 + 8 * w; float xg[8];
            { const f32x4 b0 = *(const LAS f32x4*)(lgu + 4096 + c0_), b1 = *(const LAS f32x4*)(lgu + 4096 + c0_ + 4);
#pragma unroll
                for (int cc = 0; cc < 4; ++cc) { xg[cc] = b0[cc]; xg[4 + cc] = b1[cc]; } }
#pragma unroll
            for (int rr = 0; rr < 16; ++rr) { const f32x4 u0 = *(const LAS f32x4*)(lgu + rr * 256 + c0_), u1 = *(const LAS f32x4*)(lgu + rr * 256 + c0_ + 4);
#pragma unroll
                for (int cc = 0; cc < 4; ++cc) { xg[cc] += gl[rr] * u0[cc]; xg[4 + cc] += gl[rr] * u1[cc]; } }
#pragma unroll
            for (int cc = 0; cc < 8; ++cc) { const float x = xg[cc]; la[cc] = (fminf(x, 0.f) - __logf(1.f + __expf(-fabsf(x)))) * (1.f / 16.f); }
        } else {
            const float lg = logf(1.f - exp2f(-5.f - (float)h));
#pragma unroll
            for (int cc = 0; cc < 8; ++cc) la[cc] = lg;
        }
        float bl[8];
#pragma unroll
        for (int cc = 0; cc < 8; ++cc) la[cc] = scan64(la[cc], lane, bl[cc]);
        float q[8], k[8];
        if (!RET) {
            unpack8(cur.a[2], q); unpack8(cur.a[3], k);
#pragma unroll
            for (int i = 0; i < 8; ++i) q[i] *= 0.125f;
        } else {
            const int c0 = 8 * w; float qp[8], kp[8];
            unpack8(cur.a[0], q); unpack8(cur.a[1], qp); unpack8(cur.a[2], k); unpack8(cur.a[3], kp);
#pragma unroll
            for (int i = 0; i < 8; ++i) { const float c = cur.c[i >> 2][i & 3], s = cur.c[2 + (i >> 2)][i & 3];
                if (c0 < 32) { q[i] = q[i] * c - qp[i] * s; k[i] = (k[i] * c - kp[i] * s) * 0.125f; }
                else         { q[i] = q[i] * c + qp[i] * s; k[i] = (k[i] * c + kp[i] * s) * 0.125f; } }
        }
        float qin[8], kin[8];
        LAS bf16* kst = (LAS bf16*)(lds + L_KST);
#pragma unroll
        for (int cc = 0; cc < 8; ++cc) { qin[cc] = q[cc] * __expf(la[cc]); kin[cc] = k[cc] * __expf(-la[cc]);
            kst[(8 * w + cc) * LP + lane] = (bf16)f2bf(k[cc] * __expf(bl[cc] - la[cc])); }
        const v4u qv = pack8(qin), kv = pack8(kin);
        *(LAS v4u*)(lds + L_QIN + (lane * LP + 8 * w) * 2) = qv;
        *(LAS v4u*)(lds + L_KIN + (lane * LP + 8 * w) * 2) = kv;
        *(v4u*)(QIN + (size_t)unit * 4096 + lane * 64 + 8 * w) = qv;
        if (lane == 63) {
#pragma unroll
            for (int cc = 0; cc < 8; ++cc) DEC[(size_t)unit * 64 + 8 * w + cc] = __expf(bl[cc]); }
        { float v0[8], v1[8]; unpack8(cur.a[4], v0); unpack8(cur.a[5], v1);
            LAS bf16* vt = (LAS bf16*)(lds + L_VT);
#pragma unroll
            for (int i = 0; i < 8; ++i) { vt[(16 * w + i) * LP + lane] = (bf16)f2bf(v0[i]); vt[(16 * w + 8 + i) * LP + lane] = (bf16)f2bf(v1[i]); } }
        __syncthreads();
        ARaw nxt; if (unit + G < NUNIT) load_raw(unit + G, nxt);
        {
            const int tt = w & 3, dh = w >> 2;
            const bf16x8 qf0 = *(const LAS bf16x8*)(lds + L_QIN + ((tt * 16 + r) * LP + quad * 8) * 2), qf1 = *(const LAS bf16x8*)(lds + L_QIN + ((tt * 16 + r) * LP + 32 + quad * 8) * 2);
            f32x4 acc[4];
#pragma unroll
            for (int d4 = 0; d4 < 4; ++d4) acc[d4] = (f32x4){0.f, 0.f, 0.f, 0.f};
            const int nks = (tt >> 1) + 1;
            for (int ks = 0; ks < nks; ++ks) { const int kb = 32 * ks, krow = kb + ((r >> 2) << 3) + (r & 3);
                const LAS unsigned char* kp = lds + L_KIN + (krow * LP + quad * 8) * 2;
                const bf16x8 k00 = *(const LAS bf16x8*)kp, k01 = *(const LAS bf16x8*)(kp + 64), k10 = *(const LAS bf16x8*)(kp + 4 * LP * 2), k11 = *(const LAS bf16x8*)(kp + 4 * LP * 2 + 64);
                f32x4 s0 = mfma16(k00, qf0, (f32x4){0.f, 0.f, 0.f, 0.f}); s0 = mfma16(k01, qf1, s0);
                f32x4 s1 = mfma16(k10, qf0, (f32x4){0.f, 0.f, 0.f, 0.f}); s1 = mfma16(k11, qf1, s1);
                const int tok = tt * 16 + r, key0 = kb + 8 * quad; float p[8];
#pragma unroll
                for (int jj = 0; jj < 4; ++jj) { p[jj] = (key0 + jj <= tok) ? s0[jj] : 0.f; p[4 + jj] = (key0 + 4 + jj <= tok) ? s1[jj] : 0.f; }
                const bf16x8 pf = __builtin_bit_cast(bf16x8, pack8(p));
#pragma unroll
                for (int d4 = 0; d4 < 4; ++d4) { const bf16x8 vf = *(const LAS bf16x8*)(lds + L_VT + ((dh * 64 + d4 * 16 + r) * LP + kb + quad * 8) * 2); acc[d4] = mfma16(vf, pf, acc[d4]); }
            }
#pragma unroll
            for (int d4 = 0; d4 < 4; ++d4) { v2u o; o.x = pk2(acc[d4][0], acc[d4][1]); o.y = pk2(acc[d4][2], acc[d4][3]); *(v2u*)(OINTRA + (size_t)unit * 8192 + (tt * 16 + r) * 128 + dh * 64 + d4 * 16 + 4 * quad) = o; }
        }
        {
#pragma unroll
            for (int dkt = 0; dkt < 4; ++dkt) { f32x4 au = (f32x4){0.f, 0.f, 0.f, 0.f};
#pragma unroll
                for (int ks = 0; ks < 2; ++ks) { const bf16x8 a = *(const LAS bf16x8*)(lds + L_VT + ((16 * w + r) * LP + 32 * ks + quad * 8) * 2);
                    const bf16x8 bq = *(const LAS bf16x8*)(lds + L_KST + ((dkt * 16 + r) * LP + 32 * ks + quad * 8) * 2); au = mfma16(a, bq, au); }
#pragma unroll
                for (int i = 0; i < 4; ++i) UT[(size_t)unit * 8192 + (16 * w + 4 * quad + i) * 64 + dkt * 16 + r] = au[i]; }
        }
        __syncthreads();
        if (unit + G < NUNIT) cur = nxt;
    }
}
DI void chunk_scan(const float* __restrict__ UT, const float* __restrict__ DEC, bf16* __restrict__ SB, int gtid, int NT) {
    for (int e = gtid; e < 16 * 4096; e += NT) { const int bh = e >> 12, idx2 = (e & 4095) * 2, dk = idx2 & 63; f32x2_t S = (f32x2_t){0.f, 0.f};
        const float* up = UT + (size_t)bh * 64 * 8192 + idx2; const float* dp = DEC + (size_t)bh * 64 * 64 + dk; unsigned* sp = (unsigned*)(SB + (size_t)bh * 64 * 8192 + idx2);
#pragma unroll 8
        for (int n = 0; n < 64; ++n) { const f32x2_t u = *(const f32x2_t*)(up + (size_t)n * 8192), d = *(const f32x2_t*)(dp + n * 64); sp[(size_t)n * 4096] = pk2(S.x, S.y); S = d * S + u; } }
}
template <bool RET>
DI void chunk_phaseC(const bf16* __restrict__ QIN, const bf16* __restrict__ OINTRA, const bf16* __restrict__ SB, const bf16* __restrict__ PROJ, int ldp, int cgate,
                     const float* __restrict__ gnorm, bf16* __restrict__ MIXED, int gw, int NGW, int lane) {
    const int r = lane & 15, quad = lane >> 4;
    for (int wu0 = gw; wu0 < NUNIT * 4; wu0 += 2 * NGW) {
        int unit[2], tt[2]; bool ok[2]; bf16x8 qf[2][2]; v2u oi[2][8], gv[2][8]; size_t mrow[2]; int hh[2];
#pragma unroll
        for (int q = 0; q < 2; ++q) { const int wu = wu0 + q * NGW; ok[q] = wu < NUNIT * 4; const int wv = ok[q] ? wu : wu0; unit[q] = wv >> 2; tt[q] = wv & 3;
            const int b = unit[q] >> 8, n = unit[q] & 63; hh[q] = (unit[q] >> 6) & 3; mrow[q] = (size_t)b * T + n * 64 + tt[q] * 16 + r;
            const bf16* qp = QIN + (size_t)unit[q] * 4096 + (tt[q] * 16 + r) * 64 + quad * 8; qf[q][0] = ldg16(qp); qf[q][1] = ldg16(qp + 32);
#pragma unroll
            for (int dt = 0; dt < 8; ++dt) { oi[q][dt] = *(const v2u*)(OINTRA + (size_t)unit[q] * 8192 + (tt[q] * 16 + r) * 128 + dt * 16 + 4 * quad);
                gv[q][dt] = *(const v2u*)(PROJ + mrow[q] * ldp + cgate + hh[q] * 128 + dt * 16 + 4 * quad); } }
        f32x4 acc[2][8];
#pragma unroll
        for (int dt = 0; dt < 8; ++dt)
#pragma unroll
            for (int q = 0; q < 2; ++q) { acc[q][dt] = (f32x4){bflo(oi[q][dt].x), bfhi(oi[q][dt].x), bflo(oi[q][dt].y), bfhi(oi[q][dt].y)};
#pragma unroll
                for (int kk = 0; kk < 2; ++kk) acc[q][dt] = mfma16(ldg16(SB + (size_t)unit[q] * 8192 + (dt * 16 + r) * 64 + kk * 32 + quad * 8), qf[q][kk], acc[q][dt]); }
#pragma unroll
        for (int q = 0; q < 2; ++q) if (ok[q]) {
            float mean = 0.f;
            if (RET) { float s_ = 0.f;
#pragma unroll
                for (int dt = 0; dt < 8; ++dt) s_ += (acc[q][dt][0] + acc[q][dt][1]) + (acc[q][dt][2] + acc[q][dt][3]);
                s_ += __shfl_xor(s_, 16); s_ += __shfl_xor(s_, 32); mean = s_ * (1.f / 128.f); }
            float ss = 0.f;
#pragma unroll
            for (int dt = 0; dt < 8; ++dt)
#pragma unroll
                for (int i = 0; i < 4; ++i) { const float d = acc[q][dt][i] - mean; ss += d * d; }
            ss += __shfl_xor(ss, 16); ss += __shfl_xor(ss, 32);
            const float rstd = 1.f / sqrtf(ss * (1.f / 128.f) + EPS);
#pragma unroll
            for (int dt = 0; dt < 8; ++dt) { const int dv = dt * 16 + 4 * quad; const v2u g_ = gv[q][dt];
                const float g0 = bflo(g_.x), g1 = bfhi(g_.x), g2 = bflo(g_.y), g3 = bfhi(g_.y);
                const float* gn = gnorm + (RET ? hh[q] * 128 : 0) + dv;
                const float y0 = (acc[q][dt][0] - mean) * rstd * gn[0] * silu_f(g0), y1 = (acc[q][dt][1] - mean) * rstd * gn[1] * silu_f(g1);
                const float y2 = (acc[q][dt][2] - mean) * rstd * gn[2] * silu_f(g2), y3 = (acc[q][dt][3] - mean) * rstd * gn[3] * silu_f(g3);
                v2u o; o.x = pk2(y0, y1); o.y = pk2(y2, y3);
                *(v2u*)(MIXED + mrow[q] * 1024 + hh[q] * 128 + dv) = o; } }
    }
}

struct KVF { bf16x8 k[4]; bf16x8 v[4]; };
DI void kv_load(KVF& f, const bf16* __restrict__ Kb, const bf16* __restrict__ VTb, int kb, int r, int quad) {
    const bf16* kp = Kb + (size_t)(kb + ((r >> 2) << 3) + (r & 3)) * 64 + quad * 8;
    f.k[0] = ldg16(kp); f.k[1] = ldg16(kp + 32); f.k[2] = ldg16(kp + 256); f.k[3] = ldg16(kp + 288);
    const bf16* vp = VTb + (size_t)(kb >> 5) * 2048 + r * 32 + quad * 8;
#pragma unroll
    for (int dt = 0; dt < 4; ++dt) f.v[dt] = ldg16(vp + dt * 512);
}
DI void k_load(KVF& f, const bf16* __restrict__ Kb, int kb, int r, int quad) {
    const bf16* kp = Kb + (size_t)(kb + ((r >> 2) << 3) + (r & 3)) * 64 + quad * 8;
    f.k[0] = ldg16(kp); f.k[1] = ldg16(kp + 32); f.k[2] = ldg16(kp + 256); f.k[3] = ldg16(kp + 288);
}
DI size_t kblk_off(int key, int d0) { const int kap = key & 31, a = kap >> 3, t = (kap >> 2) & 1, c = kap & 3, sub = d0 >> 3; return (size_t)(key >> 5) * 2048 + (t * 2 + (sub >> 2)) * 512 + ((sub & 3) * 16 + 4 * a + c) * 8; }
DI void glds16(const bf16* g, LAS unsigned char* l) { __builtin_amdgcn_global_load_lds((const unsigned*)g, (LAS unsigned*)l, 16, 0, 0); }
DI void kv_dma(LAS unsigned char* slot, const bf16* __restrict__ Kb, const bf16* __restrict__ VTb, int kb, int r, int quad) {
    const bf16* kp = Kb + (size_t)(kb >> 5) * 2048 + (quad * 16 + r) * 8;
    glds16(kp, slot); glds16(kp + 512, slot + 1024); glds16(kp + 1024, slot + 2048); glds16(kp + 1536, slot + 3072);
    const bf16* vp = VTb + (size_t)(kb >> 5) * 2048 + r * 32 + quad * 8;
#pragma unroll
    for (int dt = 0; dt < 4; ++dt) glds16(vp + dt * 512, slot + 4096 + dt * 1024);
}
DI void kv_read(KVF& f, const LAS unsigned char* slot, int lane) {
#pragma unroll
    for (int i = 0; i < 4; ++i) { f.k[i] = *(const LAS bf16x8*)(slot + i * 1024 + lane * 16); f.v[i] = *(const LAS bf16x8*)(slot + 4096 + i * 1024 + lane * 16); }
}
DI void k_dma(LAS unsigned char* slot, const bf16* __restrict__ Kb, int kb, int r, int quad) {
    const bf16* kp = Kb + (size_t)(kb >> 5) * 2048 + (quad * 16 + r) * 8;
    glds16(kp, slot); glds16(kp + 512, slot + 1024); glds16(kp + 1024, slot + 2048); glds16(kp + 1536, slot + 3072);
}
DI void k_read(KVF& f, const LAS unsigned char* slot, int lane) {
#pragma unroll
    for (int i = 0; i < 4; ++i) f.k[i] = *(const LAS bf16x8*)(slot + i * 1024 + lane * 16);
}
#define VM_WAIT(n) asm volatile("s_waitcnt vmcnt(" #n ")" ::: "memory")
DI void mask_bias(unsigned vm, float c2, f32x4& blo, f32x4& bhi) {
#pragma unroll
    for (int jj = 0; jj < 4; ++jj) { blo[jj] = ((vm >> jj) & 1u) ? -c2 : -1e30f; bhi[jj] = ((vm >> (4 + jj)) & 1u) ? -c2 : -1e30f; } }
DI void scores8(const KVF& f, const bf16x8 (&q)[2], const f32x4 blo, const f32x4 bhi, f32x4& s0, f32x4& s1) {
    s0 = mfma16(f.k[0], q[0], blo); s1 = mfma16(f.k[2], q[0], bhi); s0 = mfma16(f.k[1], q[1], s0); s1 = mfma16(f.k[3], q[1], s1); }
DI bf16x8 ones_frag() { return __builtin_bit_cast(bf16x8, (v4u){0x3f803f80u, 0x3f803f80u, 0x3f803f80u, 0x3f803f80u}); }
DI void attn_compute(const KVF& f, unsigned vm, const bf16x8 (&qf)[4][2], f32x4 (&acc)[4][4], f32x4 (&accl)[4], float c2) {
    f32x4 blo, bhi; mask_bias(vm, c2, blo, bhi);
    f32x4 s0[4], s1[4];
#pragma unroll
    for (int g = 0; g < 4; ++g) { s0[g] = mfma16(f.k[0], qf[g][0], blo); s1[g] = mfma16(f.k[2], qf[g][0], bhi); }
#pragma unroll
    for (int g = 0; g < 4; ++g) { s0[g] = mfma16(f.k[1], qf[g][1], s0[g]); s1[g] = mfma16(f.k[3], qf[g][1], s1[g]); }
    const bf16x8 ones = ones_frag();
#pragma unroll
    for (int g = 0; g < 4; ++g) { float p[8];
#pragma unroll
        for (int jj = 0; jj < 4; ++jj) { p[jj] = __builtin_amdgcn_exp2f(s0[g][jj]); p[4 + jj] = __builtin_amdgcn_exp2f(s1[g][jj]); }
        const bf16x8 pf = __builtin_bit_cast(bf16x8, pack8(p));
#pragma unroll
        for (int dt = 0; dt < 4; ++dt) acc[g][dt] = mfma16(f.v[dt], pf, acc[g][dt]);
        accl[g] = mfma16(ones, pf, accl[g]); }
}
DI unsigned win_mask(int kb, int quad, int tok, int W) { unsigned vm = 0u;
#pragma unroll
    for (int jj = 0; jj < 8; ++jj) { const int key = kb + 8 * quad + jj; if (key <= tok && key > tok - W) vm |= 1u << jj; }
    return vm; }
DI void load_q(bf16x8 (&qf)[4][2], const bf16* __restrict__ Q, int b, int hk, int t0, int r, int quad) {
#pragma unroll
    for (int g = 0; g < 4; ++g) { const bf16* qp = Q + ((size_t)(b * 8 + hk * 4 + g) * T + t0 + r) * 64 + quad * 8; qf[g][0] = ldg16(qp); qf[g][1] = ldg16(qp + 32); }
}
DI float wave_max_abs64(const float* __restrict__ g, int lane) { float v = fabsf(g[lane]);
#pragma unroll
    for (int o = 1; o < 64; o <<= 1) v = fmaxf(v, __shfl_xor(v, o));
    return v; }
DI int bal_tile(int wu) { const int u = wu & 255, w = u & 7, q = u >> 3, pair = q * 4 + (w & 3); return (w < 4) ? pair : 255 - pair; }
DI float quad_sum(float v) { v += __shfl_xor(v, 16); v += __shfl_xor(v, 32); return v; }
template <bool SINK, bool TO_MIXED>
DI void window_attn(const bf16* __restrict__ Q, const bf16* __restrict__ Kx, const bf16* __restrict__ VT, int W, const float* __restrict__ sinks, const float* __restrict__ gq, const float* __restrict__ gk,
                    bf16* __restrict__ MIXED, float* __restrict__ ONSA, const bf16* __restrict__ PROJ1, LAS unsigned char* ring, int gw, int NGW, int lane) {
    const int r = lane & 15, quad = lane >> 4; const float sc2 = 0.125f * LOG2E;
    float c2 = sc2 * 64.f * wave_max_abs64(gq, lane) * wave_max_abs64(gk, lane);
    if (SINK) { c2 = fmaxf(c2, fmaxf(fmaxf(sinks[0], sinks[1]), fmaxf(sinks[2], sinks[3])) * LOG2E); c2 = fmaxf(c2, fmaxf(fmaxf(sinks[4], sinks[5]), fmaxf(sinks[6], sinks[7])) * LOG2E); }
    for (int wu = gw; wu < BATCH * 2 * 256; wu += NGW) { const int tile = bal_tile(wu), hk = (wu >> 8) & 1, b = wu >> 9, t0 = tile * 16, tok = t0 + r;
        bf16x8 qf[4][2]; load_q(qf, Q, b, hk, t0, r, quad);
        f32x4 acc[4][4], accl[4];
#pragma unroll
        for (int g = 0; g < 4; ++g) { accl[g] = (f32x4){0.f, 0.f, 0.f, 0.f};
#pragma unroll
            for (int dt = 0; dt < 4; ++dt) acc[g][dt] = (f32x4){0.f, 0.f, 0.f, 0.f}; }
        const bf16* Kb = Kx + (size_t)(b * 2 + hk) * T * 64; const bf16* VTb = VT + (size_t)(b * 2 + hk) * 64 * T;
        int kb0 = t0 - (W - 1); kb0 = kb0 < 0 ? 0 : (kb0 & ~31);
        const int nst = ((t0 & ~31) - kb0) / 32 + 1;
        VM_WAIT(0);
        kv_dma(ring, Kb, VTb, kb0, r, quad); if (nst > 1) kv_dma(ring + 8192, Kb, VTb, kb0 + 32, r, quad);
        for (int st = 0; st < nst; ++st) { KVF cur;
            if (st + 1 < nst) VM_WAIT(8); else VM_WAIT(0);
            kv_read(cur, ring + (st & 1) * 8192, lane); LDS_WAIT();
            if (st + 2 < nst) kv_dma(ring + (st & 1) * 8192, Kb, VTb, kb0 + 32 * (st + 2), r, quad);
            attn_compute(cur, win_mask(kb0 + 32 * st, quad, tok, W), qf, acc, accl, c2); }
        const size_t m = (size_t)b * T + tok;
#pragma unroll
        for (int g = 0; g < 4; ++g) { float l = accl[g][0]; if (SINK) l += __builtin_amdgcn_exp2f(sinks[hk * 4 + g] * LOG2E - c2);
            float inv = l > 0.f ? 1.f / l : 0.f;
            if (!TO_MIXED) { const float gl = __builtin_bit_cast(float, ((unsigned)PROJ1[m * N1P + C1_NG + hk * 12 + g * 3 + 2]) << 16); inv *= 1.f / (1.f + __expf(-gl)); }
#pragma unroll
            for (int dt = 0; dt < 4; ++dt) { const f32x4 o = acc[g][dt] * inv; const int col = (hk * 4 + g) * 64 + dt * 16 + 4 * quad;
                if (TO_MIXED) { v2u w2; w2.x = pk2(o[0], o[1]); w2.y = pk2(o[2], o[3]); *(v2u*)(MIXED + m * 1024 + 512 + col) = w2; }
                else *(f32x4*)(ONSA + m * 512 + col) = o; } }
    }
}

#ifndef PROBE_A
#define PROBE_A -1
#endif
#define SUBSTAMP(k) do { if (PROBE_A >= 0 && blockIdx.x == 0 && threadIdx.x == 256) ((volatile LAS unsigned long long*)(plds - 4 * 4096 + (MISC_OFF + 128) / 4))[k] = __builtin_amdgcn_s_memrealtime(); } while (0)
DI void nsa_cmp_slc(const bf16* __restrict__ Q, const bf16* __restrict__ KCB, const bf16* __restrict__ VCBT, const bf16* __restrict__ KSL, const bf16* __restrict__ VSLT,
                    const float* __restrict__ gq, const float* __restrict__ gkc, const float* __restrict__ gks,
                    const bf16* __restrict__ PROJ1, float* __restrict__ ONSA, bf16* __restrict__ MIXED, LAS unsigned char* lds, int w, int gw, int NGW, int lane) {
    LAS float* plds = (LAS float*)(lds + w * 16384);
    const int r = lane & 15, quad = lane >> 4; const float sc2 = 0.125f * LOG2E;
    const float gqm = wave_max_abs64(gq, lane); const float c2c = sc2 * 64.f * gqm * wave_max_abs64(gkc, lane), c2s = sc2 * 64.f * gqm * wave_max_abs64(gks, lane);
    for (int wu = gw; wu < BATCH * 2 * 256; wu += NGW) { const int tile = bal_tile(wu), hk = (wu >> 8) & 1, b = wu >> 9, t0 = tile * 16, tok = t0 + r;
        bf16x8 qf[4][2]; load_q(qf, Q, b, hk, t0, r, quad);
        const size_t m = (size_t)b * T + tok;
        LAS unsigned char* ring = (LAS unsigned char*)plds; LAS float* imain = plds + 2048; LAS float* icarry = plds + 3072;
#pragma unroll
        for (int i = 0; i < 8; ++i) *(LAS f32x4*)(imain + (i * 64 + lane) * 4) = (f32x4){0.f, 0.f, 0.f, 0.f};
        const bf16* Kc = KCB + (size_t)(b * 2 + hk) * 256 * 64; const bf16* Vc = VCBT + (size_t)(b * 2 + hk) * 64 * 256;
        const int nsteps = ((t0 >> 4) + 31) >> 5;
        f32x4 accl[4];
#pragma unroll
        for (int g = 0; g < 4; ++g) accl[g] = (f32x4){0.f, 0.f, 0.f, 0.f};
        VM_WAIT(0);
        if (nsteps > 0) k_dma(ring, Kc, 0, r, quad);
        for (int st = 0; st < nsteps; ++st) { const int kb = 32 * st; KVF cur;
            VM_WAIT(0); k_read(cur, ring, lane); LDS_WAIT();
            if (st + 1 < nsteps) k_dma(ring, Kc, kb + 32, r, quad);
            unsigned vm = 0u;
#pragma unroll
            for (int jj = 0; jj < 8; ++jj) if (16 * (kb + 8 * quad + jj) + 31 <= tok) vm |= 1u << jj;
            f32x4 blo, bhi; mask_bias(vm, c2c, blo, bhi); const bf16x8 ones = ones_frag();
#pragma unroll
            for (int g = 0; g < 4; ++g) { f32x4 s0, s1; scores8(cur, qf[g], blo, bhi, s0, s1); float p[8];
#pragma unroll
                for (int jj = 0; jj < 4; ++jj) { p[jj] = __builtin_amdgcn_exp2f(s0[jj]); p[4 + jj] = __builtin_amdgcn_exp2f(s1[jj]); }
                accl[g] = mfma16(ones, __builtin_bit_cast(bf16x8, pack8(p)), accl[g]); } }
        float invl[4];
#pragma unroll
        for (int g = 0; g < 4; ++g) { const float l = accl[g][0]; invl[g] = l > 0.f ? 1.f / l : 0.f; }
        f32x4 acc[4][4];
#pragma unroll
        for (int g = 0; g < 4; ++g)
#pragma unroll
            for (int dt = 0; dt < 4; ++dt) acc[g][dt] = (f32x4){0.f, 0.f, 0.f, 0.f};
        if (nsteps > 0) kv_dma(ring, Kc, Vc, 0, r, quad);
        for (int st = 0; st < nsteps; ++st) { const int kb = 32 * st; KVF cur;
            VM_WAIT(0); kv_read(cur, ring, lane); LDS_WAIT();
            if (st + 1 < nsteps) kv_dma(ring, Kc, Vc, kb + 32, r, quad);
            unsigned vm = 0u;
#pragma unroll
            for (int jj = 0; jj < 8; ++jj) if (16 * (kb + 8 * quad + jj) + 31 <= tok) vm |= 1u << jj;
            f32x4 blo, bhi; mask_bias(vm, c2c, blo, bhi);
            float ps[8];
#pragma unroll
            for (int jj = 0; jj < 8; ++jj) ps[jj] = 0.f;
#pragma unroll
            for (int g = 0; g < 4; ++g) { f32x4 s0, s1; scores8(cur, qf[g], blo, bhi, s0, s1); float p[8];
#pragma unroll
                for (int jj = 0; jj < 4; ++jj) { p[jj] = __builtin_amdgcn_exp2f(s0[jj]) * invl[g]; p[4 + jj] = __builtin_amdgcn_exp2f(s1[jj]) * invl[g]; }
#pragma unroll
                for (int jj = 0; jj < 8; ++jj) ps[jj] += p[jj];
                const bf16x8 pf = __builtin_bit_cast(bf16x8, pack8(p));
#pragma unroll
                for (int dt = 0; dt < 4; ++dt) acc[g][dt] = mfma16(cur.v[dt], pf, acc[g][dt]); }
            const int j0 = (kb >> 2) + 2 * quad;
            f32x2_t mv; mv.x = 2.f * (ps[0] + ps[1] + ps[2]) + ps[3]; mv.y = ps[3] + 2.f * (ps[4] + ps[5] + ps[6]) + ps[7];
            *(LAS f32x2_t*)(imain + r * 64 + j0) = mv;
            if (j0 + 2 < 64) icarry[r * 64 + j0 + 2] = ps[7]; }
#pragma unroll
        for (int g = 0; g < 4; ++g) { const float gate0 = 1.f / (1.f + __expf(-__builtin_bit_cast(float, ((unsigned)PROJ1[m * N1P + C1_NG + hk * 12 + g * 3]) << 16)));
#pragma unroll
            for (int dt = 0; dt < 4; ++dt) { float* op = ONSA + m * 512 + (hk * 4 + g) * 64 + dt * 16 + 4 * quad; *(f32x4*)op = *(const f32x4*)op + acc[g][dt] * gate0; } }
        LDS_WAIT(); asm volatile("" ::: "memory"); __builtin_amdgcn_wave_barrier();
        unsigned long long mymask = 0ull, uni = 0ull;
        for (int tk = 0; tk < 16; ++tk) { const int tblk = (t0 + tk) >> 6, j = lane;
            const float imp = imain[tk * 64 + j] + icarry[tk * 64 + j];
            const bool forced = (j == 0) || (j == tblk) || (j == tblk - 1), allowed = j <= tblk;
            const float score = forced ? 1e9f : (allowed ? imp : -1e9f);
            unsigned u = __builtin_bit_cast(unsigned, score); u = (u & 0x80000000u) ? ~u : (u | 0x80000000u);
            const unsigned key = (u & ~63u) | (unsigned)(63 - j);
            unsigned prefix = 0u;
#pragma unroll
            for (int bit = 31; bit >= 0; --bit) { const unsigned cand = prefix | (1u << bit); const unsigned long long ge = __ballot(key >= cand); if (__builtin_popcountll(ge) >= 16) prefix = cand; }
            const unsigned long long mask = __ballot((key >= prefix) && allowed);
            if (r == tk) mymask = mask;
            uni |= mask; }
#pragma unroll
        for (int g = 0; g < 4; ++g) { accl[g] = (f32x4){0.f, 0.f, 0.f, 0.f};
#pragma unroll
            for (int dt = 0; dt < 4; ++dt) acc[g][dt] = (f32x4){0.f, 0.f, 0.f, 0.f}; }
        const bf16* Kb = KSL + (size_t)(b * 2 + hk) * T * 64; const bf16* VTb = VSLT + (size_t)(b * 2 + hk) * 64 * T;
        {   LAS unsigned long long* xu = (LAS unsigned long long*)(lds + LDSCTL_OFF + 2048);
            if (lane == 0) xu[w] = uni;
            VM_WAIT(0); LDS_WAIT();
            __syncthreads();
            unsigned long long wgu = 0ull;
#pragma unroll
            for (int i = 0; i < 8; ++i) wgu |= xu[i];
            constexpr int NB = 4;
            const int n = __builtin_popcountll(wgu); unsigned long long remi = wgu, remc = wgu;
            const bf16* src0 = (w < 4) ? Kb + w * 512 + lane * 8 : VTb + (w - 4) * 512 + r * 32 + quad * 8;
            auto blk_dma = [&](int bufi, int j) { LAS unsigned char* bp = lds + bufi * 16384 + w * 1024;
                glds16(src0 + (size_t)(2 * j) * 2048, bp); glds16(src0 + (size_t)(2 * j + 1) * 2048, bp + 8192); };
            for (int k = 0; k < NB - 1 && k < n; ++k) { const int j = __builtin_ctzll(remi); remi &= remi - 1ull; blk_dma(k, j); }
            for (int i = 0; i < n; ++i) { const int left = n - 1 - i;
                if (left >= 2) VM_WAIT(4); else if (left == 1) VM_WAIT(2); else VM_WAIT(0);
                __syncthreads();
                if (i + NB - 1 < n) { const int j2 = __builtin_ctzll(remi); remi &= remi - 1ull; blk_dma((i + NB - 1) % NB, j2); }
                const int j = __builtin_ctzll(remc); remc &= remc - 1ull;
                if ((uni >> j) & 1ull) { const bool sb = (mymask >> j) & 1ull; const LAS unsigned char* bp = lds + (i % NB) * 16384;
#pragma unroll
                    for (int hf = 0; hf < 2; ++hf) { KVF cur; kv_read(cur, bp + hf * 8192, lane); LDS_WAIT();
                        const int kb = 64 * j + 32 * hf; unsigned vm = 0u;
#pragma unroll
                        for (int jj = 0; jj < 8; ++jj) if (sb && (kb + 8 * quad + jj <= tok)) vm |= 1u << jj;
                        attn_compute(cur, vm, qf, acc, accl, c2s); } } }
            __syncthreads();
        }
#pragma unroll
        for (int g = 0; g < 4; ++g) { const float l = accl[g][0]; const float gate1 = 1.f / (1.f + __expf(-__builtin_bit_cast(float, ((unsigned)PROJ1[m * N1P + C1_NG + hk * 12 + g * 3 + 1]) << 16)));
            const float inv = (l > 0.f ? 1.f / l : 0.f) * gate1;
#pragma unroll
            for (int dt = 0; dt < 4; ++dt) { const int col = (hk * 4 + g) * 64 + dt * 16 + 4 * quad; const f32x4 o = *(const f32x4*)(ONSA + m * 512 + col) + acc[g][dt] * inv;
                v2u w2; w2.x = pk2(o[0], o[1]); w2.y = pk2(o[2], o[3]); *(v2u*)(MIXED + m * 1024 + 512 + col) = w2; } }
        __builtin_amdgcn_wave_barrier();
    }
}
DI float gelu_tanh(float x) { const float u = 0.7978845608028654f * (x + 0.044715f * x * x * x); const float e = __expf(2.f * u); const float th = 1.f - 2.f / (e + 1.f); return 0.5f * x * (1.f + th); }
DI void cmp_layer2(const float* __restrict__ CMPH, const bf16* __restrict__ W2T, const float* __restrict__ b2k, const float* __restrict__ b2v,
                   const float* __restrict__ kcnorm, const float* __restrict__ rope1, bf16* __restrict__ KCB, bf16* __restrict__ VCBT, int u0, int u1, int ustep, int lane) {
    const int r = lane & 15, quad = lane >> 4;
    for (int wu = u0; wu < u1; wu += ustep) { const int kv = wu >> 7, rt = wu & 127;
        const float* hp = CMPH + ((size_t)kv * 2048 + rt * 16 + r) * 256 + quad * 8; const bf16* wp = W2T + (size_t)kv * 64 * 256 + (size_t)r * 256 + quad * 8;
        f32x4 acc[4];
#pragma unroll
        for (int nt = 0; nt < 4; ++nt) acc[nt] = (f32x4){0.f, 0.f, 0.f, 0.f};
        f32x4 hv[16];
#pragma unroll
        for (int kk = 0; kk < 8; ++kk) { hv[2 * kk] = *(const f32x4*)(hp + kk * 32); hv[2 * kk + 1] = *(const f32x4*)(hp + kk * 32 + 4); }
#pragma unroll
        for (int kk = 0; kk < 8; ++kk) { bf16x8 wf[4];
#pragma unroll
            for (int nt = 0; nt < 4; ++nt) wf[nt] = ldg16(wp + (size_t)nt * 16 * 256 + kk * 32);
            float ge[8];
#pragma unroll
            for (int i = 0; i < 4; ++i) { ge[i] = gelu_tanh(hv[2 * kk][i]); ge[4 + i] = gelu_tanh(hv[2 * kk + 1][i]); }
            const bf16x8 af = __builtin_bit_cast(bf16x8, pack8(ge));
#pragma unroll
            for (int nt = 0; nt < 4; ++nt) acc[nt] = mfma16(af, wf[nt], acc[nt]); }
        const float* b2 = kv ? b2v : b2k;
#pragma unroll
        for (int nt = 0; nt < 4; ++nt) { const float bb = b2[nt * 16 + r]; acc[nt] = acc[nt] + bb; }
#pragma unroll
        for (int i = 0; i < 4; ++i) { const int row = rt * 16 + 4 * quad + i, bh = row >> 8, n = row & 255; const bool pad = (n == 255);
            if (kv == 0) { float ss = 0.f;
#pragma unroll
                for (int nt = 0; nt < 4; ++nt) ss += acc[nt][i] * acc[nt][i];
                ss = sum16(ss); const float rstd = 1.f / sqrtf(ss * (1.f / 64.f) + EPS);
                float y[4];
#pragma unroll
                for (int nt = 0; nt < 4; ++nt) y[nt] = acc[nt][i] * rstd * kcnorm[nt * 16 + r];
                const float other = dppf<0x128>(y[0]);
                const float* cs = rope1 + ((size_t)(bh >> 1) * T + (pad ? 0 : 16 * n + 31)) * 16;
                y[0] = (r < 8) ? y[0] * cs[r] - other * cs[8 + r] : y[0] * cs[r - 8] + other * cs[r];
#pragma unroll
                for (int nt = 0; nt < 4; ++nt) { const int d = nt * 16 + r; KCB[(size_t)bh * 256 * 64 + kblk_off(n, d & ~7) + (d & 7)] = pad ? (bf16)0 : (bf16)f2bf(y[nt]); }
            } else {
#pragma unroll
                for (int nt = 0; nt < 4; ++nt) VCBT[(((size_t)bh * 8 + (n >> 5)) * 64 + nt * 16 + r) * 32 + (n & 31)] = pad ? (bf16)0 : (bf16)f2bf(acc[nt][i]);
            } }
    }
}

DI void prep0_swa(const bf16* __restrict__ PROJ, const float* __restrict__ qn, const float* __restrict__ kn, const float* __restrict__ rope1,
                  bf16* __restrict__ QS, bf16* __restrict__ KS, bf16* __restrict__ VST, int lane, int w, int bid, int G) {
    for (int grp = bid; grp < M / 64; grp += G) { const int m0 = grp * 64, b = m0 / T, t0 = m0 % T;
#pragma unroll
        for (int i = 0; i < 8; ++i) { const int tl = 8 * w + i; const size_t m = (size_t)m0 + tl;
            q8_token(PROJ + m * N0P + C0_SQ, qn, rope1 + m * 16, QS + ((size_t)(b * 8) * T + t0 + tl) * 64, (size_t)T * 64, lane); }
#pragma unroll
        for (int p = 0; p < 2; ++p) { const int tl = 8 * w + 4 * p + (lane >> 4), head = (lane >> 3) & 1, sub = lane & 7; const size_t m = (size_t)m0 + tl; float x[8];
            unpack8(*(const v4u*)(PROJ + m * N0P + C0_SK + head * 64 + sub * 8), x); head_norm_rope(x, kn, sub, rope1 + m * 16);
            *(v4u*)(KS + (size_t)(b * 2 + head) * T * 64 + kblk_off(t0 + tl, sub * 8)) = pack8(x); }
        { const size_t m = (size_t)m0 + lane; const v4u a = *(const v4u*)(PROJ + m * N0P + C0_SV + 16 * w), c = *(const v4u*)(PROJ + m * N0P + C0_SV + 16 * w + 8);
            const unsigned wv[8] = {a.x, a.y, a.z, a.w, c.x, c.y, c.z, c.w};
#pragma unroll
            for (int i = 0; i < 16; ++i) { const int hd = 16 * w + i; VST[(((size_t)(b * 2 + (hd >> 6)) * (T / 32) + ((t0 + lane) >> 5)) * 64 + (hd & 63)) * 32 + ((t0 + lane) & 31)] = (bf16)((i & 1) ? (wv[i >> 1] >> 16) : (wv[i >> 1] & 0xffffu)); } }
    }
}
DI void prep1_nsa(const bf16* __restrict__ PROJ, const float* __restrict__ qn, const float* __restrict__ ksn, const float* __restrict__ kwn, const float* __restrict__ rope1,
                  bf16* __restrict__ QS, bf16* __restrict__ KS, bf16* __restrict__ KW, bf16* __restrict__ KCR, bf16* __restrict__ VCR, bf16* __restrict__ VST, bf16* __restrict__ VWT,
                  int lane, int w, int bid, int G) {
    for (int grp = bid; grp < M / 64; grp += G) { const int m0 = grp * 64, b = m0 / T, t0 = m0 % T;
#pragma unroll
        for (int i = 0; i < 8; ++i) { const int tl = 8 * w + i; const size_t m = (size_t)m0 + tl;
            q8_token(PROJ + m * N1P + C1_NQ, qn, rope1 + m * 16, QS + ((size_t)(b * 8) * T + t0 + tl) * 64, (size_t)T * 64, lane); }
#pragma unroll
        for (int p = 0; p < 2; ++p) { const int tl = 8 * w + 4 * p + (lane >> 4), head = (lane >> 3) & 1, sub = lane & 7; const size_t m = (size_t)m0 + tl; float x[8];
            const size_t dsto = ((size_t)(b * 2 + head) * T + t0 + tl) * 64 + sub * 8, dstk = (size_t)(b * 2 + head) * T * 64 + kblk_off(t0 + tl, sub * 8);
            unpack8(*(const v4u*)(PROJ + m * N1P + C1_KSL + head * 64 + sub * 8), x); head_norm_rope(x, ksn, sub, rope1 + m * 16); *(v4u*)(KS + dstk) = pack8(x);
            unpack8(*(const v4u*)(PROJ + m * N1P + C1_KWN + head * 64 + sub * 8), x); head_norm_rope(x, kwn, sub, rope1 + m * 16); *(v4u*)(KW + dstk) = pack8(x);
            *(v4u*)(KCR + dsto) = *(const v4u*)(PROJ + m * N1P + C1_KC + head * 64 + sub * 8);
            *(v4u*)(VCR + dsto) = *(const v4u*)(PROJ + m * N1P + C1_VC + head * 64 + sub * 8); }
#pragma unroll
        for (int which = 0; which < 2; ++which) { const size_t m = (size_t)m0 + lane; const int cbase = which ? C1_VWN : C1_VSL; bf16* dst = which ? VWT : VST;
            const v4u a = *(const v4u*)(PROJ + m * N1P + cbase + 16 * w), c = *(const v4u*)(PROJ + m * N1P + cbase + 16 * w + 8);
            const unsigned wv[8] = {a.x, a.y, a.z, a.w, c.x, c.y, c.z, c.w};
#pragma unroll
            for (int i = 0; i < 16; ++i) { const int hd = 16 * w + i; dst[(((size_t)(b * 2 + (hd >> 6)) * (T / 32) + ((t0 + lane) >> 5)) * 64 + (hd & 63)) * 32 + ((t0 + lane) & 31)] = (bf16)((i & 1) ? (wv[i >> 1] >> 16) : (wv[i >> 1] & 0xffffu)); } }
    }
}

DI void moe_route(const bf16* __restrict__ H, const float* __restrict__ gln, const float* __restrict__ rw, const float* __restrict__ rb, bf16* __restrict__ XN,
                  int* __restrict__ TOKE, float* __restrict__ TOKW, int* __restrict__ TOKR, unsigned* CNT, LAS unsigned char* lds, int tid, int lane, int w, int bid, int G) {
    LAS unsigned* lcnt = (LAS unsigned*)lds; LAS int* le = (LAS int*)(lds + 64); LAS int* lr = (LAS int*)(lds + 64 + 512);
    for (int blk = bid; blk < M / 64; blk += G) {
        if (tid < 16) lcnt[tid] = 0u;
        __syncthreads();
#pragma unroll 1
        for (int hb = 0; hb < 2; ++hb) {
        v4u vv[4][2];
#pragma unroll
        for (int i = 0; i < 4; ++i) { const v4u* xr = (const v4u*)(H + ((size_t)blk * 64 + 8 * w + 4 * hb + i) * D) + lane; vv[i][0] = xr[0]; vv[i][1] = xr[64]; }
#pragma unroll
        for (int i = 0; i < 4; ++i) { const int rl = 8 * w + 4 * hb + i; const size_t m = (size_t)blk * 64 + rl; float x[16]; { float t8[8]; unpack8(vv[i][0], t8);
#pragma unroll
                for (int c = 0; c < 8; ++c) x[c] = t8[c];
                unpack8(vv[i][1], t8);
#pragma unroll
                for (int c = 0; c < 8; ++c) x[8 + c] = t8[c]; }
            float s = 0.f;
#pragma unroll
            for (int c = 0; c < 16; ++c) s += x[c] * x[c];
            const float rstd = 1.f / sqrtf(wave_sum(s) * (1.f / D) + EPS);
            v4u o0, o1; o0.x = pk2(x[0] * rstd, x[1] * rstd); o0.y = pk2(x[2] * rstd, x[3] * rstd); o0.z = pk2(x[4] * rstd, x[5] * rstd); o0.w = pk2(x[6] * rstd, x[7] * rstd);
            o1.x = pk2(x[8] * rstd, x[9] * rstd); o1.y = pk2(x[10] * rstd, x[11] * rstd); o1.z = pk2(x[12] * rstd, x[13] * rstd); o1.w = pk2(x[14] * rstd, x[15] * rstd);
            v4u* orow = (v4u*)(XN + m * D) + lane; orow[0] = o0; orow[64] = o1;
            float lg[8];
#pragma unroll
            for (int e = 0; e < 8; ++e) lg[e] = 0.f;
#pragma unroll
            for (int c = 0; c < 16; ++c) { const int col = (c < 8) ? 8 * lane + c : 512 + 8 * lane + (c - 8); const float xv = x[c] * rstd * gln[col]; const f32x4* wr = (const f32x4*)(rw + (size_t)col * 8); const f32x4 a = wr[0], bq = wr[1];
                lg[0] += xv * a[0]; lg[1] += xv * a[1]; lg[2] += xv * a[2]; lg[3] += xv * a[3]; lg[4] += xv * bq[0]; lg[5] += xv * bq[1]; lg[6] += xv * bq[2]; lg[7] += xv * bq[3]; }
#pragma unroll
            for (int e = 0; e < 8; ++e) lg[e] = wave_sum(lg[e]) + rb[e];
            if (lane == 0) { float v1 = lg[0]; int e1 = 0;
#pragma unroll
                for (int e = 1; e < 8; ++e) if (lg[e] > v1) { v1 = lg[e]; e1 = e; }
                float v2 = -3.0e38f; int e2 = 0;
#pragma unroll
                for (int e = 0; e < 8; ++e) if (e != e1 && lg[e] > v2) { v2 = lg[e]; e2 = e; }
                const float w1 = 1.f / (1.f + expf(v2 - v1));
                TOKE[2 * m] = e1; TOKE[2 * m + 1] = e2; TOKW[2 * m] = w1; TOKW[2 * m + 1] = 1.f - w1;
                le[2 * rl] = e1; le[2 * rl + 1] = e2; lr[2 * rl] = (int)atomicAdd((unsigned*)&lcnt[e1], 1u); lr[2 * rl + 1] = (int)atomicAdd((unsigned*)&lcnt[e2], 1u); }
        }
        }
        __syncthreads();
        if (tid < 8) lcnt[8 + tid] = __hip_atomic_fetch_add(CNT + tid, lcnt[tid], __ATOMIC_RELAXED, __HIP_MEMORY_SCOPE_AGENT);
        __syncthreads();
        if (tid < 128) { const size_t m = (size_t)blk * 64 + (tid >> 1); TOKR[2 * m + (tid & 1)] = lr[tid] + (int)lcnt[8 + le[tid]]; }
        __syncthreads();
    }
}
DI void moe_dispatch(unsigned* CNT, const bf16* __restrict__ XN, const int* __restrict__ TOKE, const int* __restrict__ TOKR, int* __restrict__ TOKS, bf16* __restrict__ XS,
                     int* __restrict__ TILEE, unsigned* NTW, LAS unsigned char* lds, int tid, int lane, int w, int bid, int G) {
    LAS int* lbase = (LAS int*)lds;
    if (tid == 0) { int acc = 0;
        for (int e = 0; e < 8; ++e) { const int c = (int)__hip_atomic_load(CNT + e, __ATOMIC_RELAXED, __HIP_MEMORY_SCOPE_AGENT); lbase[e] = acc; lbase[16 + e] = c; acc += (c + 255) & ~255; }
        lbase[8] = acc; }
    __syncthreads();
    const int ntiles = lbase[8] >> 8;
    if (bid == 0) { for (int t = tid; t < ntiles; t += 512) { int e = 0;
#pragma unroll
            for (int k = 1; k < 8; ++k) if (t * 256 >= lbase[k]) e = k;
            TILEE[t] = e; }
        if (tid == 0) *NTW = (unsigned)ntiles; }
    const int gw = bid * NWAVES + w, NGW = G * NWAVES;
    for (int m0 = gw; m0 < M; m0 += 2 * NGW) {
        int slot[2][2]; v4u va[2][2]; bool ok[2];
#pragma unroll
        for (int q = 0; q < 2; ++q) { const int m = m0 + q * NGW; ok[q] = m < M; const int mm = ok[q] ? m : m0;
            const v4u* src = (const v4u*)(XN + (size_t)mm * D) + lane; va[q][0] = src[0]; va[q][1] = src[64];
#pragma unroll
            for (int k = 0; k < 2; ++k) slot[q][k] = lbase[TOKE[2 * mm + k]] + TOKR[2 * mm + k]; }
#pragma unroll
        for (int q = 0; q < 2; ++q) if (ok[q]) { const int m = m0 + q * NGW;
#pragma unroll
            for (int k = 0; k < 2; ++k) { if (lane == 0) TOKS[2 * m + k] = slot[q][k];
                v4u* dst = (v4u*)(XS + (size_t)slot[q][k] * D) + lane; dst[0] = va[q][0]; dst[64] = va[q][1]; } } }
    for (int e = 0; e < 8; ++e) { const int lo = lbase[e] + lbase[16 + e], hi = lbase[e + 1];
        for (int row = lo + gw; row < hi; row += NGW) { v4u* dst = (v4u*)(XS + (size_t)row * D) + lane; dst[0] = (v4u){0u, 0u, 0u, 0u}; dst[64] = (v4u){0u, 0u, 0u, 0u}; } }
}
template <class BarF>
DI void moe_combine(float* __restrict__ OUT, const bf16* __restrict__ HB, const bf16* __restrict__ Y, const bf16* __restrict__ PART, const int* __restrict__ TOKS, const float* __restrict__ TOKW, int gw, int NGW, int lane, BarF&& grid_barrier) {
    constexpr int OVR = 2 * HALFTILES * 256, RPW = 8;
    f32x4 res[RPW][4];
#pragma unroll
    for (int q = 0; q < RPW; ++q) { const int m = gw + q * NGW; const bool ok = m < M; const int mm = ok ? m : gw;
        const int s0 = TOKS[2 * mm], s1 = TOKS[2 * mm + 1]; const float w0 = TOKW[2 * mm], w1 = TOKW[2 * mm + 1];
#pragma unroll
        for (int j = 0; j < 4; ++j) { const int col = lane * 4 + 256 * j; const v2u hb = *(const v2u*)(HB + (size_t)mm * D + col);
            f32x4 o = (f32x4){bflo(hb.x), bfhi(hb.x), bflo(hb.y), bfhi(hb.y)};
#pragma unroll
            for (int k = 0; k < 2; ++k) { const int sl = k ? s1 : s0; const float wt = k ? w1 : w0; float y0, y1, y2, y3;
                if (sl < OVR) { const v2u a = *(const v2u*)(Y + (size_t)sl * D + col); y0 = bflo(a.x); y1 = bfhi(a.x); y2 = bflo(a.y); y3 = bfhi(a.y); }
                else { y0 = y1 = y2 = y3 = 0.f;
                    for (int ks = 0; ks < NSPLIT; ++ks) { const v2u a = *(const v2u*)(PART + ((size_t)ks * 8 * 256 + (sl - OVR)) * D + col); y0 += bflo(a.x); y1 += bfhi(a.x); y2 += bflo(a.y); y3 += bfhi(a.y); } }
                o[0] += wt * y0; o[1] += wt * y1; o[2] += wt * y2; o[3] += wt * y3; }
            res[q][j] = o; }
        if (q & 1) asm volatile("" : "+v"(res[q][0]), "+v"(res[q][1]), "+v"(res[q][2]), "+v"(res[q][3]), "+v"(res[q - 1][0]), "+v"(res[q - 1][1]), "+v"(res[q - 1][2]), "+v"(res[q - 1][3]) :: "memory"); }
    grid_barrier();
#pragma unroll
    for (int q = 0; q < RPW; ++q) { const int m = gw + q * NGW;
        if (m < M) {
#pragma unroll
            for (int j = 0; j < 4; ++j) *(f32x4*)(OUT + (size_t)m * D + lane * 4 + 256 * j) = res[q][j]; } }
}

#ifndef ONE_LAUNCH
#define ONE_LAUNCH 1
#endif
#ifndef STOP_PHASE
#define STOP_PHASE 23
#endif
constexpr int NPHASE = 23;
#ifndef EARLY1
#define EARLY1 640
#endif
#ifndef EARLY2
#define EARLY2 1280
#endif
#ifndef DUP_MASK
#define DUP_MASK 0u
#endif
#define DUPN(k) (int)((DUP_MASK >> (k)) & 1u)
#define REP(k) _Pragma("unroll") for (int rep = 0; rep <= DUPN(k); ++rep)
#define REPBAR() do { if (rep) xcd_barrier(bar); } while (0)
#define REPRT(k) _Pragma("unroll 1") for (int rep = 0; rep <= DUPN(k); ++rep)
struct Args { const void* in[39]; float* out; unsigned char* ws; int ph_lo, ph_hi; };

__global__ void __launch_bounds__(NWAVES * 64, 2) hybrid_fwd(Args args) {
    extern __shared__ __attribute__((aligned(16))) unsigned char lds_raw[];
    LAS unsigned char* lds = (LAS unsigned char*)lds_raw;
    const int tid = threadIdx.x, lane = tid & 63, w = __builtin_amdgcn_readfirstlane(tid >> 6);
    const int G = gridDim.x, bid = blockIdx.x;
    const int gw = bid * NWAVES + w, NGW = G * NWAVES, gtid = bid * (NWAVES * 64) + tid, NTH = G * NWAVES * 64;
    unsigned char* ws = args.ws;
    unsigned* CTL = (unsigned*)(ws + WS_CTL);
    for (int u = tid; u < (LDS_BYTES - LDSCTL_OFF) / 4; u += NWAVES * 64) ((LAS unsigned*)(lds + LDSCTL_OFF))[u] = 0u;
    __syncthreads();
    XcdBarrier bar; bar.bar = CTL + CW_BAR; bar.x = 0; bar.st = nullptr;
    if (ONE_LAUNCH) bar = xcd_barrier_post(CTL + CW_BAR, (volatile LAS unsigned*)(lds + MISC_OFF) + 8);
    const int lo = args.ph_lo, hi = args.ph_hi < STOP_PHASE ? args.ph_hi : STOP_PHASE;
#define IN(k) (lo <= (k) && (k) < hi)
#ifndef PROBE_A
#define PROBE_A -1
#endif
#ifndef PROBE_B
#define PROBE_B -1
#endif
#ifndef PROBE_AE
#define PROBE_AE (PROBE_A + 1)
#endif
#ifndef PROBE_BE
#define PROBE_BE (PROBE_B + 1)
#endif
    volatile LAS unsigned long long* stamps = (volatile LAS unsigned long long*)(lds + MISC_OFF + 128);
#define STAMP(k) do { if (PROBE_A >= 0 && bid == 0 && tid == 0) stamps[k] = __builtin_amdgcn_s_memrealtime(); } while (0)
#define SEAM(k) do { if (ONE_LAUNCH && IN(k) && IN((k) + 1)) xcd_barrier(bar); STAMP((k) + 1); } while (0)
    STAMP(0);

    const float* x = (const float*)args.in[0]; const int* positions = (const int*)args.in[1];
    const float* ln_mix_e = (const float*)args.in[2]; const float* w_in_e = (const float*)args.in[3];
    const float* gla_gate_up = (const float*)args.in[4]; const float* gla_gate_bias = (const float*)args.in[5]; const float* gla_out_norm = (const float*)args.in[6];
    const float* swa_q_norm = (const float*)args.in[7]; const float* swa_k_norm = (const float*)args.in[8]; const float* swa_sinks = (const float*)args.in[9];
    const float* w_out_e = (const float*)args.in[10]; const float* ln_ffn_e = (const float*)args.in[11];
    const float* ffn_w_gate = (const float*)args.in[12]; const float* ffn_w_up = (const float*)args.in[13]; const float* ffn_w_down = (const float*)args.in[14];
    const float* ln_mix_o = (const float*)args.in[15]; const float* w_in_o = (const float*)args.in[16]; const float* ret_out_norm = (const float*)args.in[17];
    const float* nsa_q_norm = (const float*)args.in[18]; const float* nsa_kc_norm = (const float*)args.in[19]; const float* nsa_ks_norm = (const float*)args.in[20]; const float* nsa_kw_norm = (const float*)args.in[21];
    const float* cmp_pos_k = (const float*)args.in[22]; const float* cmp_w1_k = (const float*)args.in[23]; const float* cmp_b1_k = (const float*)args.in[24]; const float* cmp_w2_k = (const float*)args.in[25]; const float* cmp_b2_k = (const float*)args.in[26];
    const float* cmp_pos_v = (const float*)args.in[27]; const float* cmp_w1_v = (const float*)args.in[28]; const float* cmp_b1_v = (const float*)args.in[29]; const float* cmp_w2_v = (const float*)args.in[30]; const float* cmp_b2_v = (const float*)args.in[31];
    const float* w_out_o = (const float*)args.in[32]; const float* ln_ffn_o = (const float*)args.in[33]; const float* router_w = (const float*)args.in[34]; const float* router_b = (const float*)args.in[35];
    const float* exp_w_gate = (const float*)args.in[36]; const float* exp_w_up = (const float*)args.in[37]; const float* exp_w_down = (const float*)args.in[38];
    float* out = args.out; bf16* HB = (bf16*)args.out;
    float* ROPE1 = (float*)(ws + WS_ROPE1); float* ROPE2 = (float*)(ws + WS_ROPE2);
    bf16* WIN0 = (bf16*)(ws + WS_WIN0); bf16* WOUT0 = (bf16*)(ws + WS_WOUT0); bf16* WGU = (bf16*)(ws + WS_WGU); bf16* WDN = (bf16*)(ws + WS_WDN);
    bf16* WIN1 = (bf16*)(ws + WS_WIN1); bf16* WOUT1 = (bf16*)(ws + WS_WOUT1); bf16* WCMP = (bf16*)(ws + WS_WCMP); bf16* MOEGU = (bf16*)(ws + WS_MOEGU); bf16* MOED = (bf16*)(ws + WS_MOED);
    bf16* XN = (bf16*)(ws + WS_XN); bf16* MIXED = XN; bf16* PROJ = (bf16*)(ws + WS_PROJ); bf16* ACT = PROJ;
    bf16* QS = (bf16*)(ws + WS_QS); bf16* KS = (bf16*)(ws + WS_KS); bf16* VST = (bf16*)(ws + WS_VST);
    bf16* QIN = (bf16*)(ws + WS_QIN); bf16* OINTRA = (bf16*)(ws + WS_OINTRA); bf16* SB = (bf16*)(ws + WS_SB); float* UT = (float*)(ws + WS_UT); float* DEC = (float*)(ws + WS_DEC);
    float* ONSA = (float*)(ws + WS_ONSA); float* CMPH = (float*)(ws + WS_CMPH);
    bf16* KCR = (bf16*)(ws + WS_KCR); bf16* VCR = (bf16*)(ws + WS_VCR); bf16* KW = (bf16*)(ws + WS_KW); bf16* VWT = (bf16*)(ws + WS_VWT);
    bf16* KCB = (bf16*)(ws + WS_CMPT + CT_KCB); bf16* VCBT = (bf16*)(ws + WS_CMPT + CT_VCBT); float* B1P = (float*)(ws + WS_CMPT + CT_B1P); bf16* W2T = (bf16*)(ws + WS_CMPT + CT_W2T);
    int* TOKE = (int*)(ws + WS_TAB + TB_TOKE); float* TOKW = (float*)(ws + WS_TAB + TB_TOKW); int* TOKR = (int*)(ws + WS_TAB + TB_TOKR); int* TOKS = (int*)(ws + WS_TAB + TB_TOKS); int* TILEE = (int*)(ws + WS_TAB + TB_TILEE);
    bf16* XS = (bf16*)(ws + WS_XS); bf16* ACTH = (bf16*)(ws + WS_ACTH); bf16* PART = (bf16*)(ws + WS_XN);
    LAS unsigned char* scr = lds + w * 16384;

    if (IN(0)) REP(0) { REPBAR();
        if (gw < 512) { const int kv = gw >> 8; cmp_bias_item(kv ? cmp_pos_v : cmp_pos_k, kv ? cmp_w1_v : cmp_w1_k, B1P + kv * 16384, (gw >> 6) & 3, gw & 63, lane); }
        conv_mat(cmp_w2_k, 256, 64, 64, W2T, 0, nullptr, scr, gw, NGW, lane);
        conv_mat(cmp_w2_v, 256, 64, 64, W2T + 64 * 256, 0, nullptr, scr, gw, NGW, lane);
        conv_mat_wg(w_in_e, D, N0, N0P, WIN0, 0, ln_mix_e, lds, lane, w, bid, G);
        conv_mat_wg(w_out_e, D, D, D, WOUT0, 0, nullptr, lds, lane, w, (bid + 80) % G, G);
        conv_mat_wg(ffn_w_gate, D, FF, FF, WGU, 1, ln_ffn_e, lds, lane, w, (bid + 112) % G, G);
        conv_mat_wg(ffn_w_up, D, FF, FF, WGU, 2, ln_ffn_e, lds, lane, w, (bid + 200) % G, G);
        conv_mat_wg(ffn_w_down, FF, D, D, WDN, 0, nullptr, lds, lane, w, (bid + 288) % G, G);
        conv_mat_wg(w_in_o, D, N1, N1P, WIN1, 0, ln_mix_o, lds, lane, w, (bid + 376) % G, G);
        conv_mat_wg(w_out_o, D, D, D, WOUT1, 0, nullptr, lds, lane, w, (bid + 472) % G, G);
        conv_mat_wg(cmp_w1_k, 2048, 256, 256, WCMP, 0, nullptr, lds, lane, w, (bid + 504) % G, G);
        conv_mat_wg(cmp_w1_v, 2048, 256, 256, WCMP + 256 * 2048, 0, nullptr, lds, lane, w, (bid + 520) % G, G);
        rope_tables(positions, ROPE1, ROPE2, gtid, NTH);
        rms_phase(x, XN, gw, NGW, lane);
    }
    SEAM(0);
    if (IN(1)) REP(1) { REPBAR(); pg8::Gemm g{XN, WIN0, M, N0P, D, D, D}; pg8::StaticOrder S; S.init(M, N0P, G, bid); pg8::EpiBf16Plain E{PROJ, N0P};
        pg8::gemm_phase<pg8::EpiBf16Plain, pg8::StaticOrder, true, true>(lds, g, S, E);
        if (!rep && G == 256 && bid >= 128) conv_moe_tiles(exp_w_gate, exp_w_up, exp_w_down, ln_ffn_o, MOEGU, MOED, lds, lane, w, 0, EARLY1, bid - 128, 128); }
    SEAM(1);
    if (IN(2)) REPRT(2) { REPBAR();
        prep0_swa(PROJ, swa_q_norm, swa_k_norm, ROPE1, QS, KS, VST, lane, w, bid, G);
        if (PROBE_A >= 0) { __syncthreads(); STAMP(29); }
        chunk_phaseA<false>(lds, PROJ, N0P, C0_GQ, C0_GK, C0_GV, C0_GLOW, gla_gate_up, gla_gate_bias, nullptr, QIN, OINTRA, UT, DEC, lane, w, bid, G);
    }
    SEAM(2);
    if (IN(3)) REPRT(3) { REPBAR();
        if (!rep) chunk_scan(UT, DEC, SB, gtid, NTH);
        window_attn<true, true>(QS, KS, VST, 128, swa_sinks, swa_q_norm, swa_k_norm, MIXED, nullptr, nullptr, lds + w * 16384, gw, NGW, lane);
    }
    SEAM(3);
    if (IN(4)) REP(4) { REPBAR(); chunk_phaseC<false>(QIN, OINTRA, SB, PROJ, N0P, C0_GOUT, gla_out_norm, MIXED, gw, NGW, lane); }
    SEAM(4);
    if (IN(5)) REP(5) { REPBAR(); pg8::Gemm g{MIXED, WOUT0, M, D, D, D, D}; pg8::StaticOrder S; S.init(M, D, G, bid); pg8::EpiResB E{x, nullptr, HB, D};
        pg8::gemm_phase<pg8::EpiResB, pg8::StaticOrder, true, true>(lds, g, S, E); }
    SEAM(5);
    if (IN(6)) REP(6) { REPBAR(); rms_phase_b(HB, XN, gw, NGW, lane); }
    SEAM(6);
    if (IN(7)) REP(7) { REPBAR(); pg8::Gemm g{XN, WGU, M, 2 * FF, D, D, D}; pg8::StaticOrder S; S.init(M, 2 * FF, G, bid); pg8::EpiSwiglu E{ACT, FF};
        pg8::gemm_phase<pg8::EpiSwiglu, pg8::StaticOrder, true, true>(lds, g, S, E);
        if (!rep && G == 256 && bid >= 128) conv_moe_tiles(exp_w_gate, exp_w_up, exp_w_down, ln_ffn_o, MOEGU, MOED, lds, lane, w, EARLY1, EARLY2, bid - 128, 128); }
    SEAM(7);
    if (IN(8)) REP(8) { REPBAR(); pg8::Gemm g{ACT, WDN, M, D, FF, FF, FF}; pg8::StaticOrder S; S.init(M, D, G, bid); pg8::EpiResB E{nullptr, HB, rep ? (bf16*)(ws + WS_RA) : HB, D};
        pg8::gemm_phase<pg8::EpiResB, pg8::StaticOrder, true, true>(lds, g, S, E); }
    SEAM(8);
    if (IN(9)) REP(9) { REPBAR(); rms_phase_b(HB, XN, gw, NGW, lane); }
    SEAM(9);
    if (IN(10)) REP(10) { REPBAR(); pg8::Gemm g{XN, WIN1, M, N1P, D, D, D}; pg8::StaticOrder S; S.init(M, N1P, G, bid); pg8::EpiBf16Plain E{PROJ, N1P};
        pg8::gemm_phase<pg8::EpiBf16Plain, pg8::StaticOrder, true, true>(lds, g, S, E); }
    SEAM(10);
    if (IN(11)) REPRT(11) { REPBAR();
        if (gtid < 512) { const int kv = gtid >> 8, j = gtid & 255; float bsum = (kv ? cmp_b1_v : cmp_b1_k)[j];
#pragma unroll
            for (int c = 0; c < 64; ++c) bsum += B1P[(kv * 64 + c) * 256 + j];
            B1P[32768 + gtid] = bsum; }
        prep1_nsa(PROJ, nsa_q_norm, nsa_ks_norm, nsa_kw_norm, ROPE1, QS, KS, KW, KCR, VCR, VST, VWT, lane, w, bid, G);
        if (PROBE_A >= 0) { __syncthreads(); STAMP(31); }
        chunk_phaseA<true>(lds, PROJ, N1P, C1_RQ, C1_RK, C1_RV, 0, nullptr, nullptr, ROPE2, QIN, OINTRA, UT, DEC, lane, w, bid, G);
    }
    SEAM(11);
    if (IN(12)) REPRT(12) { REPBAR();
        constexpr int NCW = 16;
        if (bid < NCW) { pg8::Gemm g{KCR, WCMP, 4096, 256, 2048, 1024, 2048}; pg8::CmpOrder S{NCW, bid}; pg8::EpiCmp E{CMPH, B1P + 32768};
            pg8::gemm_phase<pg8::EpiCmp, pg8::CmpOrder, true, true>(lds, g, S, E); }
        else { if (!rep) chunk_scan(UT, DEC, SB, gtid - NCW * NWAVES * 64, NTH - NCW * NWAVES * 64);
            window_attn<false, false>(QS, KW, VWT, 512, nullptr, nsa_q_norm, nsa_kw_norm, nullptr, ONSA, PROJ, lds + w * 16384, gw - NCW * NWAVES, NGW - NCW * NWAVES, lane); }
    }
    SEAM(12);
    if (IN(13)) REP(13) { REPBAR();
        cmp_layer2(CMPH, W2T, cmp_b2_k, cmp_b2_v, nsa_kc_norm, ROPE1, KCB, VCBT, gw, 256, NGW, lane);
        chunk_phaseC<true>(QIN, OINTRA, SB, PROJ, N1P, C1_RG, ret_out_norm, MIXED, gw, NGW, lane);
    }
    SEAM(13);
    if (IN(14)) REPRT(14) { REPBAR(); nsa_cmp_slc(QS, KCB, VCBT, KS, VST, nsa_q_norm, nsa_kc_norm, nsa_ks_norm, PROJ, rep ? (float*)OINTRA : ONSA, rep ? (bf16*)UT : MIXED, lds, w, gw, NGW, lane); }
    SEAM(14);
    if (IN(15)) REP(15) { REPBAR(); pg8::Gemm g{MIXED, WOUT1, M, D, D, D, D}; pg8::StaticOrder S; S.init(M, D, G, bid); pg8::EpiResB E{nullptr, HB, rep ? (bf16*)(ws + WS_RA) : HB, D};
        pg8::gemm_phase<pg8::EpiResB, pg8::StaticOrder, true, true>(lds, g, S, E); }
    SEAM(15);
    if (IN(16)) REP(16) { REPBAR();
        if (!rep) moe_route(HB, ln_ffn_o, router_w, router_b, XN, TOKE, TOKW, TOKR, CTL + CW_CNT, lds + 126976, tid, lane, w, bid, G);
        conv_moe_tiles(exp_w_gate, exp_w_up, exp_w_down, ln_ffn_o, MOEGU, MOED, lds, lane, w, (G == 256) ? EARLY2 : 0, 2688, bid, G);
    }
    SEAM(16);
    if (IN(17)) REP(17) { REPBAR(); moe_dispatch(CTL + CW_CNT, XN, TOKE, TOKR, TOKS, XS, TILEE, CTL + CW_NT, lds, tid, lane, w, bid, G); }
    SEAM(17);
#pragma unroll
    for (int hf = 0; hf < 2; ++hf) {
        if (IN(18 + 2 * hf)) REP(18) { REPBAR(); const int nt = (int)__hip_atomic_load(CTL + CW_NT, __ATOMIC_RELAXED, __HIP_MEMORY_SCOPE_AGENT);
            const int t0 = hf * HALFTILES, t1 = hf ? nt : (nt < HALFTILES ? nt : HALFTILES);
            if (t1 > t0) { pg8::Gemm g{XS, MOEGU, 0, 2 * FFE, D, D, D}; pg8::MoeOrder S{TILEE, t0, t1, 2 * FFE / 256, G, bid}; pg8::EpiSwiglu E{ACTH - (size_t)t0 * 256 * FFE, FFE};
                pg8::gemm_phase<pg8::EpiSwiglu, pg8::MoeOrder, true, true>(lds, g, S, E); } }
        SEAM(18 + 2 * hf);
        if (IN(19 + 2 * hf)) REP(19) { REPBAR(); const int nt = (int)__hip_atomic_load(CTL + CW_NT, __ATOMIC_RELAXED, __HIP_MEMORY_SCOPE_AGENT);
            const int t0 = hf * HALFTILES; int t1 = hf ? nt : (nt < HALFTILES ? nt : HALFTILES); if (t1 > 2 * HALFTILES) t1 = 2 * HALFTILES;
            if (t1 > t0) { pg8::Gemm g{ACTH - (size_t)t0 * 256 * FFE, MOED, 0, D, FFE, FFE, FFE}; pg8::MoeOrder S{TILEE, t0, t1, D / 256, G, bid}; pg8::EpiBf16Plain E{XS, D};
                pg8::gemm_phase<pg8::EpiBf16Plain, pg8::MoeOrder, true, true>(lds, g, S, E); }
            if (hf && nt > 2 * HALFTILES) { pg8::Gemm g{ACTH - (size_t)t0 * 256 * FFE, MOED, 0, D, FFE / NSPLIT, FFE, FFE}; pg8::MoeSplitOrder S{TILEE, 2 * HALFTILES, nt, D / 256, NSPLIT, FFE / NSPLIT, G, (bid + 128) % G};
                pg8::EpiBf16Split E{PART - (size_t)2 * HALFTILES * 256 * D, D, (size_t)8 * 256 * D};
                pg8::gemm_phase<pg8::EpiBf16Split, pg8::MoeSplitOrder, true, true>(lds, g, S, E); } }
        SEAM(19 + 2 * hf);
    }
    if (IN(22)) moe_combine(out, HB, XS, PART, TOKS, TOKW, gw, NGW, lane, [&]() { if (ONE_LAUNCH) xcd_barrier(bar); });
    if (PROBE_A >= 0) { __syncthreads(); STAMP(23);
        if (bid == 0 && tid == 0) { const unsigned long long da = (stamps[PROBE_AE] - stamps[PROBE_A]) / 100ull, db = (PROBE_B >= 0) ? (stamps[PROBE_BE] - stamps[PROBE_B]) / 100ull : 0ull;
            const unsigned long long wait = (da + 512ull * db) * 100ull, t0 = __builtin_amdgcn_s_memrealtime();
            while (__builtin_amdgcn_s_memrealtime() - t0 < wait) __builtin_amdgcn_s_sleep(8); } }
#undef IN
#undef SEAM
}

extern "C" void kernel_launch(void* const* d_in, const int* in_sizes, int n_in, void* d_out, int out_size, void* d_ws, size_t ws_size, hipStream_t stream) {
    static int grid = 0;
    if (grid == 0) {
        if (n_in != 39 || out_size != M * D || ws_size < WS_END) { fprintf(stderr, "kernel_launch: unexpected problem (n_in %d, out %d, ws %zu < %zu)\n", n_in, out_size, ws_size, (size_t)WS_END); grid = -1; return; }
        int dev = 0, cus = 0, per_cu = 0;
        if (hipGetDevice(&dev) != hipSuccess || hipDeviceGetAttribute(&cus, hipDeviceAttributeMultiprocessorCount, dev) != hipSuccess) { grid = -1; return; }
        if (hipFuncSetAttribute((const void*)hybrid_fwd, hipFuncAttributeMaxDynamicSharedMemorySize, LDS_BYTES) != hipSuccess) { fprintf(stderr, "kernel_launch: hipFuncSetAttribute failed\n"); grid = -1; return; }
        if (hipOccupancyMaxActiveBlocksPerMultiprocessor(&per_cu, (const void*)hybrid_fwd, NWAVES * 64, LDS_BYTES) != hipSuccess || per_cu < 1) { fprintf(stderr, "kernel_launch: occupancy query says %d\n", per_cu); }
        (void)hipGetLastError();
        grid = cus;
    }
    if (grid < 0) return;
    if (hipMemsetAsync((char*)d_ws + WS_CTL, 0, CTL_ZERO_BYTES, stream) != hipSuccess) return;
    Args a{};
    for (int i = 0; i < 39; ++i) a.in[i] = d_in[i];
    a.out = (float*)d_out; a.ws = (unsigned char*)d_ws;
#if ONE_LAUNCH
    a.ph_lo = 0; a.ph_hi = NPHASE;
    hipLaunchKernelGGL(hybrid_fwd, dim3(grid), dim3(NWAVES * 64), LDS_BYTES, stream, a);
#else
    for (int p = 0; p < NPHASE && p < STOP_PHASE; ++p) { a.ph_lo = p; a.ph_hi = p + 1; hipLaunchKernelGGL(hybrid_fwd, dim3(grid), dim3(NWAVES * 64), LDS_BYTES, stream, a); }
#endif
}
```

```cpp
#include <hip/hip_runtime.h>
#include <cstdio>
#include <cstdint>
namespace pg8 {
#define PG8_LAS __attribute__((address_space(3)))
typedef unsigned short bf16_t;
typedef short bf16x8 __attribute__((ext_vector_type(8)));
typedef float f32x4 __attribute__((ext_vector_type(4)));
typedef unsigned u32x4 __attribute__((ext_vector_type(4)));
constexpr int BM = 256, BK = 64, HALF = 128, HTB = HALF * BK * 2  , STAGE_BYTES = 8 * HTB, NXCD = 8, WGM = 8;

__host__ __device__ __forceinline__ int lds_byte(int r, int c) { const int st = (r >> 4) * 2 + (c >> 5), rr = r & 15, cc = c & 31, ob = rr * 64 + cc * 2; return st * 1024 + (ob ^ (((ob >> 9) & 1) << 5)); }
__host__ __device__ __forceinline__ void stage_rc(int b, int& R, int& C) { const int st = b / 1024, sb = b % 1024, swz = sb ^ (((sb >> 9) & 1) << 5); R = (st >> 1) * 16 + swz / 64; C = (st & 1) * 32 + (swz % 64) / 2; }
__host__ __device__ __forceinline__ int perm32(int rho) { const int n = rho >> 4, i = rho & 15; return 8 * (i >> 2) + 4 * n + (i & 3); }

struct Unit { int pm, pn, pb, ko, ks; };
struct Gemm { const bf16_t* A; const bf16_t* Bt; int M, N, K, lda, ldb; };

struct StaticOrder {
    int nM, nN, nwg, G, c;
    __host__ __device__ void init(int M, int N, int G_, int c_) { nM = M / BM; nN = N / BM; nwg = nM * nN; G = G_; c = c_; }
    __host__ __device__ bool next(int i, Unit& u) const {
        const long L = (long)i * G + c; if (L >= nwg) return false;
        int wgid = (int)L; { const int q = nwg / NXCD, r = nwg % NXCD, xcd = wgid % NXCD, off = wgid / NXCD; wgid = (xcd < r ? xcd * (q + 1) : r * (q + 1) + (xcd - r) * q) + off; }
        const int nig = WGM * nN, gid = wgid / nig, fm = gid * WGM, gsz = (nM - fm) < WGM ? (nM - fm) : WGM;
        u.pm = fm + ((wgid % nig) % gsz); u.pn = (wgid % nig) / gsz; u.pb = u.pn; u.ko = 0; u.ks = 0; return true;
    }
    __device__ __forceinline__ void a_ready(const Unit&) const {}
    __device__ __forceinline__ void done(const Unit&) const {}
};
struct MoeOrder {
    const int* tile_e; int t0, t1, nN, G, c;
    __device__ bool next(int i, Unit& u) const {
        u.ko = 0; u.ks = 0;
        if (G != 256) { const long L = (long)i * G + c; const long n = (long)(t1 - t0) * nN; if (L >= n) return false;
            u.pm = t0 + (int)(L / nN); u.pn = (int)(L % nN); u.pb = tile_e[u.pm] * nN + u.pn; return true; }
        const int ncg = nN >> 2, nsb = ((t1 - t0 + 7) >> 3) * ncg, sb = i * 8 + (c & 7), l = c >> 3;
        if (sb >= nsb) return false;
        const int rg = sb / ncg, cg = sb - rg * ncg;
        u.pm = t0 + rg * 8 + (l >> 2); if (u.pm >= t1) return false;
        u.pn = cg * 4 + (l & 3); u.pb = tile_e[u.pm] * nN + u.pn; return true;
    }
    __device__ __forceinline__ void a_ready(const Unit&) const {}
    __device__ __forceinline__ void done(const Unit&) const {}
};

__device__ __forceinline__ unsigned cvt_pk_bf16(float lo, float hi) { unsigned r; asm volatile("v_cvt_pk_bf16_f32 %0, %1, %2" : "=v"(r) : "v"(lo), "v"(hi)); return r; }

struct EpiBf16Plain {
    static constexpr bool PERM = true, AFTER_DRAIN = false;
    bf16_t* O; int ldc;
    __device__ __forceinline__ void operator()(const f32x4 (&acc)[2][2][4][2], const Unit& u, int wr, int wc, int fr, int fq) const {
        const int row0 = u.pm * BM + wr * 64 + fr, col0 = u.pn * BM + wc * 32 + 8 * fq;
#pragma unroll
        for (int ai = 0; ai < 2; ++ai)
#pragma unroll
            for (int m = 0; m < 4; ++m) { bf16_t* rowp = O + (size_t)(row0 + ai * HALF + m * 16) * ldc + col0;
#pragma unroll
                for (int bj = 0; bj < 2; ++bj) { const f32x4 v0 = acc[ai][bj][m][0], v1 = acc[ai][bj][m][1];
                    u32x4 w; w.x = cvt_pk_bf16(v0[0], v0[1]); w.y = cvt_pk_bf16(v0[2], v0[3]); w.z = cvt_pk_bf16(v1[0], v1[1]); w.w = cvt_pk_bf16(v1[2], v1[3]);
                    *(u32x4*)(rowp + bj * HALF) = w; } }
    }
};
struct MoeSplitOrder {
    const int* tile_e; int t0, t1, nN, NS, klen, G, c;
    __device__ bool next(int i, Unit& u) const {
        const long L = (long)i * G + c; const int per = nN * NS; const long n = (long)(t1 - t0) * per; if (L >= n) return false;
        const int rem = (int)(L % per); u.pm = t0 + (int)(L / per); u.pn = rem / NS; u.ks = rem % NS; u.ko = u.ks * klen * 2; u.pb = tile_e[u.pm] * nN + u.pn; return true;
    }
    __device__ __forceinline__ void a_ready(const Unit&) const {}
    __device__ __forceinline__ void done(const Unit&) const {}
};
struct EpiBf16Split {
    static constexpr bool PERM = true, AFTER_DRAIN = false;
    bf16_t* O; int ldc; size_t stride;
    __device__ __forceinline__ void operator()(const f32x4 (&acc)[2][2][4][2], const Unit& u, int wr, int wc, int fr, int fq) const {
        const int row0 = u.pm * BM + wr * 64 + fr, col0 = u.pn * BM + wc * 32 + 8 * fq; bf16_t* base = O + (size_t)u.ks * stride;
#pragma unroll
        for (int ai = 0; ai < 2; ++ai)
#pragma unroll
            for (int m = 0; m < 4; ++m) { bf16_t* rowp = base + (size_t)(row0 + ai * HALF + m * 16) * ldc + col0;
#pragma unroll
                for (int bj = 0; bj < 2; ++bj) { const f32x4 v0 = acc[ai][bj][m][0], v1 = acc[ai][bj][m][1];
                    u32x4 w; w.x = cvt_pk_bf16(v0[0], v0[1]); w.y = cvt_pk_bf16(v0[2], v0[3]); w.z = cvt_pk_bf16(v1[0], v1[1]); w.w = cvt_pk_bf16(v1[2], v1[3]);
                    *(u32x4*)(rowp + bj * HALF) = w; } }
    }
};
struct EpiResF32 {
    static constexpr bool PERM = false, AFTER_DRAIN = false;
    const float* base; float* out; int ldc;
    __device__ __forceinline__ void operator()(const f32x4 (&acc)[2][2][4][2], const Unit& u, int wr, int wc, int fr, int fq) const {
        const int row0 = u.pm * BM + wr * 64 + fr, col0 = u.pn * BM + wc * 32 + 4 * fq;
#pragma unroll
        for (int ai = 0; ai < 2; ++ai)
#pragma unroll
            for (int m = 0; m < 4; ++m) { const size_t ro = (size_t)(row0 + ai * HALF + m * 16) * ldc + col0;
#pragma unroll
                for (int bj = 0; bj < 2; ++bj)
#pragma unroll
                    for (int n = 0; n < 2; ++n) { const size_t o = ro + bj * HALF + n * 16; const f32x4 b = *(const f32x4*)(base + o); *(f32x4*)(out + o) = b + acc[ai][bj][m][n]; } }
    }
};
struct EpiResB {
    static constexpr bool PERM = true, AFTER_DRAIN = false;
    const float* basef; const bf16_t* baseb; bf16_t* out; int ldc;
    __device__ __forceinline__ void operator()(const f32x4 (&acc)[2][2][4][2], const Unit& u, int wr, int wc, int fr, int fq) const {
        const int row0 = u.pm * BM + wr * 64 + fr, col0 = u.pn * BM + wc * 32 + 8 * fq;
#pragma unroll
        for (int ai = 0; ai < 2; ++ai)
#pragma unroll
            for (int m = 0; m < 4; ++m) { const size_t ro = (size_t)(row0 + ai * HALF + m * 16) * ldc + col0;
#pragma unroll
                for (int bj = 0; bj < 2; ++bj) { f32x4 b0, b1;
                    if (basef) { b0 = *(const f32x4*)(basef + ro + bj * HALF); b1 = *(const f32x4*)(basef + ro + bj * HALF + 4); }
                    else { const u32x4 w = *(const u32x4*)(baseb + ro + bj * HALF);
                        b0 = (f32x4){__builtin_bit_cast(float, w.x << 16), __builtin_bit_cast(float, w.x & 0xffff0000u), __builtin_bit_cast(float, w.y << 16), __builtin_bit_cast(float, w.y & 0xffff0000u)};
                        b1 = (f32x4){__builtin_bit_cast(float, w.z << 16), __builtin_bit_cast(float, w.z & 0xffff0000u), __builtin_bit_cast(float, w.w << 16), __builtin_bit_cast(float, w.w & 0xffff0000u)}; }
                    const f32x4 v0 = b0 + acc[ai][bj][m][0], v1 = b1 + acc[ai][bj][m][1];
                    u32x4 o; o.x = cvt_pk_bf16(v0[0], v0[1]); o.y = cvt_pk_bf16(v0[2], v0[3]); o.z = cvt_pk_bf16(v1[0], v1[1]); o.w = cvt_pk_bf16(v1[2], v1[3]);
                    *(u32x4*)(out + ro + bj * HALF) = o; } }
    }
};
struct EpiSwiglu {
    static constexpr bool PERM = true, AFTER_DRAIN = false;
    bf16_t* O; int ldc;
    __device__ __forceinline__ void operator()(const f32x4 (&acc)[2][2][4][2], const Unit& u, int wr, int wc, int fr, int fq) const {
        const int row0 = u.pm * BM + wr * 64 + fr, col0 = u.pn * HALF + wc * 32 + 8 * fq;
#pragma unroll
        for (int ai = 0; ai < 2; ++ai)
#pragma unroll
            for (int m = 0; m < 4; ++m) { bf16_t* rowp = O + (size_t)(row0 + ai * HALF + m * 16) * ldc + col0;
                float r[8];
#pragma unroll
                for (int n = 0; n < 2; ++n)
#pragma unroll
                    for (int i = 0; i < 4; ++i) { const float g = acc[ai][0][m][n][i], up = acc[ai][1][m][n][i]; r[n * 4 + i] = g * __builtin_amdgcn_rcpf(1.0f + __expf(-g)) * up; }
                u32x4 w; w.x = cvt_pk_bf16(r[0], r[1]); w.y = cvt_pk_bf16(r[2], r[3]); w.z = cvt_pk_bf16(r[4], r[5]); w.w = cvt_pk_bf16(r[6], r[7]);
                *(u32x4*)rowp = w; }
    }
};

struct CmpOrder {
    int G, c;
    __device__ bool next(int i, Unit& u) const { const int L = i * G + c; if (L >= 16) return false; u.pm = L; u.pn = 0; u.pb = L >> 3; u.ko = 0; u.ks = 0; return true; }
    __device__ __forceinline__ void a_ready(const Unit&) const {}
    __device__ __forceinline__ void done(const Unit&) const {}
};
struct EpiCmp {
    static constexpr bool PERM = false, AFTER_DRAIN = false;
    float* C; const float* bias;
    __device__ __forceinline__ void operator()(const f32x4 (&acc)[2][2][4][2], const Unit& u, int wr, int wc, int fr, int fq) const {
        const int row0 = u.pm * BM + wr * 64 + fr, col0 = wc * 32 + 4 * fq; const float* bp = bias + u.pb * 256 + col0;
#pragma unroll
        for (int ai = 0; ai < 2; ++ai)
#pragma unroll
            for (int m = 0; m < 4; ++m) { float* rowp = C + (size_t)(row0 + ai * HALF + m * 16) * 256 + col0;
#pragma unroll
                for (int bj = 0; bj < 2; ++bj)
#pragma unroll
                    for (int n = 0; n < 2; ++n) *(f32x4*)(rowp + bj * HALF + n * 16) = acc[ai][bj][m][n] + *(const f32x4*)(bp + bj * HALF + n * 16); }
    }
};
template <class Epi, class Sched, bool ALIGN_EPI = false, bool SP2 = false>
__device__ __forceinline__ void gemm_phase(PG8_LAS unsigned char* lds, const Gemm g, const Sched& S, const Epi& E) {
    const int tid = threadIdx.x, wid = __builtin_amdgcn_readfirstlane(tid >> 6), lane = tid & 63, wr = wid >> 2, wc = wid & 3, fr = lane & 15, fq = lane >> 4;
    const int K = g.K, nt = K / BK;
    unsigned voffA[2], voffB[2];
#pragma unroll
    for (int i = 0; i < 2; ++i) { int R, C; stage_rc(tid * 16 + i * 8192, R, C); const int Rb = Epi::PERM ? ((R & ~31) + perm32(R & 31)) : R;
        voffA[i] = (unsigned)(R * g.lda + C) * 2u; voffB[i] = (unsigned)(Rb * g.ldb + C) * 2u; }
    const size_t kstep = (size_t)(BK * 2);
    const size_t hstep = (size_t)HALF * g.ldb * 2;
    const size_t tstep = 2 * hstep; const size_t hstepA = (size_t)HALF * g.lda * 2, tstepA = 2 * hstepA;
    const unsigned ldsw = (unsigned)wid * 1024u;
    const int aoff = lds_byte(wr * 64 + fr, fq * 8), boff = lds_byte(wc * 32 + fr, fq * 8);
#define PG8_SA(b, h) (((b) * 2 + (h)) * HTB)
#define PG8_SB(b, h) ((4 + (b) * 2 + (h)) * HTB)
#define PG8_STAGE(bufoff, gbase, voff) do { _Pragma("unroll") for (int _i = 0; _i < 2; ++_i) \
        __builtin_amdgcn_global_load_lds((const unsigned*)((const char*)(gbase) + (voff)[_i]), (PG8_LAS unsigned*)(lds + (bufoff) + ldsw + _i * 8192), 16, 0, 0); } while (0)
#define PG8_LDA(dst, b, h) do { _Pragma("unroll") for (int m = 0; m < 4; ++m) _Pragma("unroll") for (int k = 0; k < 2; ++k) dst[m][k] = *(const PG8_LAS bf16x8*)(lds + PG8_SA(b, h) + aoff + m * 2048 + k * 1024); } while (0)
#define PG8_LDB(dst, b, h) do { _Pragma("unroll") for (int n = 0; n < 2; ++n) _Pragma("unroll") for (int k = 0; k < 2; ++k) dst[n][k] = *(const PG8_LAS bf16x8*)(lds + PG8_SB(b, h) + boff + n * 2048 + k * 1024); } while (0)
#define PG8_MMA(ai, bj, At, Bt) do { __builtin_amdgcn_s_setprio(1); _Pragma("unroll") for (int m = 0; m < 4; ++m) _Pragma("unroll") for (int n = 0; n < 2; ++n) _Pragma("unroll") for (int k = 0; k < 2; ++k) \
        acc[ai][bj][m][n] = __builtin_amdgcn_mfma_f32_16x16x32_bf16(Bt[n][k], At[m][k], acc[ai][bj][m][n], 0, 0, 0); __builtin_amdgcn_s_setprio(0); } while (0)
#define PG8_WAIT_V(n) asm volatile("s_waitcnt vmcnt(" #n ")" ::: "memory")
#define PG8_WAIT_L(n) asm volatile("s_waitcnt lgkmcnt(" #n ")" ::: "memory")
#define PG8_BAR __builtin_amdgcn_s_barrier()
#define PG8_SCHED __builtin_amdgcn_sched_barrier(0)
    Unit cur, nxt; int ui = 0;
    if (!S.next(0, cur)) return;
    f32x4 acc[2][2][4][2];
#pragma unroll
    for (int a = 0; a < 2; ++a)
#pragma unroll
        for (int b = 0; b < 2; ++b)
#pragma unroll
            for (int m = 0; m < 4; ++m)
#pragma unroll
                for (int n = 0; n < 2; ++n) acc[a][b][m][n] = (f32x4){0.f, 0.f, 0.f, 0.f};
    bf16x8 At[4][2], B0[2][2], B1[2][2];
    const char* cA = (const char*)g.A + (size_t)cur.pm * tstepA + cur.ko; const char* cB = (const char*)g.Bt + (size_t)cur.pb * tstep + cur.ko;
    S.a_ready(cur);
    if constexpr (SP2) {
        PG8_STAGE(PG8_SB(0, 0), cB, voffB); PG8_STAGE(PG8_SB(0, 1), cB + hstep, voffB); PG8_STAGE(PG8_SA(0, 0), cA, voffA); PG8_STAGE(PG8_SA(0, 1), cA + hstepA, voffA);
        if (wr == 1) PG8_BAR;
        PG8_WAIT_V(2); PG8_BAR;
        PG8_STAGE(PG8_SB(1, 0), cB + kstep, voffB); PG8_STAGE(PG8_SA(1, 0), cA + kstep, voffA); PG8_STAGE(PG8_SB(1, 1), cB + hstep + kstep, voffB);
        PG8_WAIT_V(6); PG8_BAR;
    } else {
        PG8_STAGE(PG8_SB(0, 0), cB, voffB); PG8_STAGE(PG8_SA(0, 0), cA, voffA); PG8_STAGE(PG8_SB(0, 1), cB + hstep, voffB); PG8_STAGE(PG8_SA(0, 1), cA + hstepA, voffA);
        if (wr == 1) PG8_BAR;
        PG8_WAIT_V(4); PG8_BAR;
        PG8_STAGE(PG8_SB(1, 0), cB + kstep, voffB); PG8_STAGE(PG8_SA(1, 0), cA + kstep, voffA); PG8_STAGE(PG8_SB(1, 1), cB + hstep + kstep, voffB);
        PG8_WAIT_V(6); PG8_BAR;
    }
    for (;;) {
        const bool has_next = S.next(ui + 1, nxt);
        const char* nA = has_next ? (const char*)g.A + (size_t)nxt.pm * tstepA + nxt.ko : cA; const char* nB = has_next ? (const char*)g.Bt + (size_t)nxt.pb * tstep + nxt.ko : cB;
        for (int t = 0; t < nt; t += 2) {
            const bool last = (t == nt - 2);
            const char* a1 = cA + (size_t)(t + 1) * kstep;
            const char* a2 = last ? nA : cA + (size_t)(t + 2) * kstep; const char* b2 = last ? nB : cB + (size_t)(t + 2) * kstep;
            const char* a3 = a2 + kstep; const char* b3 = b2 + kstep;
            if (last && has_next) S.a_ready(nxt);
            if constexpr (SP2) {
            PG8_LDB(B0, 0, 0); PG8_LDB(B1, 0, 1); PG8_SCHED; PG8_LDA(At, 0, 0); PG8_STAGE(PG8_SA(1, 1), a1 + hstepA, voffA);
            PG8_WAIT_V(8); PG8_WAIT_L(0); PG8_BAR; PG8_MMA(0, 0, At, B0); PG8_MMA(0, 1, At, B1); PG8_BAR; PG8_SCHED;
            PG8_LDA(At, 0, 1); PG8_STAGE(PG8_SB(0, 0), b2, voffB); PG8_STAGE(PG8_SB(0, 1), b2 + hstep, voffB); PG8_STAGE(PG8_SA(0, 0), a2, voffA);
            PG8_WAIT_V(8); PG8_WAIT_L(0); PG8_BAR; PG8_MMA(1, 0, At, B0); PG8_MMA(1, 1, At, B1); PG8_BAR; PG8_SCHED;
            PG8_LDB(B0, 1, 0); PG8_LDB(B1, 1, 1); PG8_SCHED; PG8_LDA(At, 1, 0); PG8_STAGE(PG8_SA(0, 1), a2 + hstepA, voffA);
            PG8_WAIT_V(8); PG8_WAIT_L(0); PG8_BAR; PG8_MMA(0, 0, At, B0); PG8_MMA(0, 1, At, B1); PG8_BAR; PG8_SCHED;
            PG8_LDA(At, 1, 1); PG8_STAGE(PG8_SB(1, 0), b3, voffB); PG8_STAGE(PG8_SB(1, 1), b3 + hstep, voffB); PG8_STAGE(PG8_SA(1, 0), a3, voffA);
            PG8_WAIT_V(8); PG8_WAIT_L(0); PG8_BAR; PG8_MMA(1, 0, At, B0); PG8_MMA(1, 1, At, B1); PG8_BAR; PG8_SCHED;
            } else {
            PG8_LDB(B0, 0, 0); PG8_SCHED; PG8_LDA(At, 0, 0); PG8_STAGE(PG8_SA(1, 1), a1 + hstepA, voffA);
            PG8_WAIT_L(8); PG8_BAR; PG8_WAIT_L(0); PG8_MMA(0, 0, At, B0); PG8_BAR; PG8_SCHED;
            PG8_LDB(B1, 0, 1); PG8_STAGE(PG8_SB(0, 0), b2, voffB);
            PG8_BAR; PG8_WAIT_L(0); PG8_MMA(0, 1, At, B1); PG8_BAR;
            PG8_LDA(At, 0, 1); PG8_STAGE(PG8_SA(0, 0), a2, voffA);
            PG8_BAR; PG8_WAIT_L(0); PG8_MMA(1, 0, At, B0); PG8_BAR; PG8_SCHED;
            PG8_STAGE(PG8_SB(0, 1), b2 + hstep, voffB);
            PG8_WAIT_V(6); PG8_BAR; PG8_MMA(1, 1, At, B1); PG8_BAR;
            PG8_LDB(B0, 1, 0); PG8_SCHED; PG8_LDA(At, 1, 0); PG8_STAGE(PG8_SA(0, 1), a2 + hstepA, voffA);
            PG8_WAIT_L(8); PG8_BAR; PG8_WAIT_L(0); PG8_MMA(0, 0, At, B0); PG8_BAR; PG8_SCHED;
            PG8_LDB(B1, 1, 1); PG8_STAGE(PG8_SB(1, 0), b3, voffB);
            PG8_BAR; PG8_WAIT_L(0); PG8_MMA(0, 1, At, B1); PG8_BAR;
            PG8_LDA(At, 1, 1); PG8_STAGE(PG8_SA(1, 0), a3, voffA);
            PG8_BAR; PG8_WAIT_L(0); PG8_MMA(1, 0, At, B0); PG8_BAR; PG8_SCHED;
            PG8_STAGE(PG8_SB(1, 1), b3 + hstep, voffB);
            PG8_WAIT_V(6); PG8_BAR; PG8_MMA(1, 1, At, B1); PG8_BAR;
            }
        }
        if constexpr (ALIGN_EPI) { if (wr == 0) PG8_BAR; }
        if constexpr (!Epi::AFTER_DRAIN) { E(acc, cur, wr, wc, fr, fq); S.done(cur); }
        if (!has_next) break;
#pragma unroll
        for (int a = 0; a < 2; ++a)
#pragma unroll
            for (int b = 0; b < 2; ++b)
#pragma unroll
                for (int m = 0; m < 4; ++m)
#pragma unroll
                    for (int n = 0; n < 2; ++n) acc[a][b][m][n] = (f32x4){0.f, 0.f, 0.f, 0.f};
        cur = nxt; cA = nA; cB = nB; ++ui;
        if constexpr (ALIGN_EPI) { if (wr == 1) PG8_BAR; }
    }
    PG8_WAIT_V(0);
    if constexpr (!ALIGN_EPI) { if (wr == 0) PG8_BAR; }
    PG8_BAR;
    if constexpr (Epi::AFTER_DRAIN) { E.fused(acc, cur, wr, wc, fr, fq, lds, wid, lane); S.done(cur); }
#undef PG8_SA
#undef PG8_SB
#undef PG8_STAGE
#undef PG8_LDA
#undef PG8_LDB
#undef PG8_MMA
#undef PG8_WAIT_V
#undef PG8_WAIT_L
#undef PG8_BAR
#undef PG8_SCHED
}
}

constexpr int BATCH = 4, T = 4096, D = 1024, M = BATCH * T;
constexpr int N0 = 2320, N0P = 2560, N1 = 2840, N1P = 3072;
constexpr int FF = 2816, FFE = 3584, NEXP = 8;
constexpr int C0_GQ = 0, C0_GK = 256, C0_GV = 512, C0_GLOW = 1024, C0_GOUT = 1040, C0_SQ = 1552, C0_SK = 2064, C0_SV = 2192;
constexpr int C1_RQ = 0, C1_RK = 256, C1_RV = 512, C1_RG = 1024, C1_NQ = 1536, C1_KC = 2048, C1_VC = 2176, C1_KSL = 2304, C1_VSL = 2432, C1_KWN = 2560, C1_VWN = 2688, C1_NG = 2816;
constexpr float EPS = 1e-6f;
constexpr float LOG2E = 1.4426950408889634f;
constexpr int NCH = T / 64;
constexpr int NUNIT = BATCH * 4 * NCH;
constexpr int MAXTILES = 136, HALFTILES = 64, XS_ROWS = MAXTILES * 256, NSPLIT = 7;

constexpr size_t MiB = 1u << 20;
constexpr size_t WS_CTL = 0, CTL_ZERO_BYTES = 1 * MiB;
constexpr size_t WS_ROPE1 = 1 * MiB;
constexpr size_t WS_ROPE2 = 2 * MiB;
constexpr size_t WS_TAB = 6 * MiB;
constexpr size_t WS_CMPT = 7 * MiB;
constexpr size_t WS_WIN0 = 8 * MiB, WS_WOUT0 = 13 * MiB, WS_WGU = 15 * MiB, WS_WDN = 26 * MiB, WS_WIN1 = 32 * MiB, WS_WOUT1 = 451 * MiB, WS_WCMP = 40 * MiB;
constexpr size_t WS_H3B = 8 * MiB;
constexpr size_t WS_MOEGU = 42 * MiB, WS_MOED = 154 * MiB;
constexpr size_t WS_XN = 210 * MiB;
constexpr size_t WS_PROJ = 242 * MiB;
constexpr size_t WS_RA = 338 * MiB;
constexpr size_t WS_END = 453 * MiB;
constexpr size_t WS_ONSA = 42 * MiB;
constexpr size_t WS_CMPH = 74 * MiB;
constexpr size_t WS_KCR = 80 * MiB, WS_VCR = 84 * MiB, WS_KW = 88 * MiB, WS_VWT = 92 * MiB;
constexpr size_t WS_QS = 338 * MiB;
constexpr size_t WS_KS = 354 * MiB;
constexpr size_t WS_VST = 358 * MiB;
constexpr size_t WS_QIN = 362 * MiB;
constexpr size_t WS_OINTRA = 370 * MiB;
constexpr size_t WS_UT = 402 * MiB;
constexpr size_t WS_DEC = 434 * MiB;
constexpr size_t WS_SB = 435 * MiB;
constexpr size_t WS_XS = 242 * MiB;
constexpr size_t WS_ACTH = 310 * MiB;
static_assert(WS_XS + (size_t)XS_ROWS * 1024 * 2 <= WS_ACTH && WS_ACTH + (size_t)(MAXTILES - HALFTILES) * 256 * FFE * 2 <= WS_END && (size_t)NSPLIT * 8 * 256 * 1024 * 2 <= 32 * MiB, "moe map");
static_assert(WS_DEC + (size_t)NUNIT * 64 * 4 <= WS_SB && WS_SB + (size_t)NUNIT * 8192 * 2 <= WS_END, "ws map");
constexpr size_t TB_TOKE = 0, TB_TOKW = 128 * 1024, TB_TOKR = 256 * 1024, TB_TOKS = 384 * 1024, TB_TILEE = 512 * 1024;
constexpr size_t CT_KCB = 0, CT_VCBT = 256 * 1024, CT_B1P = 512 * 1024, CT_W2T = 768 * 1024;
constexpr int CW_BAR = 4096;
constexpr int CW_CNT = 16384;
constexpr int CW_NT = 16384 + 64;

constexpr int RING_BYTES = 131072;
constexpr int LDSCTL_OFF = RING_BYTES, MISC_OFF = LDSCTL_OFF + 320;
constexpr int LDS_BYTES = 147456;
constexpr int NWAVES = 8;

#define GAS __attribute__((address_space(1)))
#define LAS __attribute__((address_space(3)))
#define DI __device__ __forceinline__
typedef unsigned short bf16;
typedef unsigned v4u __attribute__((ext_vector_type(4)));
typedef unsigned v2u __attribute__((ext_vector_type(2)));
typedef float f32x4 __attribute__((ext_vector_type(4)));
typedef short bf16x8 __attribute__((ext_vector_type(8)));
typedef float f32x2_t __attribute__((ext_vector_type(2))); typedef __bf16 bf16x2_t __attribute__((ext_vector_type(2)));
DI unsigned pk2(float lo, float hi) { f32x2_t v = {lo, hi}; bf16x2_t b = __builtin_convertvector(v, bf16x2_t); return __builtin_bit_cast(unsigned, b); }
DI unsigned f2bf(float f) { return pk2(f, 0.f) & 0xffffu; }
DI float bflo(unsigned w) { return __builtin_bit_cast(float, w << 16); }
DI float bfhi(unsigned w) { return __builtin_bit_cast(float, w & 0xffff0000u); }
DI void unpack8(const v4u v, float (&x)[8]) { x[0] = bflo(v.x); x[1] = bfhi(v.x); x[2] = bflo(v.y); x[3] = bfhi(v.y); x[4] = bflo(v.z); x[5] = bfhi(v.z); x[6] = bflo(v.w); x[7] = bfhi(v.w); }
DI v4u pack8(const float (&x)[8]) { v4u v; v.x = pk2(x[0], x[1]); v.y = pk2(x[2], x[3]); v.z = pk2(x[4], x[5]); v.w = pk2(x[6], x[7]); return v; }
DI bf16x8 ldg16(const bf16* p) { return *(const bf16x8*)p; }
DI f32x4 mfma16(bf16x8 a, bf16x8 b, f32x4 c) { return __builtin_amdgcn_mfma_f32_16x16x32_bf16(a, b, c, 0, 0, 0); }
template <int CTRL> DI float dppf(float v) { return __builtin_bit_cast(float, __builtin_amdgcn_update_dpp(0, __builtin_bit_cast(int, v), CTRL, 0xf, 0xf, true)); }
DI float rdlane(float v, int l) { return __builtin_bit_cast(float, __builtin_amdgcn_readlane(__builtin_bit_cast(int, v), l)); }
DI float sum8(float v) { v += dppf<0xB1>(v); v += dppf<0x4E>(v); v += dppf<0x141>(v); return v; }
DI float sum16(float v) { v = sum8(v); v += dppf<0x140>(v); return v; }
DI float wave_sum(float v) { v = sum16(v); return (rdlane(v, 0) + rdlane(v, 16)) + (rdlane(v, 32) + rdlane(v, 48)); }
DI float xor1(float v) { return dppf<0xB1>(v); }
DI float scan64(float v, int lane, float& total) {
    v += dppf<0x111>(v); v += dppf<0x112>(v); v += dppf<0x114>(v); v += dppf<0x118>(v);
    const float s0 = rdlane(v, 15), s1 = rdlane(v, 31), s2 = rdlane(v, 47), s3 = rdlane(v, 63); const int row = lane >> 4;
    v += (row >= 1 ? s0 : 0.f) + (row >= 2 ? s1 : 0.f) + (row >= 3 ? s2 : 0.f);
    total = (s0 + s1) + (s2 + s3); return v;
}
DI float silu_f(float g) { return g / (1.0f + __expf(-g)); }

#define XB_TMO      128
#define XB_XCNT(j)  (256  + 64 * (j))
#define XB_XSUB(j)  (1280 + 64 * (j))
#define XB_XGEN(j)  (2304 + 64 * (j))
#define XB_TOP      3328
#define XB_TOPGEN   3392
#define XCD_BAR_WORDS 3456
#define XB_SPIN_CAP (1u << 18)

__device__ __forceinline__ unsigned xb_ld(unsigned* p)              { return __hip_atomic_load(p, __ATOMIC_RELAXED, __HIP_MEMORY_SCOPE_AGENT); }
__device__ __forceinline__ unsigned xb_add(unsigned* p, unsigned v) { return __hip_atomic_fetch_add(p, v, __ATOMIC_RELAXED, __HIP_MEMORY_SCOPE_AGENT); }
__device__ __forceinline__ unsigned xb_xcc_id() { return (unsigned)__builtin_amdgcn_s_getreg((3 << 11) | 20) & 0xFu; }
#define XB_SPIN(cond, bar) do { unsigned _sp = 0; while (cond) { __builtin_amdgcn_s_sleep(1); \
    if ((++_sp & 255u) == 0u) { if (xb_ld(&(bar)[XB_TMO])) break; if (_sp > XB_SPIN_CAP) { atomicAdd(&(bar)[XB_TMO], 1u); break; } } } } while (0)

struct XcdBarrier { unsigned* bar; unsigned x; volatile LAS unsigned* st; };

__device__ __forceinline__ XcdBarrier xcd_barrier_post(unsigned* bar, volatile LAS unsigned* st) {
    XcdBarrier b; b.bar = bar; b.x = xb_xcc_id(); b.st = st;
    if (threadIdx.x == 0) (void)xb_add(&bar[XB_XCNT(b.x)], 1u);
    return b;
}
__device__ __forceinline__ void xcd_barrier_complete(unsigned* bar, unsigned x, unsigned& nloc, unsigned& nx) {
    const unsigned G = gridDim.x * gridDim.y * gridDim.z;
    unsigned sum, cnt, mine, sp = 0u;
    for (;;) {
        sum = 0u; cnt = 0u; mine = 0u;
#pragma unroll
        for (unsigned j = 0; j < 16; ++j) { const unsigned c = xb_ld(&bar[XB_XCNT(j)]); sum += c; cnt += (c > 0u) ? 1u : 0u; mine = (j == x) ? c : mine; }
        if (sum == G) break;
        __builtin_amdgcn_s_sleep(1);
        if ((++sp & 255u) == 0u) { if (xb_ld(&bar[XB_TMO])) break; if (sp > XB_SPIN_CAP) { atomicAdd(&bar[XB_TMO], 1u); break; } }
    }
    nloc = mine > 0u ? mine : 1u; nx = cnt > 0u ? cnt : 1u;
}
__device__ __forceinline__ void xcd_barrier(const XcdBarrier& b) {
    asm volatile("s_waitcnt vmcnt(0)" ::: "memory");
    __syncthreads();
    if (threadIdx.x == 0) {
        unsigned* bar = b.bar;
        __builtin_amdgcn_s_waitcnt(0);
        unsigned nloc = b.st[0], nx = b.st[1];
        if (nloc == 0u) { xcd_barrier_complete(bar, b.x, nloc, nx); b.st[0] = nloc; b.st[1] = nx; }
        const unsigned old = xb_add(&bar[XB_XSUB(b.x)], 1u);
        const unsigned gen = old / nloc;
        if (old + 1u == (gen + 1u) * nloc) {
            __builtin_amdgcn_fence(__ATOMIC_RELEASE, "agent");
            asm volatile("s_waitcnt vmcnt(0)" ::: "memory");
            const unsigned og = xb_add(&bar[XB_TOP], 1u);
            const unsigned tg = og / nx;
            if (og + 1u == (tg + 1u) * nx) xb_add(&bar[XB_TOPGEN], 1u);
            else XB_SPIN(xb_ld(&bar[XB_TOPGEN]) == tg, bar);
            __builtin_amdgcn_fence(__ATOMIC_ACQUIRE, "agent");
            xb_add(&bar[XB_XGEN(b.x)], 1u);
            asm volatile("s_waitcnt vmcnt(0)" ::: "memory");
        } else {
            XB_SPIN(xb_ld(&bar[XB_XGEN(b.x)]) == gen, bar);
            __builtin_amdgcn_fence(__ATOMIC_ACQUIRE, "agent");
            asm volatile("s_waitcnt vmcnt(0)" ::: "memory");
        }
    }
    __syncthreads();
}

#define LDS_WAIT() asm volatile("s_waitcnt lgkmcnt(0)" ::: "memory")

DI void tr_item64(const float* __restrict__ W, int N, bf16* __restrict__ WT, int kpitch, int drow0, int k0, int n0, const float* __restrict__ gain, LAS unsigned char* scr, int lane) {
    const int n4 = lane & 15, kq = lane >> 4, n = n0 + 4 * n4; const bool ok = n < N;
    f32x4 v[4][4];
#pragma unroll
    for (int g = 0; g < 4; ++g)
#pragma unroll
        for (int j = 0; j < 4; ++j) v[g][j] = ok ? __builtin_nontemporal_load((const f32x4*)(W + (size_t)(k0 + 16 * g + 4 * kq + j) * N + n)) : (f32x4){0.f, 0.f, 0.f, 0.f};
#pragma unroll
    for (int g = 0; g < 4; ++g) { float gj[4];
#pragma unroll
        for (int j = 0; j < 4; ++j) gj[j] = gain ? gain[k0 + 16 * g + 4 * kq + j] : 1.f;
        const int chunk = 2 * g + (kq >> 1), half = kq & 1;
#pragma unroll
        for (int i = 0; i < 4; ++i) { const int nn = 4 * n4 + i; v2u wv; wv.x = pk2(v[g][0][i] * gj[0], v[g][1][i] * gj[1]); wv.y = pk2(v[g][2][i] * gj[2], v[g][3][i] * gj[3]);
            *(LAS v2u*)(scr + nn * 128 + ((chunk ^ (n4 & 7)) << 4) + half * 8) = wv; } }
    LDS_WAIT(); asm volatile("" ::: "memory");
#pragma unroll
    for (int jj = 0; jj < 8; ++jj) { const int nn = (lane >> 3) + 8 * jj, c = lane & 7; const v4u o = *(const LAS v4u*)(scr + nn * 128 + ((c ^ ((nn >> 2) & 7)) << 4));
        *(v4u*)(WT + (size_t)(drow0 + nn) * kpitch + k0 + 8 * c) = o; }
    LDS_WAIT(); asm volatile("" ::: "memory");
}
DI void conv_mat(const float* W, int K, int N, int NP, bf16* WT, int mode, const float* gain, LAS unsigned char* scr, int gw, int NGW, int lane) {
    const int nblk = NP / 64, nit = nblk * (K / 64);
    for (int it = gw; it < nit; it += NGW) { const int kb = it / nblk, nb = it - kb * nblk, n0 = nb * 64;
        const int drow0 = (mode == 0) ? n0 : ((n0 >> 7) * 256 + (n0 & 127) + (mode == 2 ? 128 : 0));
        tr_item64(W, N, WT, K, drow0, kb * 64, n0, gain, scr, lane); }
}
DI void conv_tile_wg(const float* __restrict__ W, int K, int N, bf16* __restrict__ WT, int mode, const float* __restrict__ gain, LAS unsigned char* lds, int lane, int w, int k0, int n0) {
    const int col4 = lane & 31, rsub = lane >> 5;
    const int kl = 32 * w + 16 * rsub;
    const float* src = W + (size_t)(k0 + kl) * N + n0 + 4 * col4;
    f32x4 v[16];
#pragma unroll
    for (int i = 0; i < 16; ++i) v[i] = (n0 + 4 * col4 < N) ? __builtin_nontemporal_load((const f32x4*)(src + (size_t)i * N)) : (f32x4){0.f, 0.f, 0.f, 0.f};
    if (gain) {
#pragma unroll
        for (int i = 0; i < 16; ++i) v[i] = v[i] * gain[k0 + kl + i]; }
    const int c0 = 4 * w + 2 * rsub;
#pragma unroll
    for (int i = 0; i < 4; ++i) { const int nn = 4 * col4 + i;
#pragma unroll
        for (int hf = 0; hf < 2; ++hf) { v4u o; o.x = pk2(v[8 * hf + 0][i], v[8 * hf + 1][i]); o.y = pk2(v[8 * hf + 2][i], v[8 * hf + 3][i]); o.z = pk2(v[8 * hf + 4][i], v[8 * hf + 5][i]); o.w = pk2(v[8 * hf + 6][i], v[8 * hf + 7][i]);
            *(LAS v4u*)(lds + nn * 512 + (((c0 + hf) ^ (col4 & 7)) << 4)) = o; } }
    __syncthreads();
    const int drow0 = (mode == 0) ? n0 : ((n0 >> 7) * 256 + (mode == 2 ? 128 : 0));
#pragma unroll
    for (int jj = 0; jj < 8; ++jj) { const int nn = 16 * w + 2 * jj + rsub, c = lane & 31; const v4u o = *(const LAS v4u*)(lds + nn * 512 + ((c ^ ((nn >> 2) & 7)) << 4));
        *(v4u*)(WT + (size_t)(drow0 + nn) * K + k0 + 8 * c) = o; }
    __syncthreads();
}
DI void conv_mat_wg(const float* __restrict__ W, int K, int N, int NP, bf16* __restrict__ WT, int mode, const float* __restrict__ gain, LAS unsigned char* lds, int lane, int w, int bid, int G) {
    const int nsb = NP / 128, nst = nsb * (K / 256);
    __syncthreads();
    for (int st = bid; st < nst; st += G) { const int kb = st / nsb, nb = st - kb * nsb; conv_tile_wg(W, K, N, WT, mode, gain, lds, lane, w, kb * 256, nb * 128); }
}
DI void conv_moe_tiles(const float* __restrict__ wg_, const float* __restrict__ wu_, const float* __restrict__ wd_, const float* __restrict__ gain, bf16* __restrict__ MOEGU, bf16* __restrict__ MOED,
                       LAS unsigned char* lds, int lane, int w, int lo, int hi, int rank, int n) {
    __syncthreads();
    for (int t = lo + rank; t < hi; t += n) { const int mi = t / 112, st = t - mi * 112;
        if (mi < 8) { conv_tile_wg(wd_ + (size_t)mi * FFE * D, FFE, D, MOED + (size_t)mi * D * FFE, 0, nullptr, lds, lane, w, (st >> 3) * 256, (st & 7) * 128); }
        else { const int q = mi - 8, e = 7 - (q >> 1), up = q & 1; const int kb = st / 28, nb = st - kb * 28;
            conv_tile_wg((up ? wu_ : wg_) + (size_t)e * D * FFE, D, FFE, MOEGU + (size_t)e * 2 * FFE * D, up ? 2 : 1, gain, lds, lane, w, kb * 256, nb * 128); } }
}
DI void rope_tables(const int* __restrict__ pos, float* __restrict__ R1, float* __restrict__ R2, int gtid, int NT) {
    for (int idx = gtid; idx < M * 40; idx += NT) { const int m = idx / 40, i = idx - m * 40; const float p = (float)pos[m];
        float inv; if (i < 8) inv = exp2f(-(float)i * (18.931568569324174f / 8.0f)); else inv = exp2f(-(float)(i - 8) * (13.287712379549449f / 32.0f));
        double rev = (double)p * (double)inv * 0.15915494309189535; rev -= floor(rev); const float fr = (float)rev;
        const float c = __builtin_amdgcn_cosf(fr), s = __builtin_amdgcn_sinf(fr);
        if (i < 8) { R1[m * 16 + i] = c; R1[m * 16 + 8 + i] = s; } else { R2[m * 64 + (i - 8)] = c; R2[m * 64 + 32 + (i - 8)] = s; } }
}
DI void rms_row_bf16(const float* __restrict__ xrow, bf16* __restrict__ orow, int lane) {
    const f32x4* xr = (const f32x4*)xrow + lane;
    f32x4 v[4]; float s = 0.f;
#pragma unroll
    for (int j = 0; j < 4; ++j) { v[j] = xr[64 * j]; s += (v[j].x * v[j].x + v[j].y * v[j].y) + (v[j].z * v[j].z + v[j].w * v[j].w); }
    const float rstd = 1.f / sqrtf(wave_sum(s) * (1.f / D) + EPS);
    unsigned long long* o8 = (unsigned long long*)orow + lane;
#pragma unroll
    for (int j = 0; j < 4; ++j) o8[64 * j] = (unsigned long long)pk2(v[j].x * rstd, v[j].y * rstd) | ((unsigned long long)pk2(v[j].z * rstd, v[j].w * rstd) << 32);
}
DI void rms_phase(const float* __restrict__ src, bf16* __restrict__ dst, int gw, int NGW, int lane) {
    int m = gw;
    for (; m + 3 * NGW < M; m += 4 * NGW) { f32x4 v[4][4];
#pragma unroll
        for (int q = 0; q < 4; ++q) { const f32x4* xr = (const f32x4*)(src + (size_t)(m + q * NGW) * D) + lane;
#pragma unroll
            for (int j = 0; j < 4; ++j) v[q][j] = xr[64 * j]; }
#pragma unroll
        for (int q = 0; q < 4; ++q) { float s = 0.f;
#pragma unroll
            for (int j = 0; j < 4; ++j) s += (v[q][j].x * v[q][j].x + v[q][j].y * v[q][j].y) + (v[q][j].z * v[q][j].z + v[q][j].w * v[q][j].w);
            const float rstd = 1.f / sqrtf(wave_sum(s) * (1.f / D) + EPS);
            unsigned long long* o8 = (unsigned long long*)(dst + (size_t)(m + q * NGW) * D) + lane;
#pragma unroll
            for (int j = 0; j < 4; ++j) o8[64 * j] = (unsigned long long)pk2(v[q][j].x * rstd, v[q][j].y * rstd) | ((unsigned long long)pk2(v[q][j].z * rstd, v[q][j].w * rstd) << 32); } }
    for (; m < M; m += NGW) rms_row_bf16(src + (size_t)m * D, dst + (size_t)m * D, lane);
}
DI void rms_phase_b(const bf16* __restrict__ src, bf16* __restrict__ dst, int gw, int NGW, int lane) {
    constexpr int RB = 4; int m = gw;
    for (; m < M; m += RB * NGW) { v4u v[RB][2];
#pragma unroll
        for (int q = 0; q < RB; ++q) { const int mm = (m + q * NGW < M) ? m + q * NGW : m; const v4u* xr = (const v4u*)(src + (size_t)mm * D) + lane; v[q][0] = xr[0]; v[q][1] = xr[64]; }
#pragma unroll
        for (int q = 0; q < RB; ++q) if (m + q * NGW < M) { float x[16]; { float t8[8]; unpack8(v[q][0], t8);
#pragma unroll
                for (int i = 0; i < 8; ++i) x[i] = t8[i];
                unpack8(v[q][1], t8);
#pragma unroll
                for (int i = 0; i < 8; ++i) x[8 + i] = t8[i]; }
            float s_ = 0.f;
#pragma unroll
            for (int i = 0; i < 16; ++i) s_ += x[i] * x[i];
            const float rstd = 1.f / sqrtf(wave_sum(s_) * (1.f / D) + EPS);
            v4u o0, o1; o0.x = pk2(x[0] * rstd, x[1] * rstd); o0.y = pk2(x[2] * rstd, x[3] * rstd); o0.z = pk2(x[4] * rstd, x[5] * rstd); o0.w = pk2(x[6] * rstd, x[7] * rstd);
            o1.x = pk2(x[8] * rstd, x[9] * rstd); o1.y = pk2(x[10] * rstd, x[11] * rstd); o1.z = pk2(x[12] * rstd, x[13] * rstd); o1.w = pk2(x[14] * rstd, x[15] * rstd);
            v4u* orow = (v4u*)(dst + (size_t)(m + q * NGW) * D) + lane; orow[0] = o0; orow[64] = o1; } }
}
DI void cmp_bias_item(const float* __restrict__ posf, const float* __restrict__ w1, float* __restrict__ outp, int jb, int ch, int lane) {
    const int j = jb * 64 + lane; float a0 = 0.f, a1 = 0.f, a2 = 0.f, a3 = 0.f;
#pragma unroll
    for (int i = ch * 32; i < ch * 32 + 32; i += 4) {
        a0 += posf[i] * w1[(size_t)i * 256 + j]; a1 += posf[i + 1] * w1[(size_t)(i + 1) * 256 + j];
        a2 += posf[i + 2] * w1[(size_t)(i + 2) * 256 + j]; a3 += posf[i + 3] * w1[(size_t)(i + 3) * 256 + j]; }
    outp[ch * 256 + j] = (a0 + a1) + (a2 + a3);
}

DI void head_norm_rope(float (&x)[8], const float* __restrict__ gain, int sub, const float* __restrict__ cs) {
    float ss = 0.f;
#pragma unroll
    for (int i = 0; i < 8; ++i) ss += x[i] * x[i];
    ss = sum8(ss);
    const float rstd = 1.f / sqrtf(ss * (1.f / 64.f) + EPS);
#pragma unroll
    for (int i = 0; i < 8; ++i) x[i] = x[i] * rstd * gain[sub * 8 + i];
#pragma unroll
    for (int i = 0; i < 8; ++i) { const float other = xor1(x[i]); const float c = cs[i], s = cs[8 + i];
        if (sub == 0) x[i] = x[i] * c - other * s; else if (sub == 1) x[i] = x[i] * c + other * s; }
}
DI void q8_token(const bf16* __restrict__ src, const float* __restrict__ gain, const float* __restrict__ cs, bf16* __restrict__ dst, size_t hstride, int lane) {
    const int head = lane >> 3, sub = lane & 7; float x[8];
    unpack8(*(const v4u*)(src + head * 64 + sub * 8), x);
    head_norm_rope(x, gain, sub, cs);
#pragma unroll
    for (int i = 0; i < 8; ++i) x[i] *= 0.125f * LOG2E;
    *(v4u*)(dst + (size_t)head * hstride + sub * 8) = pack8(x);
}

constexpr int LP = 72;
constexpr int L_QIN = 0, L_KIN = 64 * LP * 2, L_KST = 2 * 64 * LP * 2, L_VT = 3 * 64 * LP * 2;

template <bool RET>
DI void chunk_phaseA(LAS unsigned char* lds, const bf16* __restrict__ PROJ, int ldp, int cq, int ck, int cv, int cglow,
                     const float* __restrict__ gate_up, const float* __restrict__ gate_bias, const float* __restrict__ rope2,
                     bf16* __restrict__ QIN, bf16* __restrict__ OINTRA, float* __restrict__ UT, float* __restrict__ DEC,
                     int lane, int w, int bid, int G) {
    const int r = lane & 15, quad = lane >> 4;
    struct ARaw { v4u a[6]; f32x4 c[4]; };
    auto load_raw = [&](int unit_, ARaw& R_) { const int b_ = unit_ >> 8, h_ = (unit_ >> 6) & 3, n_ = unit_ & 63; const int m_ = b_ * T + n_ * 64 + lane; const bf16* pr = PROJ + (size_t)m_ * ldp;
        if (!RET) { R_.a[0] = *(const v4u*)(pr + cglow); R_.a[1] = *(const v4u*)(pr + cglow + 8); R_.a[2] = *(const v4u*)(pr + cq + h_ * 64 + 8 * w); R_.a[3] = *(const v4u*)(pr + ck + h_ * 64 + 8 * w); }
        else { const int c0 = 8 * w, cp = (c0 + 32) & 63; R_.a[0] = *(const v4u*)(pr + cq + h_ * 64 + c0); R_.a[1] = *(const v4u*)(pr + cq + h_ * 64 + cp); R_.a[2] = *(const v4u*)(pr + ck + h_ * 64 + c0); R_.a[3] = *(const v4u*)(pr + ck + h_ * 64 + cp);
            const float* cs = rope2 + (size_t)m_ * 64 + (c0 & 31); R_.c[0] = *(const f32x4*)cs; R_.c[1] = *(const f32x4*)(cs + 4); R_.c[2] = *(const f32x4*)(cs + 32); R_.c[3] = *(const f32x4*)(cs + 36); }
        R_.a[4] = *(const v4u*)(pr + cv + h_ * 128 + 16 * w); R_.a[5] = *(const v4u*)(pr + cv + h_ * 128 + 16 * w + 8); };
    ARaw cur; if (bid < NUNIT) load_raw(bid, cur);
    LAS float* lgu = (LAS float*)(lds + 49152);
    if (!RET) { const int t_ = (int)threadIdx.x;
#pragma unroll
        for (int i = 0; i < 2; ++i) *(LAS f32x4*)(lgu + (t_ + 512 * i) * 4) = *(const f32x4*)(gate_up + (t_ + 512 * i) * 4);
        if (t_ < 64) *(LAS f32x4*)(lgu + 4096 + t_ * 4) = *(const f32x4*)(gate_bias + t_ * 4);
        __syncthreads(); }
    for (int unit = bid; unit < NUNIT; unit += G) {
        const int h = (unit >> 6) & 3;
        float la[8];
        if (!RET) {
            float gl[16]; { float t8[8]; unpack8(cur.a[0], t8);
#pragma unroll
                for (int i = 0; i < 8; ++i) gl[i] = t8[i];
                unpack8(cur.a[1], t8);
#pragma unroll
                for (int i = 0; i < 8; ++i) gl[8 + i] = t8[i]; }
            const int c0_ = h * 64 + 8 * w; float xg[8];
            { const f32x4 b0 = *(const LAS f32x4*)(lgu + 4096 + c0_), b1 = *(const LAS f32x4*)(lgu + 4096 + c0_ + 4);
#pragma unroll
                for (int cc = 0; cc < 4; ++cc) { xg[cc] = b0[cc]; xg[4 + cc] = b1[cc]; } }
#pragma unroll
            for (int rr = 0; rr < 16; ++rr) { const f32x4 u0 = *(const LAS f32x4*)(lgu + rr * 256 + c0_), u1 = *(const LAS f32x4*)(lgu + rr * 256 + c0_ + 4);
#pragma unroll
                for (int cc = 0; cc < 4; ++cc) { xg[cc] += gl[rr] * u0[cc]; xg[4 + cc] += gl[rr] * u1[cc]; } }
#pragma unroll
            for (int cc = 0; cc < 8; ++cc) { const float x = xg[cc]; la[cc] = (fminf(x, 0.f) - __logf(1.f + __expf(-fabsf(x)))) * (1.f / 16.f); }
        } else {
            const float lg = logf(1.f - exp2f(-5.f - (float)h));
#pragma unroll
            for (int cc = 0; cc < 8; ++cc) la[cc] = lg;
        }
        float bl[8];
#pragma unroll
        for (int cc = 0; cc < 8; ++cc) la[cc] = scan64(la[cc], lane, bl[cc]);
        float q[8], k[8];
        if (!RET) {
            unpack8(cur.a[2], q); unpack8(cur.a[3], k);
#pragma unroll
            for (int i = 0; i < 8; ++i) q[i] *= 0.125f;
        } else {
            const int c0 = 8 * w; float qp[8], kp[8];
            unpack8(cur.a[0], q); unpack8(cur.a[1], qp); unpack8(cur.a[2], k); unpack8(cur.a[3], kp);
#pragma unroll
            for (int i = 0; i < 8; ++i) { const float c = cur.c[i >> 2][i & 3], s = cur.c[2 + (i >> 2)][i & 3];
                if (c0 < 32) { q[i] = q[i] * c - qp[i] * s; k[i] = (k[i] * c - kp[i] * s) * 0.125f; }
                else         { q[i] = q[i] * c + qp[i] * s; k[i] = (k[i] * c + kp[i] * s) * 0.125f; } }
        }
        float qin[8], kin[8];
        LAS bf16* kst = (LAS bf16*)(lds + L_KST);
#pragma unroll
        for (int cc = 0; cc < 8; ++cc) { qin[cc] = q[cc] * __expf(la[cc]); kin[cc] = k[cc] * __expf(-la[cc]);
            kst[(8 * w + cc) * LP + lane] = (bf16)f2bf(k[cc] * __expf(bl[cc] - la[cc])); }
        const v4u qv = pack8(qin), kv = pack8(kin);
        *(LAS v4u*)(lds + L_QIN + (lane * LP + 8 * w) * 2) = qv;
        *(LAS v4u*)(lds + L_KIN + (lane * LP + 8 * w) * 2) = kv;
        *(v4u*)(QIN + (size_t)unit * 4096 + lane * 64 + 8 * w) = qv;
        if (lane == 63) {
#pragma unroll
            for (int cc = 0; cc < 8; ++cc) DEC[(size_t)unit * 64 + 8 * w + cc] = __expf(bl[cc]); }
        { float v0[8], v1[8]; unpack8(cur.a[4], v0); unpack8(cur.a[5], v1);
            LAS bf16* vt = (LAS bf16*)(lds + L_VT);
#pragma unroll
            for (int i = 0; i < 8; ++i) { vt[(16 * w + i) * LP + lane] = (bf16)f2bf(v0[i]); vt[(16 * w + 8 + i) * LP + lane] = (bf16)f2bf(v1[i]); } }
        __syncthreads();
        ARaw nxt; if (unit + G < NUNIT) load_raw(unit + G, nxt);
        {
            const int tt = w & 3, dh = w >> 2;
            const bf16x8 qf0 = *(const LAS bf16x8*)(lds + L_QIN + ((tt * 16 + r) * LP + quad * 8) * 2), qf1 = *(const LAS bf16x8*)(lds + L_QIN + ((tt * 16 + r) * LP + 32 + quad * 8) * 2);
            f32x4 acc[4];
#pragma unroll
            for (int d4 = 0; d4 < 4; ++d4) acc[d4] = (f32x4){0.f, 0.f, 0.f, 0.f};
            const int nks = (tt >> 1) + 1;
            for (int ks = 0; ks < nks; ++ks) { const int kb = 32 * ks, krow = kb + ((r >> 2) << 3) + (r & 3);
                const LAS unsigned char* kp = lds + L_KIN + (krow * LP + quad * 8) * 2;
                const bf16x8 k00 = *(const LAS bf16x8*)kp, k01 = *(const LAS bf16x8*)(kp + 64), k10 = *(const LAS bf16x8*)(kp + 4 * LP * 2), k11 = *(const LAS bf16x8*)(kp + 4 * LP * 2 + 64);
                f32x4 s0 = mfma16(k00, qf0, (f32x4){0.f, 0.f, 0.f, 0.f}); s0 = mfma16(k01, qf1, s0);
                f32x4 s1 = mfma16(k10, qf0, (f32x4){0.f, 0.f, 0.f, 0.f}); s1 = mfma16(k11, qf1, s1);
                const int tok = tt * 16 + r, key0 = kb + 8 * quad; float p[8];
#pragma unroll
                for (int jj = 0; jj < 4; ++jj) { p[jj] = (key0 + jj <= tok) ? s0[jj] : 0.f; p[4 + jj] = (key0 + 4 + jj <= tok) ? s1[jj] : 0.f; }
                const bf16x8 pf = __builtin_bit_cast(bf16x8, pack8(p));
#pragma unroll
                for (int d4 = 0; d4 < 4; ++d4) { const bf16x8 vf = *(const LAS bf16x8*)(lds + L_VT + ((dh * 64 + d4 * 16 + r) * LP + kb + quad * 8) * 2); acc[d4] = mfma16(vf, pf, acc[d4]); }
            }
#pragma unroll
            for (int d4 = 0; d4 < 4; ++d4) { v2u o; o.x = pk2(acc[d4][0], acc[d4][1]); o.y = pk2(acc[d4][2], acc[d4][3]); *(v2u*)(OINTRA + (size_t)unit * 8192 + (tt * 16 + r) * 128 + dh * 64 + d4 * 16 + 4 * quad) = o; }
        }
        {
#pragma unroll
            for (int dkt = 0; dkt < 4; ++dkt) { f32x4 au = (f32x4){0.f, 0.f, 0.f, 0.f};
#pragma unroll
                for (int ks = 0; ks < 2; ++ks) { const bf16x8 a = *(const LAS bf16x8*)(lds + L_VT + ((16 * w + r) * LP + 32 * ks + quad * 8) * 2);
                    const bf16x8 bq = *(const LAS bf16x8*)(lds + L_KST + ((dkt * 16 + r) * LP + 32 * ks + quad * 8) * 2); au = mfma16(a, bq, au); }
#pragma unroll
                for (int i = 0; i < 4; ++i) UT[(size_t)unit * 8192 + (16 * w + 4 * quad + i) * 64 + dkt * 16 + r] = au[i]; }
        }
        __syncthreads();
        if (unit + G < NUNIT) cur = nxt;
    }
}
DI void chunk_scan(const float* __restrict__ UT, const float* __restrict__ DEC, bf16* __restrict__ SB, int gtid, int NT) {
    for (int e = gtid; e < 16 * 4096; e += NT) { const int bh = e >> 12, idx2 = (e & 4095) * 2, dk = idx2 & 63; f32x2_t S = (f32x2_t){0.f, 0.f};
        const float* up = UT + (size_t)bh * 64 * 8192 + idx2; const float* dp = DEC + (size_t)bh * 64 * 64 + dk; unsigned* sp = (unsigned*)(SB + (size_t)bh * 64 * 8192 + idx2);
#pragma unroll 8
        for (int n = 0; n < 64; ++n) { const f32x2_t u = *(const f32x2_t*)(up + (size_t)n * 8192), d = *(const f32x2_t*)(dp + n * 64); sp[(size_t)n * 4096] = pk2(S.x, S.y); S = d * S + u; } }
}
template <bool RET>
DI void chunk_phaseC(const bf16* __restrict__ QIN, const bf16* __restrict__ OINTRA, const bf16* __restrict__ SB, const bf16* __restrict__ PROJ, int ldp, int cgate,
                     const float* __restrict__ gnorm, bf16* __restrict__ MIXED, int gw, int NGW, int lane) {
    const int r = lane & 15, quad = lane >> 4;
    for (int wu0 = gw; wu0 < NUNIT * 4; wu0 += 2 * NGW) {
        int unit[2], tt[2]; bool ok[2]; bf16x8 qf[2][2]; v2u oi[2][8], gv[2][8]; size_t mrow[2]; int hh[2];
#pragma unroll
        for (int q = 0; q < 2; ++q) { const int wu = wu0 + q * NGW; ok[q] = wu < NUNIT * 4; const int wv = ok[q] ? wu : wu0; unit[q] = wv >> 2; tt[q] = wv & 3;
            const int b = unit[q] >> 8, n = unit[q] & 63; hh[q] = (unit[q] >> 6) & 3; mrow[q] = (size_t)b * T + n * 64 + tt[q] * 16 + r;
            const bf16* qp = QIN + (size_t)unit[q] * 4096 + (tt[q] * 16 + r) * 64 + quad * 8; qf[q][0] = ldg16(qp); qf[q][1] = ldg16(qp + 32);
#pragma unroll
            for (int dt = 0; dt < 8; ++dt) { oi[q][dt] = *(const v2u*)(OINTRA + (size_t)unit[q] * 8192 + (tt[q] * 16 + r) * 128 + dt * 16 + 4 * quad);
                gv[q][dt] = *(const v2u*)(PROJ + mrow[q] * ldp + cgate + hh[q] * 128 + dt * 16 + 4 * quad); } }
        f32x4 acc[2][8];
#pragma unroll
        for (int dt = 0; dt < 8; ++dt)
#pragma unroll
            for (int q = 0; q < 2; ++q) { acc[q][dt] = (f32x4){bflo(oi[q][dt].x), bfhi(oi[q][dt].x), bflo(oi[q][dt].y), bfhi(oi[q][dt].y)};
#pragma unroll
                for (int kk = 0; kk < 2; ++kk) acc[q][dt] = mfma16(ldg16(SB + (size_t)unit[q] * 8192 + (dt * 16 + r) * 64 + kk * 32 + quad * 8), qf[q][kk], acc[q][dt]); }
#pragma unroll
        for (int q = 0; q < 2; ++q) if (ok[q]) {
            float mean = 0.f;
            if (RET) { float s_ = 0.f;
#pragma unroll
                for (int dt = 0; dt < 8; ++dt) s_ += (acc[q][dt][0] + acc[q][dt][1]) + (acc[q][dt][2] + acc[q][dt][3]);
                s_ += __shfl_xor(s_, 16); s_ += __shfl_xor(s_, 32); mean = s_ * (1.f / 128.f); }
            float ss = 0.f;
#pragma unroll
            for (int dt = 0; dt < 8; ++dt)
#pragma unroll
                for (int i = 0; i < 4; ++i) { const float d = acc[q][dt][i] - mean; ss += d * d; }
            ss += __shfl_xor(ss, 16); ss += __shfl_xor(ss, 32);
            const float rstd = 1.f / sqrtf(ss * (1.f / 128.f) + EPS);
#pragma unroll
            for (int dt = 0; dt < 8; ++dt) { const int dv = dt * 16 + 4 * quad; const v2u g_ = gv[q][dt];
                const float g0 = bflo(g_.x), g1 = bfhi(g_.x), g2 = bflo(g_.y), g3 = bfhi(g_.y);
                const float* gn = gnorm + (RET ? hh[q] * 128 : 0) + dv;
                const float y0 = (acc[q][dt][0] - mean) * rstd * gn[0] * silu_f(g0), y1 = (acc[q][dt][1] - mean) * rstd * gn[1] * silu_f(g1);
                const float y2 = (acc[q][dt][2] - mean) * rstd * gn[2] * silu_f(g2), y3 = (acc[q][dt][3] - mean) * rstd * gn[3] * silu_f(g3);
                v2u o; o.x = pk2(y0, y1); o.y = pk2(y2, y3);
                *(v2u*)(MIXED + mrow[q] * 1024 + hh[q] * 128 + dv) = o; } }
    }
}

struct KVF { bf16x8 k[4]; bf16x8 v[4]; };
DI void kv_load(KVF& f, const bf16* __restrict__ Kb, const bf16* __restrict__ VTb, int kb, int r, int quad) {
    const bf16* kp = Kb + (size_t)(kb + ((r >> 2) << 3) + (r & 3)) * 64 + quad * 8;
    f.k[0] = ldg16(kp); f.k[1] = ldg16(kp + 32); f.k[2] = ldg16(kp + 256); f.k[3] = ldg16(kp + 288);
    const bf16* vp = VTb + (size_t)(kb >> 5) * 2048 + r * 32 + quad * 8;
#pragma unroll
    for (int dt = 0; dt < 4; ++dt) f.v[dt] = ldg16(vp + dt * 512);
}
DI void k_load(KVF& f, const bf16* __restrict__ Kb, int kb, int r, int quad) {
    const bf16* kp = Kb + (size_t)(kb + ((r >> 2) << 3) + (r & 3)) * 64 + quad * 8;
    f.k[0] = ldg16(kp); f.k[1] = ldg16(kp + 32); f.k[2] = ldg16(kp + 256); f.k[3] = ldg16(kp + 288);
}
DI size_t kblk_off(int key, int d0) { const int kap = key & 31, a = kap >> 3, t = (kap >> 2) & 1, c = kap & 3, sub = d0 >> 3; return (size_t)(key >> 5) * 2048 + (t * 2 + (sub >> 2)) * 512 + ((sub & 3) * 16 + 4 * a + c) * 8; }
DI void glds16(const bf16* g, LAS unsigned char* l) { __builtin_amdgcn_global_load_lds((const unsigned*)g, (LAS unsigned*)l, 16, 0, 0); }
DI void kv_dma(LAS unsigned char* slot, const bf16* __restrict__ Kb, const bf16* __restrict__ VTb, int kb, int r, int quad) {
    const bf16* kp = Kb + (size_t)(kb >> 5) * 2048 + (quad * 16 + r) * 8;
    glds16(kp, slot); glds16(kp + 512, slot + 1024); glds16(kp + 1024, slot + 2048); glds16(kp + 1536, slot + 3072);
    const bf16* vp = VTb + (size_t)(kb >> 5) * 2048 + r * 32 + quad * 8;
#pragma unroll
    for (int dt = 0; dt < 4; ++dt) glds16(vp + dt * 512, slot + 4096 + dt * 1024);
}
DI void kv_read(KVF& f, const LAS unsigned char* slot, int lane) {
#pragma unroll
    for (int i = 0; i < 4; ++i) { f.k[i] = *(const LAS bf16x8*)(slot + i * 1024 + lane * 16); f.v[i] = *(const LAS bf16x8*)(slot + 4096 + i * 1024 + lane * 16); }
}
DI void k_dma(LAS unsigned char* slot, const bf16* __restrict__ Kb, int kb, int r, int quad) {
    const bf16* kp = Kb + (size_t)(kb >> 5) * 2048 + (quad * 16 + r) * 8;
    glds16(kp, slot); glds16(kp + 512, slot + 1024); glds16(kp + 1024, slot + 2048); glds16(kp + 1536, slot + 3072);
}
DI void k_read(KVF& f, const LAS unsigned char* slot, int lane) {
#pragma unroll
    for (int i = 0; i < 4; ++i) f.k[i] = *(const LAS bf16x8*)(slot + i * 1024 + lane * 16);
}
#define VM_WAIT(n) asm volatile("s_waitcnt vmcnt(" #n ")" ::: "memory")
DI void mask_bias(unsigned vm, float c2, f32x4& blo, f32x4& bhi) {
#pragma unroll
    for (int jj = 0; jj < 4; ++jj) { blo[jj] = ((vm >> jj) & 1u) ? -c2 : -1e30f; bhi[jj] = ((vm >> (4 + jj)) & 1u) ? -c2 : -1e30f; } }
DI void scores8(const KVF& f, const bf16x8 (&q)[2], const f32x4 blo, const f32x4 bhi, f32x4& s0, f32x4& s1) {
    s0 = mfma16(f.k[0], q[0], blo); s1 = mfma16(f.k[2], q[0], bhi); s0 = mfma16(f.k[1], q[1], s0); s1 = mfma16(f.k[3], q[1], s1); }
DI bf16x8 ones_frag() { return __builtin_bit_cast(bf16x8, (v4u){0x3f803f80u, 0x3f803f80u, 0x3f803f80u, 0x3f803f80u}); }
DI void attn_compute(const KVF& f, unsigned vm, const bf16x8 (&qf)[4][2], f32x4 (&acc)[4][4], f32x4 (&accl)[4], float c2) {
    f32x4 blo, bhi; mask_bias(vm, c2, blo, bhi);
    f32x4 s0[4], s1[4];
#pragma unroll
    for (int g = 0; g < 4; ++g) { s0[g] = mfma16(f.k[0], qf[g][0], blo); s1[g] = mfma16(f.k[2], qf[g][0], bhi); }
#pragma unroll
    for (int g = 0; g < 4; ++g) { s0[g] = mfma16(f.k[1], qf[g][1], s0[g]); s1[g] = mfma16(f.k[3], qf[g][1], s1[g]); }
    const bf16x8 ones = ones_frag();
#pragma unroll
    for (int g = 0; g < 4; ++g) { float p[8];
#pragma unroll
        for (int jj = 0; jj < 4; ++jj) { p[jj] = __builtin_amdgcn_exp2f(s0[g][jj]); p[4 + jj] = __builtin_amdgcn_exp2f(s1[g][jj]); }
        const bf16x8 pf = __builtin_bit_cast(bf16x8, pack8(p));
#pragma unroll
        for (int dt = 0; dt < 4; ++dt) acc[g][dt] = mfma16(f.v[dt], pf, acc[g][dt]);
        accl[g] = mfma16(ones, pf, accl[g]); }
}
DI unsigned win_mask(int kb, int quad, int tok, int W) { unsigned vm = 0u;
#pragma unroll
    for (int jj = 0; jj < 8; ++jj) { const int key = kb + 8 * quad + jj; if (key <= tok && key > tok - W) vm |= 1u << jj; }
    return vm; }
DI void load_q(bf16x8 (&qf)[4][2], const bf16* __restrict__ Q, int b, int hk, int t0, int r, int quad) {
#pragma unroll
    for (int g = 0; g < 4; ++g) { const bf16* qp = Q + ((size_t)(b * 8 + hk * 4 + g) * T + t0 + r) * 64 + quad * 8; qf[g][0] = ldg16(qp); qf[g][1] = ldg16(qp + 32); }
}
DI float wave_max_abs64(const float* __restrict__ g, int lane) { float v = fabsf(g[lane]);
#pragma unroll
    for (int o = 1; o < 64; o <<= 1) v = fmaxf(v, __shfl_xor(v, o));
    return v; }
DI int bal_tile(int wu) { const int u = wu & 255, w = u & 7, q = u >> 3, pair = q * 4 + (w & 3); return (w < 4) ? pair : 255 - pair; }
DI float quad_sum(float v) { v += __shfl_xor(v, 16); v += __shfl_xor(v, 32); return v; }
template <bool SINK, bool TO_MIXED>
DI void window_attn(const bf16* __restrict__ Q, const bf16* __restrict__ Kx, const bf16* __restrict__ VT, int W, const float* __restrict__ sinks, const float* __restrict__ gq, const float* __restrict__ gk,
                    bf16* __restrict__ MIXED, float* __restrict__ ONSA, const bf16* __restrict__ PROJ1, LAS unsigned char* ring, int gw, int NGW, int lane) {
    const int r = lane & 15, quad = lane >> 4; const float sc2 = 0.125f * LOG2E;
    float c2 = sc2 * 64.f * wave_max_abs64(gq, lane) * wave_max_abs64(gk, lane);
    if (SINK) { c2 = fmaxf(c2, fmaxf(fmaxf(sinks[0], sinks[1]), fmaxf(sinks[2], sinks[3])) * LOG2E); c2 = fmaxf(c2, fmaxf(fmaxf(sinks[4], sinks[5]), fmaxf(sinks[6], sinks[7])) * LOG2E); }
    for (int wu = gw; wu < BATCH * 2 * 256; wu += NGW) { const int tile = bal_tile(wu), hk = (wu >> 8) & 1, b = wu >> 9, t0 = tile * 16, tok = t0 + r;
        bf16x8 qf[4][2]; load_q(qf, Q, b, hk, t0, r, quad);
        f32x4 acc[4][4], accl[4];
#pragma unroll
        for (int g = 0; g < 4; ++g) { accl[g] = (f32x4){0.f, 0.f, 0.f, 0.f};
#pragma unroll
            for (int dt = 0; dt < 4; ++dt) acc[g][dt] = (f32x4){0.f, 0.f, 0.f, 0.f}; }
        const bf16* Kb = Kx + (size_t)(b * 2 + hk) * T * 64; const bf16* VTb = VT + (size_t)(b * 2 + hk) * 64 * T;
        int kb0 = t0 - (W - 1); kb0 = kb0 < 0 ? 0 : (kb0 & ~31);
        const int nst = ((t0 & ~31) - kb0) / 32 + 1;
        VM_WAIT(0);
        kv_dma(ring, Kb, VTb, kb0, r, quad); if (nst > 1) kv_dma(ring + 8192, Kb, VTb, kb0 + 32, r, quad);
        for (int st = 0; st < nst; ++st) { KVF cur;
            if (st + 1 < nst) VM_WAIT(8); else VM_WAIT(0);
            kv_read(cur, ring + (st & 1) * 8192, lane); LDS_WAIT();
            if (st + 2 < nst) kv_dma(ring + (st & 1) * 8192, Kb, VTb, kb0 + 32 * (st + 2), r, quad);
            attn_compute(cur, win_mask(kb0 + 32 * st, quad, tok, W), qf, acc, accl, c2); }
        const size_t m = (size_t)b * T + tok;
#pragma unroll
        for (int g = 0; g < 4; ++g) { float l = accl[g][0]; if (SINK) l += __builtin_amdgcn_exp2f(sinks[hk * 4 + g] * LOG2E - c2);
            float inv = l > 0.f ? 1.f / l : 0.f;
            if (!TO_MIXED) { const float gl = __builtin_bit_cast(float, ((unsigned)PROJ1[m * N1P + C1_NG + hk * 12 + g * 3 + 2]) << 16); inv *= 1.f / (1.f + __expf(-gl)); }
#pragma unroll
            for (int dt = 0; dt < 4; ++dt) { const f32x4 o = acc[g][dt] * inv; const int col = (hk * 4 + g) * 64 + dt * 16 + 4 * quad;
                if (TO_MIXED) { v2u w2; w2.x = pk2(o[0], o[1]); w2.y = pk2(o[2], o[3]); *(v2u*)(MIXED + m * 1024 + 512 + col) = w2; }
                else *(f32x4*)(ONSA + m * 512 + col) = o; } }
    }
}

#ifndef PROBE_A
#define PROBE_A -1
#endif
#define SUBSTAMP(k) do { if (PROBE_A >= 0 && blockIdx.x == 0 && threadIdx.x == 256) ((volatile LAS unsigned long long*)(plds - 4 * 4096 + (MISC_OFF + 128) / 4))[k] = __builtin_amdgcn_s_memrealtime(); } while (0)
DI void nsa_cmp_slc(const bf16* __restrict__ Q, const bf16* __restrict__ KCB, const bf16* __restrict__ VCBT, const bf16* __restrict__ KSL, const bf16* __restrict__ VSLT,
                    const float* __restrict__ gq, const float* __restrict__ gkc, const float* __restrict__ gks,
                    const bf16* __restrict__ PROJ1, float* __restrict__ ONSA, bf16* __restrict__ MIXED, LAS unsigned char* lds, int w, int gw, int NGW, int lane) {
    LAS float* plds = (LAS float*)(lds + w * 16384);
    const int r = lane & 15, quad = lane >> 4; const float sc2 = 0.125f * LOG2E;
    const float gqm = wave_max_abs64(gq, lane); const float c2c = sc2 * 64.f * gqm * wave_max_abs64(gkc, lane), c2s = sc2 * 64.f * gqm * wave_max_abs64(gks, lane);
    for (int wu = gw; wu < BATCH * 2 * 256; wu += NGW) { const int tile = bal_tile(wu), hk = (wu >> 8) & 1, b = wu >> 9, t0 = tile * 16, tok = t0 + r;
        bf16x8 qf[4][2]; load_q(qf, Q, b, hk, t0, r, quad);
        const size_t m = (size_t)b * T + tok;
        LAS unsigned char* ring = (LAS unsigned char*)plds; LAS float* imain = plds + 2048; LAS float* icarry = plds + 3072;
#pragma unroll
        for (int i = 0; i < 8; ++i) *(LAS f32x4*)(imain + (i * 64 + lane) * 4) = (f32x4){0.f, 0.f, 0.f, 0.f};
        const bf16* Kc = KCB + (size_t)(b * 2 + hk) * 256 * 64; const bf16* Vc = VCBT + (size_t)(b * 2 + hk) * 64 * 256;
        const int nsteps = ((t0 >> 4) + 31) >> 5;
        f32x4 accl[4];
#pragma unroll
        for (int g = 0; g < 4; ++g) accl[g] = (f32x4){0.f, 0.f, 0.f, 0.f};
        VM_WAIT(0);
        if (nsteps > 0) k_dma(ring, Kc, 0, r, quad);
        for (int st = 0; st < nsteps; ++st) { const int kb = 32 * st; KVF cur;
            VM_WAIT(0); k_read(cur, ring, lane); LDS_WAIT();
            if (st + 1 < nsteps) k_dma(ring, Kc, kb + 32, r, quad);
            unsigned vm = 0u;
#pragma unroll
            for (int jj = 0; jj < 8; ++jj) if (16 * (kb + 8 * quad + jj) + 31 <= tok) vm |= 1u << jj;
            f32x4 blo, bhi; mask_bias(vm, c2c, blo, bhi); const bf16x8 ones = ones_frag();
#pragma unroll
            for (int g = 0; g < 4; ++g) { f32x4 s0, s1; scores8(cur, qf[g], blo, bhi, s0, s1); float p[8];
#pragma unroll
                for (int jj = 0; jj < 4; ++jj) { p[jj] = __builtin_amdgcn_exp2f(s0[jj]); p[4 + jj] = __builtin_amdgcn_exp2f(s1[jj]); }
                accl[g] = mfma16(ones, __builtin_bit_cast(bf16x8, pack8(p)), accl[g]); } }
        float invl[4];
#pragma unroll
        for (int g = 0; g < 4; ++g) { const float l = accl[g][0]; invl[g] = l > 0.f ? 1.f / l : 0.f; }
        f32x4 acc[4][4];
#pragma unroll
        for (int g = 0; g < 4; ++g)
#pragma unroll
            for (int dt = 0; dt < 4; ++dt) acc[g][dt] = (f32x4){0.f, 0.f, 0.f, 0.f};
        if (nsteps > 0) kv_dma(ring, Kc, Vc, 0, r, quad);
        for (int st = 0; st < nsteps; ++st) { const int kb = 32 * st; KVF cur;
            VM_WAIT(0); kv_read(cur, ring, lane); LDS_WAIT();
            if (st + 1 < nsteps) kv_dma(ring, Kc, Vc, kb + 32, r, quad);
            unsigned vm = 0u;
#pragma unroll
            for (int jj = 0; jj < 8; ++jj) if (16 * (kb + 8 * quad + jj) + 31 <= tok) vm |= 1u << jj;
            f32x4 blo, bhi; mask_bias(vm, c2c, blo, bhi);
            float ps[8];
#pragma unroll
            for (int jj = 0; jj < 8; ++jj) ps[jj] = 0.f;
#pragma unroll
            for (int g = 0; g < 4; ++g) { f32x4 s0, s1; scores8(cur, qf[g], blo, bhi, s0, s1); float p[8];
#pragma unroll
                for (int jj = 0; jj < 4; ++jj) { p[jj] = __builtin_amdgcn_exp2f(s0[jj]) * invl[g]; p[4 + jj] = __builtin_amdgcn_exp2f(s1[jj]) * invl[g]; }
#pragma unroll
                for (int jj = 0; jj < 8; ++jj) ps[jj] += p[jj];
                const bf16x8 pf = __builtin_bit_cast(bf16x8, pack8(p));
#pragma unroll
                for (int dt = 0; dt < 4; ++dt) acc[g][dt] = mfma16(cur.v[dt], pf, acc[g][dt]); }
            const int j0 = (kb >> 2) + 2 * quad;
            f32x2_t mv; mv.x = 2.f * (ps[0] + ps[1] + ps[2]) + ps[3]; mv.y = ps[3] + 2.f * (ps[4] + ps[5] + ps[6]) + ps[7];
            *(LAS f32x2_t*)(imain + r * 64 + j0) = mv;
            if (j0 + 2 < 64) icarry[r * 64 + j0 + 2] = ps[7]; }
#pragma unroll
        for (int g = 0; g < 4; ++g) { const float gate0 = 1.f / (1.f + __expf(-__builtin_bit_cast(float, ((unsigned)PROJ1[m * N1P + C1_NG + hk * 12 + g * 3]) << 16)));
#pragma unroll
            for (int dt = 0; dt < 4; ++dt) { float* op = ONSA + m * 512 + (hk * 4 + g) * 64 + dt * 16 + 4 * quad; *(f32x4*)op = *(const f32x4*)op + acc[g][dt] * gate0; } }
        LDS_WAIT(); asm volatile("" ::: "memory"); __builtin_amdgcn_wave_barrier();
        unsigned long long mymask = 0ull, uni = 0ull;
        for (int tk = 0; tk < 16; ++tk) { const int tblk = (t0 + tk) >> 6, j = lane;
            const float imp = imain[tk * 64 + j] + icarry[tk * 64 + j];
            const bool forced = (j == 0) || (j == tblk) || (j == tblk - 1), allowed = j <= tblk;
            const float score = forced ? 1e9f : (allowed ? imp : -1e9f);
            unsigned u = __builtin_bit_cast(unsigned, score); u = (u & 0x80000000u) ? ~u : (u | 0x80000000u);
            const unsigned key = (u & ~63u) | (unsigned)(63 - j);
            unsigned prefix = 0u;
#pragma unroll
            for (int bit = 31; bit >= 0; --bit) { const unsigned cand = prefix | (1u << bit); const unsigned long long ge = __ballot(key >= cand); if (__builtin_popcountll(ge) >= 16) prefix = cand; }
            const unsigned long long mask = __ballot((key >= prefix) && allowed);
            if (r == tk) mymask = mask;
            uni |= mask; }
#pragma unroll
        for (int g = 0; g < 4; ++g) { accl[g] = (f32x4){0.f, 0.f, 0.f, 0.f};
#pragma unroll
            for (int dt = 0; dt < 4; ++dt) acc[g][dt] = (f32x4){0.f, 0.f, 0.f, 0.f}; }
        const bf16* Kb = KSL + (size_t)(b * 2 + hk) * T * 64; const bf16* VTb = VSLT + (size_t)(b * 2 + hk) * 64 * T;
        {   LAS unsigned long long* xu = (LAS unsigned long long*)(lds + LDSCTL_OFF + 2048);
            if (lane == 0) xu[w] = uni;
            VM_WAIT(0); LDS_WAIT();
            __syncthreads();
            unsigned long long wgu = 0ull;
#pragma unroll
            for (int i = 0; i < 8; ++i) wgu |= xu[i];
            constexpr int NB = 4;
            const int n = __builtin_popcountll(wgu); unsigned long long remi = wgu, remc = wgu;
            const bf16* src0 = (w < 4) ? Kb + w * 512 + lane * 8 : VTb + (w - 4) * 512 + r * 32 + quad * 8;
            auto blk_dma = [&](int bufi, int j) { LAS unsigned char* bp = lds + bufi * 16384 + w * 1024;
                glds16(src0 + (size_t)(2 * j) * 2048, bp); glds16(src0 + (size_t)(2 * j + 1) * 2048, bp + 8192); };
            for (int k = 0; k < NB - 1 && k < n; ++k) { const int j = __builtin_ctzll(remi); remi &= remi - 1ull; blk_dma(k, j); }
            for (int i = 0; i < n; ++i) { const int left = n - 1 - i;
                if (left >= 2) VM_WAIT(4); else if (left == 1) VM_WAIT(2); else VM_WAIT(0);
                __syncthreads();
                if (i + NB - 1 < n) { const int j2 = __builtin_ctzll(remi); remi &= remi - 1ull; blk_dma((i + NB - 1) % NB, j2); }
                const int j = __builtin_ctzll(remc); remc &= remc - 1ull;
                if ((uni >> j) & 1ull) { const bool sb = (mymask >> j) & 1ull; const LAS unsigned char* bp = lds + (i % NB) * 16384;
#pragma unroll
                    for (int hf = 0; hf < 2; ++hf) { KVF cur; kv_read(cur, bp + hf * 8192, lane); LDS_WAIT();
                        const int kb = 64 * j + 32 * hf; unsigned vm = 0u;
#pragma unroll
                        for (int jj = 0; jj < 8; ++jj) if (sb && (kb + 8 * quad + jj <= tok)) vm |= 1u << jj;
                        attn_compute(cur, vm, qf, acc, accl, c2s); } } }
            __syncthreads();
        }
#pragma unroll
        for (int g = 0; g < 4; ++g) { const float l = accl[g][0]; const float gate1 = 1.f / (1.f + __expf(-__builtin_bit_cast(float, ((unsigned)PROJ1[m * N1P + C1_NG + hk * 12 + g * 3 + 1]) << 16)));
            const float inv = (l > 0.f ? 1.f / l : 0.f) * gate1;
#pragma unroll
            for (int dt = 0; dt < 4; ++dt) { const int col = (hk * 4 + g) * 64 + dt * 16 + 4 * quad; const f32x4 o = *(const f32x4*)(ONSA + m * 512 + col) + acc[g][dt] * inv;
                v2u w2; w2.x = pk2(o[0], o[1]); w2.y = pk2(o[2], o[3]); *(v2u*)(MIXED + m * 1024 + 512 + col) = w2; } }
        __builtin_amdgcn_wave_barrier();
    }
}
DI float gelu_tanh(float x) { const float u = 0.7978845608028654f * (x + 0.044715f * x * x * x); const float e = __expf(2.f * u); const float th = 1.f - 2.f / (e + 1.f); return 0.5f * x * (1.f + th); }
DI void cmp_layer2(const float* __restrict__ CMPH, const bf16* __restrict__ W2T, const float* __restrict__ b2k, const float* __restrict__ b2v,
                   const float* __restrict__ kcnorm, const float* __restrict__ rope1, bf16* __restrict__ KCB, bf16* __restrict__ VCBT, int u0, int u1, int ustep, int lane) {
    const int r = lane & 15, quad = lane >> 4;
    for (int wu = u0; wu < u1; wu += ustep) { const int kv = wu >> 7, rt = wu & 127;
        const float* hp = CMPH + ((size_t)kv * 2048 + rt * 16 + r) * 256 + quad * 8; const bf16* wp = W2T + (size_t)kv * 64 * 256 + (size_t)r * 256 + quad * 8;
        f32x4 acc[4];
#pragma unroll
        for (int nt = 0; nt < 4; ++nt) acc[nt] = (f32x4){0.f, 0.f, 0.f, 0.f};
        f32x4 hv[16];
#pragma unroll
        for (int kk = 0; kk < 8; ++kk) { hv[2 * kk] = *(const f32x4*)(hp + kk * 32); hv[2 * kk + 1] = *(const f32x4*)(hp + kk * 32 + 4); }
#pragma unroll
        for (int kk = 0; kk < 8; ++kk) { bf16x8 wf[4];
#pragma unroll
            for (int nt = 0; nt < 4; ++nt) wf[nt] = ldg16(wp + (size_t)nt * 16 * 256 + kk * 32);
            float ge[8];
#pragma unroll
            for (int i = 0; i < 4; ++i) { ge[i] = gelu_tanh(hv[2 * kk][i]); ge[4 + i] = gelu_tanh(hv[2 * kk + 1][i]); }
            const bf16x8 af = __builtin_bit_cast(bf16x8, pack8(ge));
#pragma unroll
            for (int nt = 0; nt < 4; ++nt) acc[nt] = mfma16(af, wf[nt], acc[nt]); }
        const float* b2 = kv ? b2v : b2k;
#pragma unroll
        for (int nt = 0; nt < 4; ++nt) { const float bb = b2[nt * 16 + r]; acc[nt] = acc[nt] + bb; }
#pragma unroll
        for (int i = 0; i < 4; ++i) { const int row = rt * 16 + 4 * quad + i, bh = row >> 8, n = row & 255; const bool pad = (n == 255);
            if (kv == 0) { float ss = 0.f;
#pragma unroll
                for (int nt = 0; nt < 4; ++nt) ss += acc[nt][i] * acc[nt][i];
                ss = sum16(ss); const float rstd = 1.f / sqrtf(ss * (1.f / 64.f) + EPS);
                float y[4];
#pragma unroll
                for (int nt = 0; nt < 4; ++nt) y[nt] = acc[nt][i] * rstd * kcnorm[nt * 16 + r];
                const float other = dppf<0x128>(y[0]);
                const float* cs = rope1 + ((size_t)(bh >> 1) * T + (pad ? 0 : 16 * n + 31)) * 16;
                y[0] = (r < 8) ? y[0] * cs[r] - other * cs[8 + r] : y[0] * cs[r - 8] + other * cs[r];
#pragma unroll
                for (int nt = 0; nt < 4; ++nt) { const int d = nt * 16 + r; KCB[(size_t)bh * 256 * 64 + kblk_off(n, d & ~7) + (d & 7)] = pad ? (bf16)0 : (bf16)f2bf(y[nt]); }
            } else {
#pragma unroll
                for (int nt = 0; nt < 4; ++nt) VCBT[(((size_t)bh * 8 + (n >> 5)) * 64 + nt * 16 + r) * 32 + (n & 31)] = pad ? (bf16)0 : (bf16)f2bf(acc[nt][i]);
            } }
    }
}

DI void prep0_swa(const bf16* __restrict__ PROJ, const float* __restrict__ qn, const float* __restrict__ kn, const float* __restrict__ rope1,
                  bf16* __restrict__ QS, bf16* __restrict__ KS, bf16* __restrict__ VST, int lane, int w, int bid, int G) {
    for (int grp = bid; grp < M / 64; grp += G) { const int m0 = grp * 64, b = m0 / T, t0 = m0 % T;
#pragma unroll
        for (int i = 0; i < 8; ++i) { const int tl = 8 * w + i; const size_t m = (size_t)m0 + tl;
            q8_token(PROJ + m * N0P + C0_SQ, qn, rope1 + m * 16, QS + ((size_t)(b * 8) * T + t0 + tl) * 64, (size_t)T * 64, lane); }
#pragma unroll
        for (int p = 0; p < 2; ++p) { const int tl = 8 * w + 4 * p + (lane >> 4), head = (lane >> 3) & 1, sub = lane & 7; const size_t m = (size_t)m0 + tl; float x[8];
            unpack8(*(const v4u*)(PROJ + m * N0P + C0_SK + head * 64 + sub * 8), x); head_norm_rope(x, kn, sub, rope1 + m * 16);
            *(v4u*)(KS + (size_t)(b * 2 + head) * T * 64 + kblk_off(t0 + tl, sub * 8)) = pack8(x); }
        { const size_t m = (size_t)m0 + lane; const v4u a = *(const v4u*)(PROJ + m * N0P + C0_SV + 16 * w), c = *(const v4u*)(PROJ + m * N0P + C0_SV + 16 * w + 8);
            const unsigned wv[8] = {a.x, a.y, a.z, a.w, c.x, c.y, c.z, c.w};
#pragma unroll
            for (int i = 0; i < 16; ++i) { const int hd = 16 * w + i; VST[(((size_t)(b * 2 + (hd >> 6)) * (T / 32) + ((t0 + lane) >> 5)) * 64 + (hd & 63)) * 32 + ((t0 + lane) & 31)] = (bf16)((i & 1) ? (wv[i >> 1] >> 16) : (wv[i >> 1] & 0xffffu)); } }
    }
}
DI void prep1_nsa(const bf16* __restrict__ PROJ, const float* __restrict__ qn, const float* __restrict__ ksn, const float* __restrict__ kwn, const float* __restrict__ rope1,
                  bf16* __restrict__ QS, bf16* __restrict__ KS, bf16* __restrict__ KW, bf16* __restrict__ KCR, bf16* __restrict__ VCR, bf16* __restrict__ VST, bf16* __restrict__ VWT,
                  int lane, int w, int bid, int G) {
    for (int grp = bid; grp < M / 64; grp += G) { const int m0 = grp * 64, b = m0 / T, t0 = m0 % T;
#pragma unroll
        for (int i = 0; i < 8; ++i) { const int tl = 8 * w + i; const size_t m = (size_t)m0 + tl;
            q8_token(PROJ + m * N1P + C1_NQ, qn, rope1 + m * 16, QS + ((size_t)(b * 8) * T + t0 + tl) * 64, (size_t)T * 64, lane); }
#pragma unroll
        for (int p = 0; p < 2; ++p) { const int tl = 8 * w + 4 * p + (lane >> 4), head = (lane >> 3) & 1, sub = lane & 7; const size_t m = (size_t)m0 + tl; float x[8];
            const size_t dsto = ((size_t)(b * 2 + head) * T + t0 + tl) * 64 + sub * 8, dstk = (size_t)(b * 2 + head) * T * 64 + kblk_off(t0 + tl, sub * 8);
            unpack8(*(const v4u*)(PROJ + m * N1P + C1_KSL + head * 64 + sub * 8), x); head_norm_rope(x, ksn, sub, rope1 + m * 16); *(v4u*)(KS + dstk) = pack8(x);
            unpack8(*(const v4u*)(PROJ + m * N1P + C1_KWN + head * 64 + sub * 8), x); head_norm_rope(x, kwn, sub, rope1 + m * 16); *(v4u*)(KW + dstk) = pack8(x);
            *(v4u*)(KCR + dsto) = *(const v4u*)(PROJ + m * N1P + C1_KC + head * 64 + sub * 8);
            *(v4u*)(VCR + dsto) = *(const v4u*)(PROJ + m * N1P + C1_VC + head * 64 + sub * 8); }
#pragma unroll
        for (int which = 0; which < 2; ++which) { const size_t m = (size_t)m0 + lane; const int cbase = which ? C1_VWN : C1_VSL; bf16* dst = which ? VWT : VST;
            const v4u a = *(const v4u*)(PROJ + m * N1P + cbase + 16 * w), c = *(const v4u*)(PROJ + m * N1P + cbase + 16 * w + 8);
            const unsigned wv[8] = {a.x, a.y, a.z, a.w, c.x, c.y, c.z, c.w};
#pragma unroll
            for (int i = 0; i < 16; ++i) { const int hd = 16 * w + i; dst[(((size_t)(b * 2 + (hd >> 6)) * (T / 32) + ((t0 + lane) >> 5)) * 64 + (hd & 63)) * 32 + ((t0 + lane) & 31)] = (bf16)((i & 1) ? (wv[i >> 1] >> 16) : (wv[i >> 1] & 0xffffu)); } }
    }
}

DI void moe_route(const bf16* __restrict__ H, const float* __restrict__ gln, const float* __restrict__ rw, const float* __restrict__ rb, bf16* __restrict__ XN,
                  int* __restrict__ TOKE, float* __restrict__ TOKW, int* __restrict__ TOKR, unsigned* CNT, LAS unsigned char* lds, int tid, int lane, int w, int bid, int G) {
    LAS unsigned* lcnt = (LAS unsigned*)lds; LAS int* le = (LAS int*)(lds + 64); LAS int* lr = (LAS int*)(lds + 64 + 512);
    for (int blk = bid; blk < M / 64; blk += G) {
        if (tid < 16) lcnt[tid] = 0u;
        __syncthreads();
#pragma unroll 1
        for (int hb = 0; hb < 2; ++hb) {
        v4u vv[4][2];
#pragma unroll
        for (int i = 0; i < 4; ++i) { const v4u* xr = (const v4u*)(H + ((size_t)blk * 64 + 8 * w + 4 * hb + i) * D) + lane; vv[i][0] = xr[0]; vv[i][1] = xr[64]; }
#pragma unroll
        for (int i = 0; i < 4; ++i) { const int rl = 8 * w + 4 * hb + i; const size_t m = (size_t)blk * 64 + rl; float x[16]; { float t8[8]; unpack8(vv[i][0], t8);
#pragma unroll
                for (int c = 0; c < 8; ++c) x[c] = t8[c];
                unpack8(vv[i][1], t8);
#pragma unroll
                for (int c = 0; c < 8; ++c) x[8 + c] = t8[c]; }
            float s = 0.f;
#pragma unroll
            for (int c = 0; c < 16; ++c) s += x[c] * x[c];
            const float rstd = 1.f / sqrtf(wave_sum(s) * (1.f / D) + EPS);
            v4u o0, o1; o0.x = pk2(x[0] * rstd, x[1] * rstd); o0.y = pk2(x[2] * rstd, x[3] * rstd); o0.z = pk2(x[4] * rstd, x[5] * rstd); o0.w = pk2(x[6] * rstd, x[7] * rstd);
            o1.x = pk2(x[8] * rstd, x[9] * rstd); o1.y = pk2(x[10] * rstd, x[11] * rstd); o1.z = pk2(x[12] * rstd, x[13] * rstd); o1.w = pk2(x[14] * rstd, x[15] * rstd);
            v4u* orow = (v4u*)(XN + m * D) + lane; orow[0] = o0; orow[64] = o1;
            float lg[8];
#pragma unroll
            for (int e = 0; e < 8; ++e) lg[e] = 0.f;
#pragma unroll
            for (int c = 0; c < 16; ++c) { const int col = (c < 8) ? 8 * lane + c : 512 + 8 * lane + (c - 8); const float xv = x[c] * rstd * gln[col]; const f32x4* wr = (const f32x4*)(rw + (size_t)col * 8); const f32x4 a = wr[0], bq = wr[1];
                lg[0] += xv * a[0]; lg[1] += xv * a[1]; lg[2] += xv * a[2]; lg[3] += xv * a[3]; lg[4] += xv * bq[0]; lg[5] += xv * bq[1]; lg[6] += xv * bq[2]; lg[7] += xv * bq[3]; }
#pragma unroll
            for (int e = 0; e < 8; ++e) lg[e] = wave_sum(lg[e]) + rb[e];
            if (lane == 0) { float v1 = lg[0]; int e1 = 0;
#pragma unroll
                for (int e = 1; e < 8; ++e) if (lg[e] > v1) { v1 = lg[e]; e1 = e; }
                float v2 = -3.0e38f; int e2 = 0;
#pragma unroll
                for (int e = 0; e < 8; ++e) if (e != e1 && lg[e] > v2) { v2 = lg[e]; e2 = e; }
                const float w1 = 1.f / (1.f + expf(v2 - v1));
                TOKE[2 * m] = e1; TOKE[2 * m + 1] = e2; TOKW[2 * m] = w1; TOKW[2 * m + 1] = 1.f - w1;
                le[2 * rl] = e1; le[2 * rl + 1] = e2; lr[2 * rl] = (int)atomicAdd((unsigned*)&lcnt[e1], 1u); lr[2 * rl + 1] = (int)atomicAdd((unsigned*)&lcnt[e2], 1u); }
        }
        }
        __syncthreads();
        if (tid < 8) lcnt[8 + tid] = __hip_atomic_fetch_add(CNT + tid, lcnt[tid], __ATOMIC_RELAXED, __HIP_MEMORY_SCOPE_AGENT);
        __syncthreads();
        if (tid < 128) { const size_t m = (size_t)blk * 64 + (tid >> 1); TOKR[2 * m + (tid & 1)] = lr[tid] + (int)lcnt[8 + le[tid]]; }
        __syncthreads();
    }
}
DI void moe_dispatch(unsigned* CNT, const bf16* __restrict__ XN, const int* __restrict__ TOKE, const int* __restrict__ TOKR, int* __restrict__ TOKS, bf16* __restrict__ XS,
                     int* __restrict__ TILEE, unsigned* NTW, LAS unsigned char* lds, int tid, int lane, int w, int bid, int G) {
    LAS int* lbase = (LAS int*)lds;
    if (tid == 0) { int acc = 0;
        for (int e = 0; e < 8; ++e) { const int c = (int)__hip_atomic_load(CNT + e, __ATOMIC_RELAXED, __HIP_MEMORY_SCOPE_AGENT); lbase[e] = acc; lbase[16 + e] = c; acc += (c + 255) & ~255; }
        lbase[8] = acc; }
    __syncthreads();
    const int ntiles = lbase[8] >> 8;
    if (bid == 0) { for (int t = tid; t < ntiles; t += 512) { int e = 0;
#pragma unroll
            for (int k = 1; k < 8; ++k) if (t * 256 >= lbase[k]) e = k;
            TILEE[t] = e; }
        if (tid == 0) *NTW = (unsigned)ntiles; }
    const int gw = bid * NWAVES + w, NGW = G * NWAVES;
    for (int m0 = gw; m0 < M; m0 += 2 * NGW) {
        int slot[2][2]; v4u va[2][2]; bool ok[2];
#pragma unroll
        for (int q = 0; q < 2; ++q) { const int m = m0 + q * NGW; ok[q] = m < M; const int mm = ok[q] ? m : m0;
            const v4u* src = (const v4u*)(XN + (size_t)mm * D) + lane; va[q][0] = src[0]; va[q][1] = src[64];
#pragma unroll
            for (int k = 0; k < 2; ++k) slot[q][k] = lbase[TOKE[2 * mm + k]] + TOKR[2 * mm + k]; }
#pragma unroll
        for (int q = 0; q < 2; ++q) if (ok[q]) { const int m = m0 + q * NGW;
#pragma unroll
            for (int k = 0; k < 2; ++k) { if (lane == 0) TOKS[2 * m + k] = slot[q][k];
                v4u* dst = (v4u*)(XS + (size_t)slot[q][k] * D) + lane; dst[0] = va[q][0]; dst[64] = va[q][1]; } } }
    for (int e = 0; e < 8; ++e) { const int lo = lbase[e] + lbase[16 + e], hi = lbase[e + 1];
        for (int row = lo + gw; row < hi; row += NGW) { v4u* dst = (v4u*)(XS + (size_t)row * D) + lane; dst[0] = (v4u){0u, 0u, 0u, 0u}; dst[64] = (v4u){0u, 0u, 0u, 0u}; } }
}
DI void moe_combine(float* __restrict__ OUT, const bf16* __restrict__ HB, const bf16* __restrict__ Y, const bf16* __restrict__ PART, const int* __restrict__ TOKS, const float* __restrict__ TOKW, int gw, int NGW, int lane) {
    constexpr int OVR = 2 * HALFTILES * 256;
    for (int m0 = gw; m0 < M; m0 += 2 * NGW) {
        int sl[2][2]; float wt[2][2]; bool ok[2];
#pragma unroll
        for (int q = 0; q < 2; ++q) { const int m = m0 + q * NGW; ok[q] = m < M; const int mm = ok[q] ? m : m0; sl[q][0] = TOKS[2 * mm]; sl[q][1] = TOKS[2 * mm + 1]; wt[q][0] = TOKW[2 * mm]; wt[q][1] = TOKW[2 * mm + 1]; }
        v2u ya[2][2][4], hb[2][4];
#pragma unroll
        for (int q = 0; q < 2; ++q) { const int m = ok[q] ? m0 + q * NGW : m0;
#pragma unroll
            for (int j = 0; j < 4; ++j) { const int col = lane * 4 + 256 * j; hb[q][j] = *(const v2u*)(HB + (size_t)m * D + col);
#pragma unroll
                for (int k = 0; k < 2; ++k) { const int s_ = sl[q][k];
                    if (s_ < OVR) ya[q][k][j] = *(const v2u*)(Y + (size_t)s_ * D + col);
                    else { float y0 = 0.f, y1 = 0.f, y2 = 0.f, y3 = 0.f;
                        for (int ks = 0; ks < NSPLIT; ++ks) { const v2u a = *(const v2u*)(PART + ((size_t)ks * 8 * 256 + (s_ - OVR)) * D + col); y0 += bflo(a.x); y1 += bfhi(a.x); y2 += bflo(a.y); y3 += bfhi(a.y); }
                        ya[q][k][j].x = pk2(y0, y1); ya[q][k][j].y = pk2(y2, y3); } } } }
#pragma unroll
        for (int q = 0; q < 2; ++q) if (ok[q]) { const int m = m0 + q * NGW;
#pragma unroll
            for (int j = 0; j < 4; ++j) { const int col = lane * 4 + 256 * j; f32x4 r_ = (f32x4){bflo(hb[q][j].x), bfhi(hb[q][j].x), bflo(hb[q][j].y), bfhi(hb[q][j].y)};
#pragma unroll
                for (int k = 0; k < 2; ++k) { const v2u a = ya[q][k][j]; const float w_ = wt[q][k]; r_[0] += w_ * bflo(a.x); r_[1] += w_ * bfhi(a.x); r_[2] += w_ * bflo(a.y); r_[3] += w_ * bfhi(a.y); }
                *(f32x4*)(OUT + (size_t)m * D + col) = r_; } }
    }
}

#ifndef ONE_LAUNCH
#define ONE_LAUNCH 1
#endif
#ifndef STOP_PHASE
#define STOP_PHASE 23
#endif
constexpr int NPHASE = 23;
#ifndef EARLY1
#define EARLY1 640
#endif
#ifndef EARLY2
#define EARLY2 1280
#endif
#ifndef DUP_MASK
#define DUP_MASK 0u
#endif
#define DUPN(k) (int)((DUP_MASK >> (k)) & 1u)
#define REP(k) _Pragma("unroll") for (int rep = 0; rep <= DUPN(k); ++rep)
#define REPBAR() do { if (rep) xcd_barrier(bar); } while (0)
#define REPRT(k) _Pragma("unroll 1") for (int rep = 0; rep <= DUPN(k); ++rep)
struct Args { const void* in[39]; float* out; unsigned char* ws; int ph_lo, ph_hi; };

__global__ void __launch_bounds__(NWAVES * 64, 2) hybrid_fwd(Args args) {
    extern __shared__ __attribute__((aligned(16))) unsigned char lds_raw[];
    LAS unsigned char* lds = (LAS unsigned char*)lds_raw;
    const int tid = threadIdx.x, lane = tid & 63, w = __builtin_amdgcn_readfirstlane(tid >> 6);
    const int G = gridDim.x, bid = blockIdx.x;
    const int gw = bid * NWAVES + w, NGW = G * NWAVES, gtid = bid * (NWAVES * 64) + tid, NTH = G * NWAVES * 64;
    unsigned char* ws = args.ws;
    unsigned* CTL = (unsigned*)(ws + WS_CTL);
    for (int u = tid; u < (LDS_BYTES - LDSCTL_OFF) / 4; u += NWAVES * 64) ((LAS unsigned*)(lds + LDSCTL_OFF))[u] = 0u;
    __syncthreads();
    XcdBarrier bar; bar.bar = CTL + CW_BAR; bar.x = 0; bar.st = nullptr;
    if (ONE_LAUNCH) bar = xcd_barrier_post(CTL + CW_BAR, (volatile LAS unsigned*)(lds + MISC_OFF) + 8);
    const int lo = args.ph_lo, hi = args.ph_hi < STOP_PHASE ? args.ph_hi : STOP_PHASE;
#define IN(k) (lo <= (k) && (k) < hi)
#ifndef PROBE_A
#define PROBE_A -1
#endif
#ifndef PROBE_B
#define PROBE_B -1
#endif
#ifndef PROBE_AE
#define PROBE_AE (PROBE_A + 1)
#endif
#ifndef PROBE_BE
#define PROBE_BE (PROBE_B + 1)
#endif
    volatile LAS unsigned long long* stamps = (volatile LAS unsigned long long*)(lds + MISC_OFF + 128);
#define STAMP(k) do { if (PROBE_A >= 0 && bid == 0 && tid == 0) stamps[k] = __builtin_amdgcn_s_memrealtime(); } while (0)
#define SEAM(k) do { if (ONE_LAUNCH && IN(k) && IN((k) + 1)) xcd_barrier(bar); STAMP((k) + 1); } while (0)
    STAMP(0);

    const float* x = (const float*)args.in[0]; const int* positions = (const int*)args.in[1];
    const float* ln_mix_e = (const float*)args.in[2]; const float* w_in_e = (const float*)args.in[3];
    const float* gla_gate_up = (const float*)args.in[4]; const float* gla_gate_bias = (const float*)args.in[5]; const float* gla_out_norm = (const float*)args.in[6];
    const float* swa_q_norm = (const float*)args.in[7]; const float* swa_k_norm = (const float*)args.in[8]; const float* swa_sinks = (const float*)args.in[9];
    const float* w_out_e = (const float*)args.in[10]; const float* ln_ffn_e = (const float*)args.in[11];
    const float* ffn_w_gate = (const float*)args.in[12]; const float* ffn_w_up = (const float*)args.in[13]; const float* ffn_w_down = (const float*)args.in[14];
    const float* ln_mix_o = (const float*)args.in[15]; const float* w_in_o = (const float*)args.in[16]; const float* ret_out_norm = (const float*)args.in[17];
    const float* nsa_q_norm = (const float*)args.in[18]; const float* nsa_kc_norm = (const float*)args.in[19]; const float* nsa_ks_norm = (const float*)args.in[20]; const float* nsa_kw_norm = (const float*)args.in[21];
    const float* cmp_pos_k = (const float*)args.in[22]; const float* cmp_w1_k = (const float*)args.in[23]; const float* cmp_b1_k = (const float*)args.in[24]; const float* cmp_w2_k = (const float*)args.in[25]; const float* cmp_b2_k = (const float*)args.in[26];
    const float* cmp_pos_v = (const float*)args.in[27]; const float* cmp_w1_v = (const float*)args.in[28]; const float* cmp_b1_v = (const float*)args.in[29]; const float* cmp_w2_v = (const float*)args.in[30]; const float* cmp_b2_v = (const float*)args.in[31];
    const float* w_out_o = (const float*)args.in[32]; const float* ln_ffn_o = (const float*)args.in[33]; const float* router_w = (const float*)args.in[34]; const float* router_b = (const float*)args.in[35];
    const float* exp_w_gate = (const float*)args.in[36]; const float* exp_w_up = (const float*)args.in[37]; const float* exp_w_down = (const float*)args.in[38];
    float* out = args.out; bf16* HB = (bf16*)args.out; bf16* H3B = (bf16*)(args.ws + WS_H3B);
    float* ROPE1 = (float*)(ws + WS_ROPE1); float* ROPE2 = (float*)(ws + WS_ROPE2);
    bf16* WIN0 = (bf16*)(ws + WS_WIN0); bf16* WOUT0 = (bf16*)(ws + WS_WOUT0); bf16* WGU = (bf16*)(ws + WS_WGU); bf16* WDN = (bf16*)(ws + WS_WDN);
    bf16* WIN1 = (bf16*)(ws + WS_WIN1); bf16* WOUT1 = (bf16*)(ws + WS_WOUT1); bf16* WCMP = (bf16*)(ws + WS_WCMP); bf16* MOEGU = (bf16*)(ws + WS_MOEGU); bf16* MOED = (bf16*)(ws + WS_MOED);
    bf16* XN = (bf16*)(ws + WS_XN); bf16* MIXED = XN; bf16* PROJ = (bf16*)(ws + WS_PROJ); bf16* ACT = PROJ;
    bf16* QS = (bf16*)(ws + WS_QS); bf16* KS = (bf16*)(ws + WS_KS); bf16* VST = (bf16*)(ws + WS_VST);
    bf16* QIN = (bf16*)(ws + WS_QIN); bf16* OINTRA = (bf16*)(ws + WS_OINTRA); bf16* SB = (bf16*)(ws + WS_SB); float* UT = (float*)(ws + WS_UT); float* DEC = (float*)(ws + WS_DEC);
    float* ONSA = (float*)(ws + WS_ONSA); float* CMPH = (float*)(ws + WS_CMPH);
    bf16* KCR = (bf16*)(ws + WS_KCR); bf16* VCR = (bf16*)(ws + WS_VCR); bf16* KW = (bf16*)(ws + WS_KW); bf16* VWT = (bf16*)(ws + WS_VWT);
    bf16* KCB = (bf16*)(ws + WS_CMPT + CT_KCB); bf16* VCBT = (bf16*)(ws + WS_CMPT + CT_VCBT); float* B1P = (float*)(ws + WS_CMPT + CT_B1P); bf16* W2T = (bf16*)(ws + WS_CMPT + CT_W2T);
    int* TOKE = (int*)(ws + WS_TAB + TB_TOKE); float* TOKW = (float*)(ws + WS_TAB + TB_TOKW); int* TOKR = (int*)(ws + WS_TAB + TB_TOKR); int* TOKS = (int*)(ws + WS_TAB + TB_TOKS); int* TILEE = (int*)(ws + WS_TAB + TB_TILEE);
    bf16* XS = (bf16*)(ws + WS_XS); bf16* ACTH = (bf16*)(ws + WS_ACTH); bf16* PART = (bf16*)(ws + WS_XN);
    LAS unsigned char* scr = lds + w * 16384;

    if (IN(0)) REP(0) { REPBAR();
        if (gw < 512) { const int kv = gw >> 8; cmp_bias_item(kv ? cmp_pos_v : cmp_pos_k, kv ? cmp_w1_v : cmp_w1_k, B1P + kv * 16384, (gw >> 6) & 3, gw & 63, lane); }
        conv_mat(cmp_w2_k, 256, 64, 64, W2T, 0, nullptr, scr, gw, NGW, lane);
        conv_mat(cmp_w2_v, 256, 64, 64, W2T + 64 * 256, 0, nullptr, scr, gw, NGW, lane);
        conv_mat_wg(w_in_e, D, N0, N0P, WIN0, 0, ln_mix_e, lds, lane, w, bid, G);
        conv_mat_wg(w_out_e, D, D, D, WOUT0, 0, nullptr, lds, lane, w, (bid + 80) % G, G);
        conv_mat_wg(ffn_w_gate, D, FF, FF, WGU, 1, ln_ffn_e, lds, lane, w, (bid + 112) % G, G);
        conv_mat_wg(ffn_w_up, D, FF, FF, WGU, 2, ln_ffn_e, lds, lane, w, (bid + 200) % G, G);
        conv_mat_wg(ffn_w_down, FF, D, D, WDN, 0, nullptr, lds, lane, w, (bid + 288) % G, G);
        conv_mat_wg(w_in_o, D, N1, N1P, WIN1, 0, ln_mix_o, lds, lane, w, (bid + 376) % G, G);
        conv_mat_wg(w_out_o, D, D, D, WOUT1, 0, nullptr, lds, lane, w, (bid + 472) % G, G);
        conv_mat_wg(cmp_w1_k, 2048, 256, 256, WCMP, 0, nullptr, lds, lane, w, (bid + 504) % G, G);
        conv_mat_wg(cmp_w1_v, 2048, 256, 256, WCMP + 256 * 2048, 0, nullptr, lds, lane, w, (bid + 520) % G, G);
        rope_tables(positions, ROPE1, ROPE2, gtid, NTH);
        rms_phase(x, XN, gw, NGW, lane);
    }
    SEAM(0);
    if (IN(1)) REP(1) { REPBAR(); pg8::Gemm g{XN, WIN0, M, N0P, D, D, D}; pg8::StaticOrder S; S.init(M, N0P, G, bid); pg8::EpiBf16Plain E{PROJ, N0P};
        pg8::gemm_phase<pg8::EpiBf16Plain, pg8::StaticOrder, true, true>(lds, g, S, E);
        if (!rep && G == 256 && bid >= 128) conv_moe_tiles(exp_w_gate, exp_w_up, exp_w_down, ln_ffn_o, MOEGU, MOED, lds, lane, w, 0, EARLY1, bid - 128, 128); }
    SEAM(1);
    if (IN(2)) REPRT(2) { REPBAR();
        prep0_swa(PROJ, swa_q_norm, swa_k_norm, ROPE1, QS, KS, VST, lane, w, bid, G);
        if (PROBE_A >= 0) { __syncthreads(); STAMP(29); }
        chunk_phaseA<false>(lds, PROJ, N0P, C0_GQ, C0_GK, C0_GV, C0_GLOW, gla_gate_up, gla_gate_bias, nullptr, QIN, OINTRA, UT, DEC, lane, w, bid, G);
    }
    SEAM(2);
    if (IN(3)) REPRT(3) { REPBAR();
        if (!rep) chunk_scan(UT, DEC, SB, gtid, NTH);
        window_attn<true, true>(QS, KS, VST, 128, swa_sinks, swa_q_norm, swa_k_norm, MIXED, nullptr, nullptr, lds + w * 16384, gw, NGW, lane);
    }
    SEAM(3);
    if (IN(4)) REP(4) { REPBAR(); chunk_phaseC<false>(QIN, OINTRA, SB, PROJ, N0P, C0_GOUT, gla_out_norm, MIXED, gw, NGW, lane); }
    SEAM(4);
    if (IN(5)) REP(5) { REPBAR(); pg8::Gemm g{MIXED, WOUT0, M, D, D, D, D}; pg8::StaticOrder S; S.init(M, D, G, bid); pg8::EpiResB E{x, nullptr, HB, D};
        pg8::gemm_phase<pg8::EpiResB, pg8::StaticOrder, true, true>(lds, g, S, E); }
    SEAM(5);
    if (IN(6)) REP(6) { REPBAR(); rms_phase_b(HB, XN, gw, NGW, lane); }
    SEAM(6);
    if (IN(7)) REP(7) { REPBAR(); pg8::Gemm g{XN, WGU, M, 2 * FF, D, D, D}; pg8::StaticOrder S; S.init(M, 2 * FF, G, bid); pg8::EpiSwiglu E{ACT, FF};
        pg8::gemm_phase<pg8::EpiSwiglu, pg8::StaticOrder, true, true>(lds, g, S, E);
        if (!rep && G == 256 && bid >= 128) conv_moe_tiles(exp_w_gate, exp_w_up, exp_w_down, ln_ffn_o, MOEGU, MOED, lds, lane, w, EARLY1, EARLY2, bid - 128, 128); }
    SEAM(7);
    if (IN(8)) REP(8) { REPBAR(); pg8::Gemm g{ACT, WDN, M, D, FF, FF, FF}; pg8::StaticOrder S; S.init(M, D, G, bid); pg8::EpiResB E{nullptr, HB, rep ? (bf16*)(ws + WS_RA) : HB, D};
        pg8::gemm_phase<pg8::EpiResB, pg8::StaticOrder, true, true>(lds, g, S, E); }
    SEAM(8);
    if (IN(9)) REP(9) { REPBAR(); rms_phase_b(HB, XN, gw, NGW, lane); }
    SEAM(9);
    if (IN(10)) REP(10) { REPBAR(); pg8::Gemm g{XN, WIN1, M, N1P, D, D, D}; pg8::StaticOrder S; S.init(M, N1P, G, bid); pg8::EpiBf16Plain E{PROJ, N1P};
        pg8::gemm_phase<pg8::EpiBf16Plain, pg8::StaticOrder, true, true>(lds, g, S, E); }
    SEAM(10);
    if (IN(11)) REPRT(11) { REPBAR();
        if (gtid < 512) { const int kv = gtid >> 8, j = gtid & 255; float bsum = (kv ? cmp_b1_v : cmp_b1_k)[j];
#pragma unroll
            for (int c = 0; c < 64; ++c) bsum += B1P[(kv * 64 + c) * 256 + j];
            B1P[32768 + gtid] = bsum; }
        prep1_nsa(PROJ, nsa_q_norm, nsa_ks_norm, nsa_kw_norm, ROPE1, QS, KS, KW, KCR, VCR, VST, VWT, lane, w, bid, G);
        if (PROBE_A >= 0) { __syncthreads(); STAMP(31); }
        chunk_phaseA<true>(lds, PROJ, N1P, C1_RQ, C1_RK, C1_RV, 0, nullptr, nullptr, ROPE2, QIN, OINTRA, UT, DEC, lane, w, bid, G);
    }
    SEAM(11);
    if (IN(12)) REPRT(12) { REPBAR();
        constexpr int NCW = 16;
        if (bid < NCW) { pg8::Gemm g{KCR, WCMP, 4096, 256, 2048, 1024, 2048}; pg8::CmpOrder S{NCW, bid}; pg8::EpiCmp E{CMPH, B1P + 32768};
            pg8::gemm_phase<pg8::EpiCmp, pg8::CmpOrder, true, true>(lds, g, S, E); }
        else { if (!rep) chunk_scan(UT, DEC, SB, gtid - NCW * NWAVES * 64, NTH - NCW * NWAVES * 64);
            window_attn<false, false>(QS, KW, VWT, 512, nullptr, nsa_q_norm, nsa_kw_norm, nullptr, ONSA, PROJ, lds + w * 16384, gw - NCW * NWAVES, NGW - NCW * NWAVES, lane); }
    }
    SEAM(12);
    if (IN(13)) REP(13) { REPBAR();
        cmp_layer2(CMPH, W2T, cmp_b2_k, cmp_b2_v, nsa_kc_norm, ROPE1, KCB, VCBT, gw, 256, NGW, lane);
        chunk_phaseC<true>(QIN, OINTRA, SB, PROJ, N1P, C1_RG, ret_out_norm, MIXED, gw, NGW, lane);
    }
    SEAM(13);
    if (IN(14)) REPRT(14) { REPBAR(); nsa_cmp_slc(QS, KCB, VCBT, KS, VST, nsa_q_norm, nsa_kc_norm, nsa_ks_norm, PROJ, rep ? (float*)OINTRA : ONSA, rep ? (bf16*)UT : MIXED, lds, w, gw, NGW, lane); }
    SEAM(14);
    if (IN(15)) REP(15) { REPBAR(); pg8::Gemm g{MIXED, WOUT1, M, D, D, D, D}; pg8::StaticOrder S; S.init(M, D, G, bid); pg8::EpiResB E{nullptr, HB, rep ? (bf16*)(ws + WS_RA) : H3B, D};
        pg8::gemm_phase<pg8::EpiResB, pg8::StaticOrder, true, true>(lds, g, S, E); }
    SEAM(15);
    if (IN(16)) REP(16) { REPBAR();
        if (!rep) moe_route(H3B, ln_ffn_o, router_w, router_b, XN, TOKE, TOKW, TOKR, CTL + CW_CNT, lds + 126976, tid, lane, w, bid, G);
        conv_moe_tiles(exp_w_gate, exp_w_up, exp_w_down, ln_ffn_o, MOEGU, MOED, lds, lane, w, (G == 256) ? EARLY2 : 0, 2688, bid, G);
    }
    SEAM(16);
    if (IN(17)) REP(17) { REPBAR(); moe_dispatch(CTL + CW_CNT, XN, TOKE, TOKR, TOKS, XS, TILEE, CTL + CW_NT, lds, tid, lane, w, bid, G); }
    SEAM(17);
#pragma unroll
    for (int hf = 0; hf < 2; ++hf) {
        if (IN(18 + 2 * hf)) REP(18) { REPBAR(); const int nt = (int)__hip_atomic_load(CTL + CW_NT, __ATOMIC_RELAXED, __HIP_MEMORY_SCOPE_AGENT);
            const int t0 = hf * HALFTILES, t1 = hf ? nt : (nt < HALFTILES ? nt : HALFTILES);
            if (t1 > t0) { pg8::Gemm g{XS, MOEGU, 0, 2 * FFE, D, D, D}; pg8::MoeOrder S{TILEE, t0, t1, 2 * FFE / 256, G, bid}; pg8::EpiSwiglu E{ACTH - (size_t)t0 * 256 * FFE, FFE};
                pg8::gemm_phase<pg8::EpiSwiglu, pg8::MoeOrder, true, true>(lds, g, S, E); } }
        SEAM(18 + 2 * hf);
        if (IN(19 + 2 * hf)) REP(19) { REPBAR(); const int nt = (int)__hip_atomic_load(CTL + CW_NT, __ATOMIC_RELAXED, __HIP_MEMORY_SCOPE_AGENT);
            const int t0 = hf * HALFTILES; int t1 = hf ? nt : (nt < HALFTILES ? nt : HALFTILES); if (t1 > 2 * HALFTILES) t1 = 2 * HALFTILES;
            if (t1 > t0) { pg8::Gemm g{ACTH - (size_t)t0 * 256 * FFE, MOED, 0, D, FFE, FFE, FFE}; pg8::MoeOrder S{TILEE, t0, t1, D / 256, G, bid}; pg8::EpiBf16Plain E{XS, D};
                pg8::gemm_phase<pg8::EpiBf16Plain, pg8::MoeOrder, true, true>(lds, g, S, E); }
            if (hf && nt > 2 * HALFTILES) { pg8::Gemm g{ACTH - (size_t)t0 * 256 * FFE, MOED, 0, D, FFE / NSPLIT, FFE, FFE}; pg8::MoeSplitOrder S{TILEE, 2 * HALFTILES, nt, D / 256, NSPLIT, FFE / NSPLIT, G, (bid + 128) % G};
                pg8::EpiBf16Split E{PART - (size_t)2 * HALFTILES * 256 * D, D, (size_t)8 * 256 * D};
                pg8::gemm_phase<pg8::EpiBf16Split, pg8::MoeSplitOrder, true, true>(lds, g, S, E); } }
        SEAM(19 + 2 * hf);
    }
    if (IN(22)) moe_combine(out, H3B, XS, PART, TOKS, TOKW, gw, NGW, lane);
    if (PROBE_A >= 0) { __syncthreads(); STAMP(23);
        if (bid == 0 && tid == 0) { const unsigned long long da = (stamps[PROBE_AE] - stamps[PROBE_A]) / 100ull, db = (PROBE_B >= 0) ? (stamps[PROBE_BE] - stamps[PROBE_B]) / 100ull : 0ull;
            const unsigned long long wait = (da + 512ull * db) * 100ull, t0 = __builtin_amdgcn_s_memrealtime();
            while (__builtin_amdgcn_s_memrealtime() - t0 < wait) __builtin_amdgcn_s_sleep(8); } }
#undef IN
#undef SEAM
}

extern "C" void kernel_launch(void* const* d_in, const int* in_sizes, int n_in, void* d_out, int out_size, void* d_ws, size_t ws_size, hipStream_t stream) {
    static int grid = 0;
    if (grid == 0) {
        if (n_in != 39 || out_size != M * D || ws_size < WS_END) { fprintf(stderr, "kernel_launch: unexpected problem (n_in %d, out %d, ws %zu < %zu)\n", n_in, out_size, ws_size, (size_t)WS_END); grid = -1; return; }
        int dev = 0, cus = 0, per_cu = 0;
        if (hipGetDevice(&dev) != hipSuccess || hipDeviceGetAttribute(&cus, hipDeviceAttributeMultiprocessorCount, dev) != hipSuccess) { grid = -1; return; }
        if (hipFuncSetAttribute((const void*)hybrid_fwd, hipFuncAttributeMaxDynamicSharedMemorySize, LDS_BYTES) != hipSuccess) { fprintf(stderr, "kernel_launch: hipFuncSetAttribute failed\n"); grid = -1; return; }
        if (hipOccupancyMaxActiveBlocksPerMultiprocessor(&per_cu, (const void*)hybrid_fwd, NWAVES * 64, LDS_BYTES) != hipSuccess || per_cu < 1) { fprintf(stderr, "kernel_launch: occupancy query says %d\n", per_cu); }
        (void)hipGetLastError();
        grid = cus;
    }
    if (grid < 0) return;
    if (hipMemsetAsync((char*)d_ws + WS_CTL, 0, CTL_ZERO_BYTES, stream) != hipSuccess) return;
    Args a{};
    for (int i = 0; i < 39; ++i) a.in[i] = d_in[i];
    a.out = (float*)d_out; a.ws = (unsigned char*)d_ws;
#if ONE_LAUNCH
    a.ph_lo = 0; a.ph_hi = NPHASE;
    hipLaunchKernelGGL(hybrid_fwd, dim3(grid), dim3(NWAVES * 64), LDS_BYTES, stream, a);
#else
    for (int p = 0; p < NPHASE && p < STOP_PHASE; ++p) { a.ph_lo = p; a.ph_hi = p + 1; hipLaunchKernelGGL(hybrid_fwd, dim3(grid), dim3(NWAVES * 64), LDS_BYTES, stream, a); }
#endif
}
```
